# Optimizing an MI355X kernel written in HIP

```python
import jax, jax.numpy as jnp
from jax import lax
import numpy as np

D_MODEL = 1024
BATCH = 8
SEQ = 8192
DEPTH = 2

HEAD_DIM = 64
POOL_WIDTH = D_MODEL // 4
POOL_WINDOWS = (2, 4, 8, 16)
N_POOL_GROUPS = len(POOL_WINDOWS)
POOL_GROUP_DIM = POOL_WIDTH // N_POOL_GROUPS
CONV_WIDTH = (3 * D_MODEL) // 8
CONV_KERNEL = 31
SGU_WIDTH = D_MODEL - POOL_WIDTH - CONV_WIDTH
SGU_HEADS = SGU_WIDTH // HEAD_DIM
CHUNK = 128
D_MIX = POOL_WIDTH + CONV_WIDTH + SGU_WIDTH
D_IN = POOL_WIDTH + 2 * CONV_WIDTH + 2 * SGU_WIDTH
D_FF = ((8 * D_MODEL // 3 + 127) // 128) * 128
N_EXPERTS = 8
TOP_K = 2
D_FF_EXPERT = 7 * D_MODEL // 2
N_MOD = 6
EPS = 1e-6

kernel_name = "hybrid_pool_conv_sgu_moe_encoder"


def rms_norm(x, g):
    xf = x.astype(jnp.float32)
    y = xf * lax.rsqrt(jnp.mean(xf * xf, axis=-1, keepdims=True) + EPS)
    return (y * g.astype(jnp.float32)).astype(x.dtype)


def layer_norm(x, g, b):
    xf = x.astype(jnp.float32)
    mu = jnp.mean(xf, axis=-1, keepdims=True)
    var = jnp.mean(jnp.square(xf - mu), axis=-1, keepdims=True)
    y = (xf - mu) * lax.rsqrt(var + EPS) * g.astype(jnp.float32) + b.astype(jnp.float32)
    return y.astype(x.dtype)


def multiscale_pool(a, pool_w, pool_scale):
    S = a.shape[1]
    af = a.astype(jnp.float32)
    cs = jnp.pad(jnp.cumsum(af, axis=1), ((0, 0), (1, 0), (0, 0)))
    t = jnp.arange(S)
    outs = []
    for g, w in enumerate(POOL_WINDOWS):
        half = w // 2
        hi = jnp.clip(t + half, 0, S)
        lo = jnp.clip(t - half, 0, S)
        sl = slice(g * POOL_GROUP_DIM, (g + 1) * POOL_GROUP_DIM)
        cs_g = cs[:, :, sl]
        win_sum = jnp.take(cs_g, hi, axis=1) - jnp.take(cs_g, lo, axis=1)
        count = (hi - lo).astype(jnp.float32)[None, :, None]
        diff = (win_sum / count - af[:, :, sl]).astype(a.dtype)
        outs.append(jnp.einsum('bsc,cd->bsd', diff, pool_w[g]))
    return jnp.concatenate(outs, axis=-1) * pool_scale


def conformer_conv(p, conv_w, conv_b, ln_g, ln_b):
    val, gate = jnp.split(p, 2, axis=-1)
    glu = val * jax.nn.sigmoid(gate)
    y = lax.conv_general_dilated(
        glu, conv_w[:, None, :], window_strides=(1,),
        padding=[(CONV_KERNEL // 2, CONV_KERNEL // 2)],
        dimension_numbers=('NWC', 'WIO', 'NWC'),
        feature_group_count=CONV_WIDTH) + conv_b
    return jax.nn.silu(layer_norm(y, ln_g, ln_b))


def spatial_gating(p, ln_g, ln_b, sgu_w, sgu_b):
    B, S, _ = p.shape
    u, v = jnp.split(p, 2, axis=-1)
    v = layer_norm(v, ln_g, ln_b).reshape(B, S // CHUNK, CHUNK, SGU_HEADS, HEAD_DIM)
    mixed = jnp.einsum('hpq,bnqhd->bnphd', sgu_w, v) + sgu_b.T[:, :, None]
    return u * mixed.reshape(B, S, SGU_WIDTH)


def swiglu(h, w_gate, w_up, w_down):
    return (jax.nn.silu(h @ w_gate) * (h @ w_up)) @ w_down


def moe_swiglu(h, router_w, router_b, w_gate, w_up, w_down):
    logits = jnp.einsum('bsd,de->bse', h.astype(jnp.float32), router_w.astype(jnp.float32)) \
        + router_b.astype(jnp.float32)
    top_vals, top_idx = lax.top_k(logits, TOP_K)
    top_w = jax.nn.softmax(top_vals, axis=-1)
    combine = jnp.sum(jax.nn.one_hot(top_idx, N_EXPERTS, dtype=jnp.float32) * top_w[..., None], axis=-2)
    combine = combine.astype(h.dtype)
    y = jnp.zeros_like(h)
    for e in range(N_EXPERTS):
        y = y + combine[..., e:e + 1] * swiglu(h, w_gate[e], w_up[e], w_down[e])
    return y


def setup_inputs(seed: int = 0) -> dict:
    key = jax.random.key(seed)
    ks = jax.random.split(key, 32)
    n_dense = (DEPTH + 1) // 2
    n_moe = DEPTH // 2

    def nrm(k, shape, fan_in):
        return jax.random.normal(k, shape, jnp.float32) * (fan_in ** -0.5)

    def near_one(k, shape):
        return 1.0 + 0.1 * jax.random.normal(k, shape, jnp.float32)

    def small(k, shape):
        return 0.02 * jax.random.normal(k, shape, jnp.float32)

    return {
        "x": jax.random.normal(ks[0], (BATCH, SEQ, D_MODEL), jnp.float32),
        "c": jax.random.normal(ks[1], (BATCH, D_MODEL), jnp.float32),
        "ada_w": nrm(ks[2], (DEPTH, D_MODEL, N_MOD * D_MODEL), D_MODEL),
        "ada_b": small(ks[3], (DEPTH, N_MOD * D_MODEL)),
        "mix_norm_g": near_one(ks[4], (DEPTH, D_MODEL)),
        "ffn_norm_g": near_one(ks[5], (DEPTH, D_MODEL)),
        "w_in": nrm(ks[6], (DEPTH, D_MODEL, D_IN), D_MODEL),
        "pool_w": nrm(ks[7], (DEPTH, N_POOL_GROUPS, POOL_GROUP_DIM, POOL_GROUP_DIM), POOL_GROUP_DIM),
        "pool_scale": near_one(ks[8], (DEPTH, POOL_WIDTH)),
        "conv_w": nrm(ks[9], (DEPTH, CONV_KERNEL, CONV_WIDTH), CONV_KERNEL),
        "conv_b": small(ks[10], (DEPTH, CONV_WIDTH)),
        "conv_ln_g": near_one(ks[11], (DEPTH, CONV_WIDTH)),
        "conv_ln_b": small(ks[12], (DEPTH, CONV_WIDTH)),
        "sgu_ln_g": near_one(ks[13], (DEPTH, SGU_WIDTH)),
        "sgu_ln_b": small(ks[14], (DEPTH, SGU_WIDTH)),
        "sgu_w": nrm(ks[15], (DEPTH, SGU_HEADS, CHUNK, CHUNK), CHUNK),
        "sgu_b": near_one(ks[16], (DEPTH, SGU_HEADS, CHUNK)),
        "w_out": nrm(ks[17], (DEPTH, D_MIX, D_MODEL), D_MIX),
        "ffn_w_gate": nrm(ks[18], (n_dense, D_MODEL, D_FF), D_MODEL),
        "ffn_w_up": nrm(ks[19], (n_dense, D_MODEL, D_FF), D_MODEL),
        "ffn_w_down": nrm(ks[20], (n_dense, D_FF, D_MODEL), D_FF),
        "router_w": nrm(ks[21], (n_moe, D_MODEL, N_EXPERTS), D_MODEL),
        "router_b": 0.01 * jax.random.normal(ks[22], (n_moe, N_EXPERTS), jnp.float32),
        "moe_w_gate": nrm(ks[23], (n_moe, N_EXPERTS, D_MODEL, D_FF_EXPERT), D_MODEL),
        "moe_w_up": nrm(ks[24], (n_moe, N_EXPERTS, D_MODEL, D_FF_EXPERT), D_MODEL),
        "moe_w_down": nrm(ks[25], (n_moe, N_EXPERTS, D_FF_EXPERT, D_MODEL), D_FF_EXPERT),
        "final_norm_g": near_one(ks[26], (D_MODEL,)),
    }


def reference(x, c, ada_w, ada_b, mix_norm_g, ffn_norm_g, w_in, pool_w, pool_scale,
              conv_w, conv_b, conv_ln_g, conv_ln_b, sgu_ln_g, sgu_ln_b, sgu_w, sgu_b, w_out,
              ffn_w_gate, ffn_w_up, ffn_w_down, router_w, router_b,
              moe_w_gate, moe_w_up, moe_w_down, final_norm_g):
    cond = jax.nn.silu(c)
    for l in range(DEPTH):
        mod = cond @ ada_w[l] + ada_b[l]
        mods = jnp.split(mod[:, None, :], N_MOD, axis=-1)
        shift_m, scale_m, gate_m, shift_f, scale_f, gate_f = mods

        h = rms_norm(x, mix_norm_g[l]) * (1.0 + scale_m) + shift_m
        proj = h @ w_in[l]
        p_pool, p_conv, p_sgu = jnp.split(proj, [POOL_WIDTH, POOL_WIDTH + 2 * CONV_WIDTH], axis=-1)
        out_a = multiscale_pool(p_pool, pool_w[l], pool_scale[l])
        out_b = conformer_conv(p_conv, conv_w[l], conv_b[l], conv_ln_g[l], conv_ln_b[l])
        out_c = spatial_gating(p_sgu, sgu_ln_g[l], sgu_ln_b[l], sgu_w[l], sgu_b[l])
        mixed = jnp.concatenate([out_a, out_b, out_c], axis=-1)
        x = x + gate_m * (mixed @ w_out[l])

        h = rms_norm(x, ffn_norm_g[l]) * (1.0 + scale_f) + shift_f
        i = l // 2
        if l % 2 == 0:
            y = swiglu(h, ffn_w_gate[i], ffn_w_up[i], ffn_w_down[i])
        else:
            y = moe_swiglu(h, router_w[i], router_b[i], moe_w_gate[i], moe_w_up[i], moe_w_down[i])
        x = x + gate_f * y
    return rms_norm(x, final_norm_g)
```

```cpp
#include <hip/hip_runtime.h>
#include <cstdio>
#include <cstdint>

#define GAS __attribute__((address_space(1)))
#define LAS __attribute__((address_space(3)))
typedef unsigned short bf16;
typedef short bf16x8 __attribute__((ext_vector_type(8)));
typedef float f32x4 __attribute__((ext_vector_type(4)));
typedef float f32x16 __attribute__((ext_vector_type(16)));
typedef unsigned u32x4 __attribute__((ext_vector_type(4)));
typedef unsigned u32x2 __attribute__((ext_vector_type(2)));

constexpr int NWAVES = 8, NTHREADS = 512;
constexpr int BATCH = 8, SEQ = 8192, D = 1024, M = BATCH * SEQ;
constexpr int D_IN = 1792, FF = 2816, FFE = 3584, NE = 8, NMOD = 6 * D;
constexpr int CONVW = 384, CKW = 31, NH = 6;
constexpr float EPS = 1e-6f;
constexpr int LISTN = M + NE * 256;

constexpr size_t MiB = 1u << 20;
constexpr size_t WS_CTL = 0, CTL_ZERO_BYTES = 1 * MiB;
constexpr size_t WS_MOD = 1 * MiB;
constexpr size_t WS_HIST = 2 * MiB;
constexpr size_t WS_TOT = 2 * MiB + 65536;
constexpr size_t WS_REC = 3 * MiB;
constexpr size_t WS_LIST = 4 * MiB;
constexpr size_t WS_WGT = 5 * MiB;
constexpr size_t WS_SGUW = 6 * MiB;
constexpr size_t WS_WIN = 8 * MiB;
constexpr size_t WS_WOUT = 15 * MiB;
constexpr size_t WS_WGU = 19 * MiB;
constexpr size_t WS_WD = 30 * MiB;
constexpr size_t WS_MWGU = 36 * MiB;
constexpr size_t WS_MWD = 148 * MiB;
constexpr size_t WS_H = 204 * MiB;
constexpr size_t WS_BIG = 332 * MiB;
constexpr size_t WS_MIXED = WS_BIG + (size_t)M * D_IN * 2;
constexpr size_t WS_END = WS_BIG + (size_t)LISTN * FFE * 2;
static_assert(WS_MIXED + (size_t)M * D * 2 <= WS_END && (size_t)M * FF * 2 <= (size_t)LISTN * FFE * 2, "ws map");
constexpr int CW_BAR = 4096;

constexpr int RING_BYTES = 131072;
constexpr int LC_OFF = RING_BYTES;
constexpr int LC_MISC = LC_OFF;
constexpr int LC_HIST = LC_OFF + 64;
constexpr int LC_TOT = LC_OFF + 128;
constexpr int LC_PRE = LC_OFF + 192;
constexpr int LC_TBASE = LC_OFF + 256;
constexpr int LC_WCNT = LC_OFF + 320;
constexpr int LC_GT = LC_OFF + 1024;
constexpr int LC_GOFF = LC_OFF + 4096;
constexpr int LDS_BYTES = RING_BYTES + 4096 + 8192;

__device__ __forceinline__ unsigned f2bf(float f) { unsigned u = __builtin_bit_cast(unsigned, f); return (u + 0x7fffu + ((u >> 16) & 1u)) >> 16; }
__device__ __forceinline__ unsigned pk2(float lo, float hi) { return f2bf(lo) | (f2bf(hi) << 16); }
__device__ __forceinline__ float bf2f(unsigned b) { return __builtin_bit_cast(float, b << 16); }
__device__ __forceinline__ float bflo(unsigned u) { return __builtin_bit_cast(float, u << 16); }
__device__ __forceinline__ float bfhi(unsigned u) { return __builtin_bit_cast(float, u & 0xffff0000u); }
__device__ __forceinline__ float fast_sigmoid(float x) { return __builtin_amdgcn_rcpf(1.0f + __builtin_amdgcn_exp2f(-1.44269504089f * x)); }
__device__ __forceinline__ float silu_f(float x) { return x * fast_sigmoid(x); }
__device__ __forceinline__ float wave_sum(float v) {
#pragma unroll
    for (int o = 1; o < 64; o <<= 1) v += __shfl_xor(v, o);
    return v;
}
#define LDS_WAIT() asm volatile("s_waitcnt lgkmcnt(0)" ::: "memory")

#define XB_TMO      128
#define XB_XCNT(j)  (256  + 64 * (j))
#define XB_XSUB(j)  (1280 + 64 * (j))
#define XB_XGEN(j)  (2304 + 64 * (j))
#define XB_TOP      3328
#define XB_TOPGEN   3392
#define XCD_BAR_WORDS 3456
#define XB_SPIN_CAP (1u << 18)
__device__ __forceinline__ unsigned xb_ld(unsigned* p)              { return __hip_atomic_load(p, __ATOMIC_RELAXED, __HIP_MEMORY_SCOPE_AGENT); }
__device__ __forceinline__ unsigned xb_add(unsigned* p, unsigned v) { return __hip_atomic_fetch_add(p, v, __ATOMIC_RELAXED, __HIP_MEMORY_SCOPE_AGENT); }
__device__ __forceinline__ unsigned xb_xcc_id() { return (unsigned)__builtin_amdgcn_s_getreg((3 << 11) | 20) & 0xFu; }
#define XB_SPIN(cond, bar) do { unsigned _sp = 0; while (cond) { __builtin_amdgcn_s_sleep(1); \
    if ((++_sp & 255u) == 0u) { if (xb_ld(&(bar)[XB_TMO])) break; if (_sp > XB_SPIN_CAP) { atomicAdd(&(bar)[XB_TMO], 1u); break; } } } } while (0)
struct XcdBarrier { unsigned* bar; unsigned x; volatile LAS unsigned* st; };
__device__ __forceinline__ XcdBarrier xcd_barrier_post(unsigned* bar, volatile LAS unsigned* st) {
    XcdBarrier b; b.bar = bar; b.x = xb_xcc_id(); b.st = st;
    if (threadIdx.x == 0) (void)xb_add(&bar[XB_XCNT(b.x)], 1u);
    return b;
}
__device__ __forceinline__ void xcd_barrier_complete(unsigned* bar, unsigned x, unsigned& nloc, unsigned& nx) {
    const unsigned G = gridDim.x * gridDim.y * gridDim.z;
    unsigned sum, cnt, mine, sp = 0u;
    for (;;) {
        sum = 0u; cnt = 0u; mine = 0u;
#pragma unroll
        for (unsigned j = 0; j < 16; ++j) { const unsigned c = xb_ld(&bar[XB_XCNT(j)]); sum += c; cnt += (c > 0u) ? 1u : 0u; mine = (j == x) ? c : mine; }
        if (sum == G) break;
        __builtin_amdgcn_s_sleep(1);
        if ((++sp & 255u) == 0u) { if (xb_ld(&bar[XB_TMO])) break; if (sp > XB_SPIN_CAP) { atomicAdd(&bar[XB_TMO], 1u); break; } }
    }
    nloc = mine > 0u ? mine : 1u; nx = cnt > 0u ? cnt : 1u;
}
__device__ __forceinline__ void xcd_barrier(const XcdBarrier& b) {
    asm volatile("s_waitcnt vmcnt(0)" ::: "memory");
    __syncthreads();
    if (threadIdx.x == 0) {
        unsigned* bar = b.bar;
        __builtin_amdgcn_s_waitcnt(0);
        unsigned nloc = b.st[0], nx = b.st[1];
        if (nloc == 0u) { xcd_barrier_complete(bar, b.x, nloc, nx); b.st[0] = nloc; b.st[1] = nx; }
        const unsigned old = xb_add(&bar[XB_XSUB(b.x)], 1u);
        const unsigned gen = old / nloc;
        if (old + 1u == (gen + 1u) * nloc) {
            __builtin_amdgcn_fence(__ATOMIC_RELEASE, "agent");
            asm volatile("s_waitcnt vmcnt(0)" ::: "memory");
            const unsigned og = xb_add(&bar[XB_TOP], 1u);
            const unsigned tg = og / nx;
            if (og + 1u == (tg + 1u) * nx) xb_add(&bar[XB_TOPGEN], 1u);
            else XB_SPIN(xb_ld(&bar[XB_TOPGEN]) == tg, bar);
            __builtin_amdgcn_fence(__ATOMIC_ACQUIRE, "agent");
            xb_add(&bar[XB_XGEN(b.x)], 1u);
            asm volatile("s_waitcnt vmcnt(0)" ::: "memory");
        } else {
            XB_SPIN(xb_ld(&bar[XB_XGEN(b.x)]) == gen, bar);
            __builtin_amdgcn_fence(__ATOMIC_ACQUIRE, "agent");
            asm volatile("s_waitcnt vmcnt(0)" ::: "memory");
        }
    }
    __syncthreads();
}

namespace pg8 {
constexpr int BM = 256, BK = 64, HALF = 128, HTB = HALF * BK * 2, STAGE_BYTES = 8 * HTB, NXCD = 8, WGM = 8;
__device__ __forceinline__ int lds_byte(int r, int c) { const int st = (r >> 4) * 2 + (c >> 5), rr = r & 15, cc = c & 31, ob = rr * 64 + cc * 2; return st * 1024 + (ob ^ (((ob >> 9) & 1) << 5)); }
__device__ __forceinline__ void stage_rc(int b, int& R, int& C) { const int st = b / 1024, sb = b % 1024, swz = sb ^ (((sb >> 9) & 1) << 5); R = (st >> 1) * 16 + swz / 64; C = (st & 1) * 32 + (swz % 64) / 2; }
__device__ __forceinline__ int perm32(int rho) { const int n = rho >> 4, i = rho & 15; return 8 * (i >> 2) + 4 * n + (i & 3); }
__device__ __forceinline__ unsigned cvt_pk_bf16(float lo, float hi) { unsigned r; asm volatile("v_cvt_pk_bf16_f32 %0, %1, %2" : "=v"(r) : "v"(lo), "v"(hi)); return r; }

struct Unit { int pm, pn, ex; };

__device__ __forceinline__ int xcd_remap(int wgid, int nwg) { const int q = nwg / NXCD, r = nwg % NXCD, xcd = wgid % NXCD, off = wgid / NXCD; return (xcd < r ? xcd * (q + 1) : r * (q + 1) + (xcd - r) * q) + off; }

struct DenseOrder {
    const bf16* A; const bf16* Bt; int K, nM, nN, nwg, G, c;
    __device__ __forceinline__ void init(const bf16* A_, const bf16* Bt_, int Mr, int N, int K_, int G_, int c_) { A = A_; Bt = Bt_; K = K_; nM = Mr / BM; nN = N / BM; nwg = nM * nN; G = G_; c = c_; }
    __device__ __forceinline__ bool next(int i, Unit& u) const {
        const long L = (long)i * G + c; if (L >= nwg) return false;
        const int wgid = xcd_remap((int)L, nwg);
        const int nig = WGM * nN, gid = wgid / nig, fm = gid * WGM, gsz = (nM - fm) < WGM ? (nM - fm) : WGM;
        u.pm = fm + ((wgid % nig) % gsz); u.pn = (wgid % nig) / gsz; u.ex = 0; return true;
    }
    __device__ __forceinline__ const char* a_ptr(const Unit& u) const { return (const char*)A + (size_t)u.pm * ((size_t)BM * K * 2); }
    __device__ __forceinline__ const char* b_ptr(const Unit& u) const { return (const char*)Bt + (size_t)u.pn * ((size_t)BM * K * 2); }
    __device__ __forceinline__ void rows_raw(const Unit&, const int (&)[2], unsigned (&)[2][2]) const {}
};
struct MoeOrder {
    const LAS int* tab; const bf16* A; const bf16* Bt; size_t bstride; const int* list; int K, nN, G, c; bool gather;
    __device__ __forceinline__ bool next(int i, Unit& u) const {
        const int U = __builtin_amdgcn_readfirstlane(tab[1]), ng = __builtin_amdgcn_readfirstlane(tab[0]);
        const long L = (long)i * G + c; if (L >= U) return false;
        const int wgid = xcd_remap((int)L, U);
        const int ln = threadIdx.x & 63;
        const int gs = (ln + 1 < ng) ? tab[64 + ln + 1] : 0x7fffffff;
        const unsigned long long bal = __ballot(gs <= wgid);
        const int g = __builtin_popcountll(bal);
        const int g0 = __builtin_amdgcn_readfirstlane(tab[64 + g]), t0 = __builtin_amdgcn_readfirstlane(tab[128 + g]), gsz = __builtin_amdgcn_readfirstlane(tab[192 + g]), ex = __builtin_amdgcn_readfirstlane(tab[256 + g]);
        const int local = wgid - g0;
        u.pm = t0 + local % gsz; u.pn = local / gsz; u.ex = ex; return true;
    }
    __device__ __forceinline__ const char* a_ptr(const Unit& u) const { return gather ? (const char*)A : (const char*)A + (size_t)u.pm * ((size_t)BM * K * 2); }
    __device__ __forceinline__ const char* b_ptr(const Unit& u) const { return (const char*)Bt + (size_t)u.ex * bstride + (size_t)u.pn * ((size_t)BM * K * 2); }
    __device__ __forceinline__ void rows_raw(const Unit& u, const int (&Rr)[2], unsigned (&raw)[2][2]) const {
#pragma unroll
        for (int h = 0; h < 2; ++h)
#pragma unroll
            for (int i = 0; i < 2; ++i) raw[h][i] = (unsigned)list[u.pm * BM + h * HALF + Rr[i]];
    }
};

struct EpiBf16 {
    static constexpr bool PERM = true;
    bf16* O; int ldc;
    __device__ __forceinline__ void operator()(const f32x4 (&acc)[2][2][4][2], const Unit& u, int wr, int wc, int fr, int fq) const {
        const int row0 = u.pm * BM + wr * 64 + fr, col0 = u.pn * BM + wc * 32 + 8 * fq;
#pragma unroll
        for (int ai = 0; ai < 2; ++ai)
#pragma unroll
            for (int m = 0; m < 4; ++m) { bf16* rowp = O + (size_t)(row0 + ai * HALF + m * 16) * ldc + col0;
#pragma unroll
                for (int bj = 0; bj < 2; ++bj) { const f32x4 v0 = acc[ai][bj][m][0], v1 = acc[ai][bj][m][1];
                    u32x4 w; w.x = cvt_pk_bf16(v0[0], v0[1]); w.y = cvt_pk_bf16(v0[2], v0[3]); w.z = cvt_pk_bf16(v1[0], v1[1]); w.w = cvt_pk_bf16(v1[2], v1[3]);
                    *(u32x4*)(rowp + bj * HALF) = w; } }
    }
};
struct EpiSwiglu {
    static constexpr bool PERM = true;
    bf16* O; int ldc;
    __device__ __forceinline__ void operator()(const f32x4 (&acc)[2][2][4][2], const Unit& u, int wr, int wc, int fr, int fq) const {
        const int row0 = u.pm * BM + wr * 64 + fr, col0 = u.pn * HALF + wc * 32 + 8 * fq;
#pragma unroll
        for (int ai = 0; ai < 2; ++ai)
#pragma unroll
            for (int m = 0; m < 4; ++m) { bf16* rowp = O + (size_t)(row0 + ai * HALF + m * 16) * ldc + col0;
                float o[8];
#pragma unroll
                for (int n = 0; n < 2; ++n)
#pragma unroll
                    for (int j = 0; j < 4; ++j) { const float g = acc[ai][0][m][n][j], up = acc[ai][1][m][n][j]; o[n * 4 + j] = silu_f(g) * up; }
                u32x4 w; w.x = cvt_pk_bf16(o[0], o[1]); w.y = cvt_pk_bf16(o[2], o[3]); w.z = cvt_pk_bf16(o[4], o[5]); w.w = cvt_pk_bf16(o[6], o[7]);
                *(u32x4*)rowp = w; }
    }
};
struct EpiResidual {
    static constexpr bool PERM = false;
    const float* xin; float* out; const float* gate;
    __device__ __forceinline__ void operator()(const f32x4 (&acc)[2][2][4][2], const Unit& u, int wr, int wc, int fr, int fq) const {
        const int row0 = u.pm * BM + wr * 64 + fr, col0 = u.pn * BM + wc * 32 + 4 * fq, b = u.pm >> 5;
        f32x4 gv[2][2];
#pragma unroll
        for (int bj = 0; bj < 2; ++bj)
#pragma unroll
            for (int n = 0; n < 2; ++n) gv[bj][n] = *(const f32x4*)(gate + (size_t)b * NMOD + col0 + bj * HALF + n * 16);
#pragma unroll
        for (int ai = 0; ai < 2; ++ai)
#pragma unroll
            for (int m = 0; m < 4; ++m) { const size_t off = (size_t)(row0 + ai * HALF + m * 16) * D + col0;
#pragma unroll
                for (int bj = 0; bj < 2; ++bj)
#pragma unroll
                    for (int n = 0; n < 2; ++n) { const f32x4 xs = *(const f32x4*)(xin + off + bj * HALF + n * 16); *(f32x4*)(out + off + bj * HALF + n * 16) = xs + gv[bj][n] * acc[ai][bj][m][n]; }
                asm volatile("" ::: "memory"); }
    }
};
struct EpiMoeDown {
    static constexpr bool PERM = false;
    float* out; const int* list; const float* wgt; const float* gate;
    __device__ __forceinline__ void operator()(const f32x4 (&acc)[2][2][4][2], const Unit& u, int wr, int wc, int fr, int fq) const {
        const int pos0 = u.pm * BM + wr * 64 + fr, col0 = u.pn * BM + wc * 32 + 4 * fq;
#pragma unroll
        for (int ai = 0; ai < 2; ++ai)
#pragma unroll
            for (int m = 0; m < 4; ++m) { const int pos = pos0 + ai * HALF + m * 16; const int tk = list[pos]; const float w = wgt[pos];
                if (tk >= 0) { const size_t off = (size_t)tk * D + col0; const float* gp = gate + (size_t)(tk >> 13) * NMOD + col0;
#pragma unroll
                    for (int bj = 0; bj < 2; ++bj)
#pragma unroll
                        for (int n = 0; n < 2; ++n) { const f32x4 gq = *(const f32x4*)(gp + bj * HALF + n * 16); const f32x4 xs = *(const f32x4*)(out + off + bj * HALF + n * 16);
                            *(f32x4*)(out + off + bj * HALF + n * 16) = xs + (gq * w) * acc[ai][bj][m][n]; } }
                asm volatile("" ::: "memory"); }
    }
};

template <class Epi, class Sched, bool GATHER>
__device__ __forceinline__ void gemm_phase(LAS unsigned char* lds, const int K, const Sched& S, const Epi& E, LAS u32x4* goff = nullptr) {
    int tid_ = threadIdx.x; asm volatile("" : "+v"(tid_));
    const int tid = tid_, wid = __builtin_amdgcn_readfirstlane(tid >> 6), lane = tid & 63, wr = wid >> 2, wc = wid & 3, fr = lane & 15, fq = lane >> 4;
    const int nt = K / BK;
    unsigned voffB[2], ao[2][2], no[2][2]; int Rr[2]; unsigned Cb[2];
    const size_t kstep = (size_t)(BK * 2);
    const size_t hstep = (size_t)HALF * K * 2;
#pragma unroll
    for (int i = 0; i < 2; ++i) { int R, C; stage_rc(tid * 16 + i * 8192, R, C); const int Rb = Epi::PERM ? ((R & ~31) + perm32(R & 31)) : R;
        voffB[i] = (unsigned)(Rb * K + C) * 2u; Rr[i] = R; Cb[i] = (unsigned)C * 2u;
        ao[0][i] = (unsigned)(R * K + C) * 2u; ao[1][i] = ao[0][i] + (unsigned)hstep; no[0][i] = ao[0][i]; no[1][i] = ao[1][i]; }
    const unsigned ldsw = (unsigned)wid * 1024u;
    const int aoff = lds_byte(wr * 64 + fr, fq * 8), boff = lds_byte(wc * 32 + fr, fq * 8);
#define PG8_SA(b, h) (((b) * 2 + (h)) * HTB)
#define PG8_SB(b, h) ((4 + (b) * 2 + (h)) * HTB)
#define PG8_STAGEB(bufoff, gbase) do { _Pragma("unroll") for (int _i = 0; _i < 2; ++_i) \
        __builtin_amdgcn_global_load_lds((const unsigned*)((const char*)(gbase) + voffB[_i]), (LAS unsigned*)(lds + (bufoff) + ldsw + _i * 8192), 16, 0, 0); } while (0)
#define PG8_STAGEA(bufoff, gbase, offs, h) do { _Pragma("unroll") for (int _i = 0; _i < 2; ++_i) \
        __builtin_amdgcn_global_load_lds((const unsigned*)((const char*)(gbase) + (offs)[h][_i]), (LAS unsigned*)(lds + (bufoff) + ldsw + _i * 8192), 16, 0, 0); } while (0)
#define PG8_LDA(dst, b, h) do { _Pragma("unroll") for (int m = 0; m < 4; ++m) _Pragma("unroll") for (int k = 0; k < 2; ++k) dst[m][k] = *(const LAS bf16x8*)(lds + PG8_SA(b, h) + aoff + m * 2048 + k * 1024); } while (0)
#define PG8_LDB(dst, b, h) do { _Pragma("unroll") for (int n = 0; n < 2; ++n) _Pragma("unroll") for (int k = 0; k < 2; ++k) dst[n][k] = *(const LAS bf16x8*)(lds + PG8_SB(b, h) + boff + n * 2048 + k * 1024); } while (0)
#define PG8_MMA(ai, bj, At, Bt) do { __builtin_amdgcn_s_setprio(1); _Pragma("unroll") for (int m = 0; m < 4; ++m) _Pragma("unroll") for (int n = 0; n < 2; ++n) _Pragma("unroll") for (int k = 0; k < 2; ++k) \
        acc[ai][bj][m][n] = __builtin_amdgcn_mfma_f32_16x16x32_bf16(Bt[n][k], At[m][k], acc[ai][bj][m][n], 0, 0, 0); __builtin_amdgcn_s_setprio(0); } while (0)
#define PG8_WAIT_V(n) asm volatile("s_waitcnt vmcnt(" #n ")" ::: "memory")
#define PG8_WAIT_L(n) asm volatile("s_waitcnt lgkmcnt(" #n ")" ::: "memory")
#define PG8_BAR __builtin_amdgcn_s_barrier()
#define PG8_SCHED __builtin_amdgcn_sched_barrier(0)
    Unit cur, nxt, nn; int ui = 0;
    if (!S.next(0, cur)) return;
    bool has_next = S.next(1, nxt);
    if constexpr (GATHER) {
        unsigned raw[2][2]; S.rows_raw(cur, Rr, raw);
#pragma unroll
        for (int h = 0; h < 2; ++h)
#pragma unroll
            for (int i = 0; i < 2; ++i) ao[h][i] = (raw[h][i] & 0xffffffu) * (unsigned)(K * 2) + Cb[i];
        if (has_next) { S.rows_raw(nxt, Rr, raw);
#pragma unroll
            for (int h = 0; h < 2; ++h)
#pragma unroll
                for (int i = 0; i < 2; ++i) no[h][i] = (raw[h][i] & 0xffffffu) * (unsigned)(K * 2) + Cb[i]; }
        else {
#pragma unroll
            for (int h = 0; h < 2; ++h)
#pragma unroll
                for (int i = 0; i < 2; ++i) no[h][i] = ao[h][i]; }
        goff[tid] = (u32x4){no[0][0], no[0][1], no[1][0], no[1][1]};
    }
    f32x4 acc[2][2][4][2];
#pragma unroll
    for (int a = 0; a < 2; ++a)
#pragma unroll
        for (int b = 0; b < 2; ++b)
#pragma unroll
            for (int m = 0; m < 4; ++m)
#pragma unroll
                for (int n = 0; n < 2; ++n) acc[a][b][m][n] = (f32x4){0.f, 0.f, 0.f, 0.f};
    bf16x8 At[4][2], B0[2][2], B1[2][2];
    const char* cA = S.a_ptr(cur); const char* cB = S.b_ptr(cur);
    PG8_STAGEB(PG8_SB(0, 0), cB); PG8_STAGEB(PG8_SB(0, 1), cB + hstep); PG8_STAGEA(PG8_SA(0, 0), cA, ao, 0); PG8_STAGEA(PG8_SA(0, 1), cA, ao, 1);
    if (wr == 1) PG8_BAR;
    PG8_WAIT_V(2); PG8_BAR;
    PG8_STAGEB(PG8_SB(1, 0), cB + kstep); PG8_STAGEA(PG8_SA(1, 0), cA + kstep, ao, 0); PG8_STAGEB(PG8_SB(1, 1), cB + hstep + kstep);
    PG8_WAIT_V(6); PG8_BAR;
    for (;;) {
        const char* nA = has_next ? S.a_ptr(nxt) : cA; const char* nB = has_next ? S.b_ptr(nxt) : cB;
        for (int t = 0; t < nt; t += 2) {
            const bool last = (t == nt - 2);
            const char* a1 = cA + (size_t)(t + 1) * kstep;
            const char* a2 = last ? nA : cA + (size_t)(t + 2) * kstep; const char* b2 = last ? nB : cB + (size_t)(t + 2) * kstep;
            const char* a3 = a2 + kstep; const char* b3 = b2 + kstep;
            PG8_LDB(B0, 0, 0); PG8_LDB(B1, 0, 1); PG8_SCHED; PG8_LDA(At, 0, 0); PG8_STAGEA(PG8_SA(1, 1), a1, ao, 1);
            if constexpr (GATHER) { if (last) { const u32x4 q = goff[tid]; ao[0][0] = q[0]; ao[0][1] = q[1]; ao[1][0] = q[2]; ao[1][1] = q[3]; } }
            PG8_WAIT_V(8); PG8_WAIT_L(0); PG8_BAR; PG8_MMA(0, 0, At, B0); PG8_MMA(0, 1, At, B1); PG8_BAR; PG8_SCHED;
            PG8_LDA(At, 0, 1); PG8_STAGEB(PG8_SB(0, 0), b2); PG8_STAGEB(PG8_SB(0, 1), b2 + hstep); PG8_STAGEA(PG8_SA(0, 0), a2, ao, 0);
            PG8_WAIT_V(8); PG8_WAIT_L(0); PG8_BAR; PG8_MMA(1, 0, At, B0); PG8_MMA(1, 1, At, B1); PG8_BAR; PG8_SCHED;
            PG8_LDB(B0, 1, 0); PG8_LDB(B1, 1, 1); PG8_SCHED; PG8_LDA(At, 1, 0); PG8_STAGEA(PG8_SA(0, 1), a2, ao, 1);
            PG8_WAIT_V(8); PG8_WAIT_L(0); PG8_BAR; PG8_MMA(0, 0, At, B0); PG8_MMA(0, 1, At, B1); PG8_BAR; PG8_SCHED;
            PG8_LDA(At, 1, 1); PG8_STAGEB(PG8_SB(1, 0), b3); PG8_STAGEB(PG8_SB(1, 1), b3 + hstep); PG8_STAGEA(PG8_SA(1, 0), a3, ao, 0);
            PG8_WAIT_V(8); PG8_WAIT_L(0); PG8_BAR; PG8_MMA(1, 0, At, B0); PG8_MMA(1, 1, At, B1); PG8_BAR; PG8_SCHED;
        }
        if (wr == 0) PG8_BAR;
        bool has_nn = false; unsigned raw[2][2];
        if (has_next) has_nn = S.next(ui + 2, nn);
        if constexpr (GATHER) { if (has_nn) S.rows_raw(nn, Rr, raw); }
        E(acc, cur, wr, wc, fr, fq);
        if (!has_next) break;
#pragma unroll
        for (int a = 0; a < 2; ++a)
#pragma unroll
            for (int b = 0; b < 2; ++b)
#pragma unroll
                for (int m = 0; m < 4; ++m)
#pragma unroll
                    for (int n = 0; n < 2; ++n) acc[a][b][m][n] = (f32x4){0.f, 0.f, 0.f, 0.f};
        if constexpr (GATHER) {
            if (has_nn) { u32x4 q;
#pragma unroll
                for (int h = 0; h < 2; ++h)
#pragma unroll
                    for (int i = 0; i < 2; ++i) q[h * 2 + i] = (raw[h][i] & 0xffffffu) * (unsigned)(K * 2) + Cb[i];
                goff[tid] = q; }
        }
        cur = nxt; cA = nA; cB = nB; nxt = nn; has_next = has_nn; ++ui;
        if (wr == 1) PG8_BAR;
    }
    PG8_WAIT_V(0);
    PG8_BAR;
#undef PG8_SA
#undef PG8_SB
#undef PG8_STAGEA
#undef PG8_STAGEB
#undef PG8_LDA
#undef PG8_LDB
#undef PG8_MMA
#undef PG8_WAIT_V
#undef PG8_WAIT_L
#undef PG8_BAR
#undef PG8_SCHED
}
}

struct Args { const float* in[27]; float* out; unsigned char* ws; };
typedef const float* cfp_t;
typedef __attribute__((address_space(4))) const cfp_t* kargp_t;
struct Frame {
    LAS unsigned char* lds;
    int tid, lane, wave, G, bid;
    kargp_t ka;
};
#define PHASE_ENTER(F) do { kargp_t _p = (F).ka; asm volatile("" : "+s"(_p)); (F).ka = _p; \
    int _t = threadIdx.x; asm volatile("" : "+v"(_t)); (F).tid = _t; (F).lane = _t & 63; (F).wave = __builtin_amdgcn_readfirstlane(_t >> 6); \
    int _g = gridDim.x; asm volatile("" : "+s"(_g)); (F).G = _g; int _b = blockIdx.x; asm volatile("" : "+s"(_b)); (F).bid = _b; } while (0)
#define KIN(k) ((F).ka[k])
#define KOUT ((float*)(F).ka[27])
#define KWS ((unsigned char*)(F).ka[28])
#define KMOD ((float*)(KWS + WS_MOD))
#define KH ((bf16*)(KWS + WS_H))
#define KPROJ ((bf16*)(KWS + WS_BIG))
#define KMIXED ((bf16*)(KWS + WS_MIXED))
#define KACT ((bf16*)(KWS + WS_BIG))

__device__ __forceinline__ void p0_transpose_item(const float* W, int K, int N, bf16* WT, int dst_row0, LAS float* scr, int kb, int nb, int lane) {
    const int k0 = 64 * kb, n0 = 32 * nb;
#pragma unroll 8
    for (int i = 0; i < 32; ++i) { const int kk = 2 * i + (lane >> 5); scr[kk * 33 + (lane & 31)] = W[(size_t)(k0 + kk) * N + n0 + (lane & 31)]; }
    LDS_WAIT(); asm volatile("" ::: "memory");
    const int c = lane & 7;
#pragma unroll
    for (int j = 0; j < 4; ++j) { const int n = (lane >> 3) + 8 * j; const LAS float* s = scr + (8 * c) * 33 + n;
        u32x4 o; o.x = pk2(s[0 * 33], s[1 * 33]); o.y = pk2(s[2 * 33], s[3 * 33]); o.z = pk2(s[4 * 33], s[5 * 33]); o.w = pk2(s[6 * 33], s[7 * 33]);
        *(u32x4*)(WT + (size_t)(dst_row0 + n) * K + k0 + 8 * c) = o; }
    LDS_WAIT(); asm volatile("" ::: "memory");
}
__device__ __forceinline__ int gu_row(int n) { return (n >> 7) * 256 + (n & 127); }

__device__ __forceinline__ void p0_prologue(Frame& F) {
    if (F.bid < 192) {
        LAS float* cond = (LAS float*)F.lds;
        LAS float* red = (LAS float*)(F.lds + 32768);
        const float* cin = KIN(1);
        for (int i = F.tid; i < BATCH * D; i += NTHREADS) cond[i] = silu_f(cin[i]);
        __syncthreads();
        for (int item = F.bid; item < 192; item += F.G) {
            const int l = item / 96, colbase = (item % 96) * 64, col = colbase + F.lane;
            const float* W = KIN(2) + (size_t)l * D * NMOD;
            float a[8];
#pragma unroll
            for (int b = 0; b < 8; ++b) a[b] = 0.f;
            for (int k = F.wave * 128; k < F.wave * 128 + 128; ++k) { const float w = W[(size_t)k * NMOD + col];
#pragma unroll
                for (int b = 0; b < 8; ++b) a[b] = fmaf(cond[b * D + k], w, a[b]); }
#pragma unroll
            for (int b = 0; b < 8; ++b) red[(F.wave * 8 + b) * 64 + F.lane] = a[b];
            __syncthreads();
            { const int b = F.tid >> 6, cl = F.tid & 63; float s = 0.f;
#pragma unroll
              for (int w = 0; w < 8; ++w) s += red[(w * 8 + b) * 64 + cl];
              KMOD[((size_t)l * BATCH + b) * NMOD + colbase + cl] = s + KIN(3)[(size_t)l * NMOD + colbase + cl]; }
            __syncthreads();
        }
    }
    LAS float* scr = (LAS float*)(F.lds + F.wave * 16384);
    const int gw = F.bid * NWAVES + F.wave, NGW = F.G * NWAVES;
    constexpr int I_IN = 16 * 56, I_OUT = 16 * 32, I_FG = 16 * 88, I_FD = 44 * 32, I_MG = 16 * 112, I_MD = 56 * 32;
    constexpr int NITEMS = 2 * I_IN + 2 * I_OUT + 2 * I_FG + I_FD + 16 * I_MG + 8 * I_MD;
    bf16* ws_b = (bf16*)KWS;
    for (int it = gw; it < NITEMS; it += NGW) {
        int r = it;
        if (r < 2 * I_IN) { const int l = r / I_IN; r -= l * I_IN; const int kb = r / 56, nb = r % 56;
            p0_transpose_item(KIN(6) + (size_t)l * D * D_IN, D, D_IN, (bf16*)(KWS + WS_WIN) + (size_t)l * D_IN * D, 32 * nb, scr, kb, nb, F.lane); continue; } r -= 2 * I_IN;
        if (r < 2 * I_OUT) { const int l = r / I_OUT; r -= l * I_OUT; const int kb = r / 32, nb = r % 32;
            p0_transpose_item(KIN(17) + (size_t)l * D * D, D, D, (bf16*)(KWS + WS_WOUT) + (size_t)l * D * D, 32 * nb, scr, kb, nb, F.lane); continue; } r -= 2 * I_OUT;
        if (r < 2 * I_FG) { const int up = r / I_FG; r -= up * I_FG; const int kb = r / 88, nb = r % 88;
            p0_transpose_item(up ? KIN(19) : KIN(18), D, FF, (bf16*)(KWS + WS_WGU), gu_row(32 * nb) + 128 * up, scr, kb, nb, F.lane); continue; } r -= 2 * I_FG;
        if (r < I_FD) { const int kb = r / 32, nb = r % 32;
            p0_transpose_item(KIN(20), FF, D, (bf16*)(KWS + WS_WD), 32 * nb, scr, kb, nb, F.lane); continue; } r -= I_FD;
        if (r < 16 * I_MG) { const int q = r / I_MG; r -= q * I_MG; const int up = q >> 3, e = q & 7; const int kb = r / 112, nb = r % 112;
            p0_transpose_item((up ? KIN(24) : KIN(23)) + (size_t)e * D * FFE, D, FFE, (bf16*)(KWS + WS_MWGU) + (size_t)e * 2 * FFE * D, gu_row(32 * nb) + 128 * up, scr, kb, nb, F.lane); continue; } r -= 16 * I_MG;
        { const int e = r / I_MD; r -= e * I_MD; const int kb = r / 32, nb = r % 32;
            p0_transpose_item(KIN(25) + (size_t)e * FFE * D, FFE, D, (bf16*)(KWS + WS_MWD) + (size_t)e * D * FFE, 32 * nb, scr, kb, nb, F.lane); }
    }
    (void)ws_b;
    { const float* sw = KIN(15); bf16* so = (bf16*)(KWS + WS_SGUW);
      for (int i = (F.bid * NTHREADS + F.tid) * 4; i < 2 * NH * 128 * 128; i += F.G * NTHREADS * 4) { const f32x4 v = *(const f32x4*)(sw + i); u32x2 o; o.x = pk2(v[0], v[1]); o.y = pk2(v[2], v[3]); *(u32x2*)(so + i) = o; } }
}

template <int MODE>
__device__ __forceinline__ void norm_phase(Frame& F, const float* xsrc, const float* g, const float* shiftp, const float* scalep, bf16* hdst, float* fdst) {
    LAS int* lhist = (LAS int*)(F.lds + LC_HIST);
    for (int tb = F.bid; tb < M / 256; tb += F.G) {
        const int row0 = tb * 256 + F.wave * 32, b = row0 >> 13;
        f32x4 gm[4], sh[4];
#pragma unroll
        for (int j = 0; j < 4; ++j) { const int col = 4 * F.lane + 256 * j; const f32x4 gg = *(const f32x4*)(g + col);
            if (MODE == 2) { gm[j] = gg; sh[j] = (f32x4){0.f, 0.f, 0.f, 0.f}; }
            else { const f32x4 sc = *(const f32x4*)(scalep + (size_t)b * NMOD + col); gm[j] = gg * (1.0f + sc); sh[j] = *(const f32x4*)(shiftp + (size_t)b * NMOD + col); } }
        float rbias[8];
        LAS float* rwl = (LAS float*)F.lds;
        if (MODE == 1) {
            for (int i = F.tid; i < D * NE; i += NTHREADS) rwl[(i & 7) * D + (i >> 3)] = KIN(21)[i];
#pragma unroll
            for (int e = 0; e < 8; ++e) rbias[e] = KIN(22)[e];
            if (F.tid < 16) lhist[F.tid] = 0;
            __syncthreads();
        }
        for (int r = 0; r < 32; ++r) {
            const int row = row0 + r;
            const f32x4* xr = (const f32x4*)(xsrc + (size_t)row * D) + F.lane;
            f32x4 v[4]; float ss = 0.f;
#pragma unroll
            for (int j = 0; j < 4; ++j) { v[j] = xr[64 * j]; ss += (v[j][0] * v[j][0] + v[j][1] * v[j][1]) + (v[j][2] * v[j][2] + v[j][3] * v[j][3]); }
            const float rstd = 1.0f / sqrtf(wave_sum(ss) * (1.0f / D) + EPS);
#pragma unroll
            for (int j = 0; j < 4; ++j) v[j] = (v[j] * rstd) * gm[j] + sh[j];
            if (MODE == 2) { f32x4* o = (f32x4*)(fdst + (size_t)row * D) + F.lane;
#pragma unroll
                for (int j = 0; j < 4; ++j) o[64 * j] = v[j]; }
            else { u32x2* o = (u32x2*)(hdst + (size_t)row * D) + F.lane;
#pragma unroll
                for (int j = 0; j < 4; ++j) { u32x2 w; w.x = pk2(v[j][0], v[j][1]); w.y = pk2(v[j][2], v[j][3]); o[64 * j] = w; } }
            if (MODE == 1) {
                float lg[8];
#pragma unroll
                for (int e = 0; e < 8; ++e) lg[e] = 0.f;
#pragma unroll
                for (int e = 0; e < 8; ++e)
#pragma unroll
                    for (int j = 0; j < 4; ++j) { const f32x4 wv = *(const LAS f32x4*)(rwl + e * D + 4 * F.lane + 256 * j);
                        lg[e] = fmaf(v[j][0], wv[0], lg[e]); lg[e] = fmaf(v[j][1], wv[1], lg[e]); lg[e] = fmaf(v[j][2], wv[2], lg[e]); lg[e] = fmaf(v[j][3], wv[3], lg[e]); }
#pragma unroll
                for (int e = 0; e < 8; ++e) lg[e] = wave_sum(lg[e]) + rbias[e];
                int i1 = 0; float v1 = lg[0];
#pragma unroll
                for (int e = 1; e < 8; ++e) if (lg[e] > v1) { v1 = lg[e]; i1 = e; }
                int i2 = -1; float v2 = -3.0e38f;
#pragma unroll
                for (int e = 0; e < 8; ++e) if (e != i1 && lg[e] > v2) { v2 = lg[e]; i2 = e; }
                const float ex = __expf(v2 - v1), w1 = 1.0f / (1.0f + ex), w2 = ex * w1;
                if (F.lane == 0) { u32x4 rec; rec.x = (unsigned)i1; rec.y = (unsigned)i2; rec.z = __float_as_uint(w1); rec.w = __float_as_uint(w2);
                    *(u32x4*)(KWS + WS_REC + (size_t)row * 16) = rec; __hip_atomic_fetch_add(&lhist[i1], 1, __ATOMIC_RELAXED, __HIP_MEMORY_SCOPE_WORKGROUP); __hip_atomic_fetch_add(&lhist[8 + i2], 1, __ATOMIC_RELAXED, __HIP_MEMORY_SCOPE_WORKGROUP); }
            }
        }
        if (MODE == 1) { __syncthreads(); if (F.tid < 16) ((int*)(KWS + WS_HIST))[tb * 16 + F.tid] = lhist[F.tid]; __syncthreads(); }
    }
}

__device__ __forceinline__ void route_phase(Frame& F) {
    LAS int* ltot = (LAS int*)(F.lds + LC_TOT); LAS int* lpre = (LAS int*)(F.lds + LC_PRE); LAS int* ltb = (LAS int*)(F.lds + LC_TBASE); LAS int* lwc = (LAS int*)(F.lds + LC_WCNT);
    const int* hist = (const int*)(KWS + WS_HIST);
    int* list = (int*)(KWS + WS_LIST); float* wgt = (float*)(KWS + WS_WGT);
    for (int tb = F.bid; tb < M / 256; tb += F.G) {
        if (F.tid < 16) { ltot[F.tid] = 0; lpre[F.tid] = 0; }
        __syncthreads();
        { const int pe = F.tid & 15, part = F.tid >> 4; int sa = 0, sp = 0;
#pragma unroll
          for (int k = 0; k < 8; ++k) { const int t = part * 8 + k; const int v = hist[t * 16 + pe]; sa += v; sp += (t < tb) ? v : 0; }
          __hip_atomic_fetch_add(&ltot[pe], sa, __ATOMIC_RELAXED, __HIP_MEMORY_SCOPE_WORKGROUP); __hip_atomic_fetch_add(&lpre[pe], sp, __ATOMIC_RELAXED, __HIP_MEMORY_SCOPE_WORKGROUP); }
        __syncthreads();
        if (F.tid < 2) { int base = 0; for (int e = 0; e < 8; ++e) { ltb[F.tid * 8 + e] = base; base += (ltot[F.tid * 8 + e] + 255) >> 8; } }
        __syncthreads();
        unsigned e01[2] = {0u, 0u}; float w01[2] = {0.f, 0.f}; int rk[2] = {0, 0};
        if (F.tid < 256) {
            const u32x4 rec = *(const u32x4*)(KWS + WS_REC + (size_t)(tb * 256 + F.tid) * 16);
            e01[0] = rec.x; e01[1] = rec.y; w01[0] = __uint_as_float(rec.z); w01[1] = __uint_as_float(rec.w);
#pragma unroll
            for (int p = 0; p < 2; ++p)
#pragma unroll
                for (int ee = 0; ee < 8; ++ee) { const unsigned long long mk = __ballot(e01[p] == (unsigned)ee);
                    if (e01[p] == (unsigned)ee) rk[p] = __builtin_popcountll(mk & ((1ull << F.lane) - 1ull));
                    if (F.lane == 0) lwc[(p * 4 + F.wave) * 8 + ee] = __builtin_popcountll(mk); }
        }
        __syncthreads();
        if (F.tid < 256) {
#pragma unroll
            for (int p = 0; p < 2; ++p) { const int e = (int)e01[p]; int off = 0;
                for (int w = 0; w < F.wave; ++w) off += lwc[(p * 4 + w) * 8 + e];
                const int pos = ltb[p * 8 + e] * 256 + lpre[p * 8 + e] + off + rk[p];
                list[p * LISTN + pos] = tb * 256 + F.tid; wgt[p * LISTN + pos] = w01[p]; }
        }
        if (tb < 16) { const int p = tb >> 3, e = tb & 7; const int lo = ltb[tb] * 256 + ltot[tb], hi = (ltb[tb] + ((ltot[tb] + 255) >> 8)) * 256;
            for (int i = lo + F.tid; i < hi; i += NTHREADS) { list[p * LISTN + i] = (int)0x80000000u; wgt[p * LISTN + i] = 0.f; } (void)e; }
        if (tb == 0 && F.tid < 16) ((int*)(KWS + WS_TOT))[F.tid] = ltot[F.tid];
        __syncthreads();
    }
}
__device__ __forceinline__ void build_group_table(Frame& F, int p, int nN) {
    LAS int* tab = (LAS int*)(F.lds + LC_GT);
    __syncthreads();
    if (F.tid == 0) { const int* tot = (const int*)(KWS + WS_TOT) + p * 8; int ng = 0, ustart = 0, tile = 0;
        for (int e = 0; e < 8; ++e) { int tl = (tot[e] + 255) >> 8;
            while (tl > 0) { const int gsz = tl < 8 ? tl : 8; tab[64 + ng] = ustart; tab[128 + ng] = tile; tab[192 + ng] = gsz; tab[256 + ng] = e; ustart += gsz * nN; tile += gsz; tl -= gsz; ++ng; } }
        tab[0] = ng; tab[1] = ustart; }
    __syncthreads();
}

__device__ __forceinline__ void mixer_unit(Frame& F, const int l, const int unit) {
    const bf16* P = KPROJ; bf16* MO = KMIXED;
    const int t0 = unit * 128, s0 = t0 & (SEQ - 1), rb = t0 - s0;
    const int lane = F.lane, wave = F.wave, tid = F.tid;
    {
        constexpr int YS = 392;
        LAS bf16* ybuf = (LAS bf16*)F.lds;
        const float* cw = KIN(9) + (size_t)l * CKW * CONVW; const float* cb = KIN(10) + (size_t)l * CONVW;
        for (int it = 0; it < 3; ++it) {
            const int wi = it * 8 + wave, seg = wi / 6, cg = wi - seg * 6, c = cg * 64 + lane;
            float w[31];
#pragma unroll
            for (int j = 0; j < 31; ++j) w[j] = cw[j * CONVW + c];
            const float bias = cb[c];
            float o[32];
#pragma unroll
            for (int i = 0; i < 32; ++i) o[i] = bias;
#pragma unroll
            for (int j = 0; j < 62; ++j) { const int s = s0 + seg * 32 - 15 + j; const bool ok = (s >= 0) && (s < SEQ); const int sc = ok ? s : s0;
                const bf16* pr = P + (size_t)(rb + sc) * D_IN + 256 + c; const float a = bf2f(pr[0]), gt = bf2f(pr[CONVW]); const float gl = ok ? a * fast_sigmoid(gt) : 0.f;
#pragma unroll
                for (int i = 0; i < 32; ++i) if (j - i >= 0 && j - i < 31) o[i] = fmaf(w[j - i], gl, o[i]); }
#pragma unroll
            for (int i = 0; i < 32; ++i) ybuf[(seg * 32 + i) * YS + c] = (bf16)f2bf(o[i]);
        }
        __syncthreads();
        float g6[6], b6[6];
#pragma unroll
        for (int k = 0; k < 3; ++k)
#pragma unroll
            for (int e = 0; e < 2; ++e) { g6[2 * k + e] = KIN(11)[l * CONVW + 128 * k + 2 * lane + e]; b6[2 * k + e] = KIN(12)[l * CONVW + 128 * k + 2 * lane + e]; }
        for (int r = 0; r < 16; ++r) { const int tk = wave * 16 + r;
            const LAS unsigned* yr = (const LAS unsigned*)(ybuf + tk * YS);
            float v[6]; float s = 0.f, q = 0.f;
#pragma unroll
            for (int k = 0; k < 3; ++k) { const unsigned u = yr[64 * k + lane]; v[2 * k] = bflo(u); v[2 * k + 1] = bfhi(u); }
#pragma unroll
            for (int k = 0; k < 6; ++k) { s += v[k]; q += v[k] * v[k]; }
            s = wave_sum(s); q = wave_sum(q);
            const float mean = s * (1.0f / CONVW), var = fmaxf(q * (1.0f / CONVW) - mean * mean, 0.f), rstd = 1.0f / sqrtf(var + EPS);
            unsigned* orow = (unsigned*)(MO + (size_t)(t0 + tk) * D + 256);
#pragma unroll
            for (int k = 0; k < 3; ++k) { const float o0 = silu_f((v[2 * k] - mean) * rstd * g6[2 * k] + b6[2 * k]), o1 = silu_f((v[2 * k + 1] - mean) * rstd * g6[2 * k + 1] + b6[2 * k + 1]);
                orow[64 * k + lane] = pk2(o0, o1); }
        }
        __syncthreads();
    }
    {
        constexpr int VS = 136;
        LAS bf16* vnT = (LAS bf16*)F.lds;
        float g6[6], b6[6];
#pragma unroll
        for (int k = 0; k < 3; ++k)
#pragma unroll
            for (int e = 0; e < 2; ++e) { g6[2 * k + e] = KIN(13)[l * CONVW + 128 * k + 2 * lane + e]; b6[2 * k + e] = KIN(14)[l * CONVW + 128 * k + 2 * lane + e]; }
        for (int r = 0; r < 16; ++r) { const int tk = wave * 16 + r;
            const unsigned* pv = (const unsigned*)(P + (size_t)(t0 + tk) * D_IN + 1408);
            float v[6]; float s = 0.f, q = 0.f;
#pragma unroll
            for (int k = 0; k < 3; ++k) { const unsigned u = pv[64 * k + lane]; v[2 * k] = bflo(u); v[2 * k + 1] = bfhi(u); }
#pragma unroll
            for (int k = 0; k < 6; ++k) { s += v[k]; q += v[k] * v[k]; }
            s = wave_sum(s); q = wave_sum(q);
            const float mean = s * (1.0f / CONVW), var = fmaxf(q * (1.0f / CONVW) - mean * mean, 0.f), rstd = 1.0f / sqrtf(var + EPS);
#pragma unroll
            for (int k = 0; k < 3; ++k)
#pragma unroll
                for (int e = 0; e < 2; ++e) vnT[(128 * k + 2 * lane + e) * VS + tk] = (bf16)f2bf((v[2 * k + e] - mean) * rstd * g6[2 * k + e] + b6[2 * k + e]);
        }
        __syncthreads();
        const bf16* sw = (const bf16*)(KWS + WS_SGUW);
        const float* sb = KIN(16) + (size_t)l * NH * 128;
        for (int tile = wave; tile < 24; tile += 8) { const int hh = tile >> 2, pb = tile & 3;
            f32x16 acc0, acc1;
#pragma unroll
            for (int i = 0; i < 16; ++i) { acc0[i] = 0.f; acc1[i] = 0.f; }
            const bf16* Wh = sw + ((size_t)((l * NH + hh) * 128 + pb * 32 + (lane & 31))) * 128 + 8 * (lane >> 5);
            const LAS bf16* Vb = vnT + (hh * 64 + (lane & 31)) * VS + 8 * (lane >> 5);
#pragma unroll
            for (int ks = 0; ks < 8; ++ks) { const bf16x8 a = *(const bf16x8*)(Wh + ks * 16);
                const bf16x8 b0 = *(const LAS bf16x8*)(Vb + ks * 16), b1 = *(const LAS bf16x8*)(Vb + 32 * VS + ks * 16);
                acc0 = __builtin_amdgcn_mfma_f32_32x32x16_bf16(a, b0, acc0, 0, 0, 0); acc1 = __builtin_amdgcn_mfma_f32_32x32x16_bf16(a, b1, acc1, 0, 0, 0); }
#pragma unroll
            for (int r = 0; r < 16; ++r) { const int p = pb * 32 + (r & 3) + 8 * (r >> 2) + 4 * (lane >> 5); const size_t row = (size_t)(t0 + p); const float bias = sb[hh * 128 + p];
                const int d0 = hh * 64 + (lane & 31);
                const float u0 = bf2f(P[row * D_IN + 1024 + d0]), u1 = bf2f(P[row * D_IN + 1024 + d0 + 32]);
                MO[row * D + 640 + d0] = (bf16)f2bf(u0 * (acc0[r] + bias)); MO[row * D + 640 + d0 + 32] = (bf16)f2bf(u1 * (acc1[r] + bias)); }
        }
        __syncthreads();
    }
    {
        constexpr int AS = 264;
        LAS bf16* abuf = (LAS bf16*)F.lds;
        LAS float* diff = (LAS float*)(F.lds + 144 * AS * 2);
        constexpr int DS = 68;
        for (int i = tid; i < 144 * 128; i += NTHREADS) { const int rr = i >> 7, cp = i & 127; const int s = s0 - 8 + rr; unsigned v = 0u;
            if (s >= 0 && s < SEQ) v = *(const unsigned*)(P + (size_t)(rb + s) * D_IN + 2 * cp);
            *(LAS unsigned*)(abuf + rr * AS + 2 * cp) = v; }
        __syncthreads();
        for (int g = 0; g < 4; ++g) {
            const int half = 1 << g;
            { const int ch = tid & 63;
              for (int k = 0; k < 16; ++k) { const int tk = (tid >> 6) + 8 * k; const int s = s0 + tk;
                  int lo = s - half; lo = lo < 0 ? 0 : lo; int hi = s + half; hi = hi > SEQ ? SEQ : hi;
                  float sum = 0.f;
                  for (int ss = lo; ss < hi; ++ss) sum += bf2f(abuf[(ss - s0 + 8) * AS + g * 64 + ch]);
                  diff[tk * DS + ch] = sum / (float)(hi - lo) - bf2f(abuf[(tk + 8) * AS + g * 64 + ch]); } }
            __syncthreads();
            { const int d = tid & 63; float w[64];
              const float* pw = KIN(7) + ((size_t)(l * 4 + g) * 64) * 64 + d;
#pragma unroll
              for (int c = 0; c < 64; ++c) w[c] = pw[c * 64];
              const float psc = KIN(8)[l * 256 + g * 64 + d];
              for (int k = 0; k < 16; ++k) { const int tk = (tid >> 6) + 8 * k; const LAS f32x4* dr = (const LAS f32x4*)(diff + tk * DS); float a = 0.f;
#pragma unroll
                  for (int c4 = 0; c4 < 16; ++c4) { const f32x4 dv = dr[c4]; a = fmaf(dv[0], w[4 * c4], a); a = fmaf(dv[1], w[4 * c4 + 1], a); a = fmaf(dv[2], w[4 * c4 + 2], a); a = fmaf(dv[3], w[4 * c4 + 3], a); }
                  MO[(size_t)(t0 + tk) * D + g * 64 + d] = (bf16)f2bf(a * psc); } }
            __syncthreads();
        }
    }
}

__global__ void __launch_bounds__(NTHREADS, 2) fwd_kernel(Args args) {
    extern __shared__ __attribute__((aligned(16))) unsigned char lds_raw[];
    Frame F;
    F.lds = (LAS unsigned char*)lds_raw;
    F.tid = threadIdx.x; F.lane = F.tid & 63; F.wave = __builtin_amdgcn_readfirstlane(F.tid >> 6); F.G = gridDim.x; F.bid = blockIdx.x;
    F.ka = (kargp_t)__builtin_amdgcn_kernarg_segment_ptr(); (void)args;
    for (int u = F.tid; u < (LDS_BYTES - LC_OFF) / 4; u += NTHREADS) ((LAS unsigned*)(F.lds + LC_OFF))[u] = 0u;
    __syncthreads();
    XcdBarrier bar = xcd_barrier_post((unsigned*)(KWS + WS_CTL) + CW_BAR, (volatile LAS unsigned*)(F.lds + LC_MISC) + 8);
#define GRID_BAR() xcd_barrier(bar)
#define MODL(l) (KMOD + (size_t)(l) * BATCH * NMOD)

    PHASE_ENTER(F);
    p0_prologue(F);
    GRID_BAR();

    for (int l = 0; l < 2; ++l) {
        { PHASE_ENTER(F); const float* xsrc = (l == 0) ? KIN(0) : (const float*)KOUT;
          norm_phase<0>(F, xsrc, KIN(4) + l * D, MODL(l) + 0 * D, MODL(l) + 1 * D, KH, nullptr); }
        GRID_BAR();
        { PHASE_ENTER(F); pg8::DenseOrder S; S.init(KH, (const bf16*)(KWS + WS_WIN) + (size_t)l * D_IN * D, M, D_IN, D, F.G, F.bid);
          pg8::EpiBf16 E{KPROJ, D_IN};
          pg8::gemm_phase<pg8::EpiBf16, pg8::DenseOrder, false>(F.lds, D, S, E); }
        GRID_BAR();
        { PHASE_ENTER(F); for (int u = F.bid; u < M / 128; u += F.G) mixer_unit(F, l, u); }
        GRID_BAR();
        { PHASE_ENTER(F); const float* xsrc = (l == 0) ? KIN(0) : (const float*)KOUT;
          pg8::DenseOrder S; S.init(KMIXED, (const bf16*)(KWS + WS_WOUT) + (size_t)l * D * D, M, D, D, F.G, F.bid);
          pg8::EpiResidual E{xsrc, KOUT, MODL(l) + 2 * D};
          pg8::gemm_phase<pg8::EpiResidual, pg8::DenseOrder, false>(F.lds, D, S, E); }
        GRID_BAR();
#ifdef DIAG_STOP
        if (DIAG_STOP == 1 + 2 * l) break;
#endif
        if (l == 0) {
            { PHASE_ENTER(F); norm_phase<0>(F, KOUT, KIN(5) + l * D, MODL(l) + 3 * D, MODL(l) + 4 * D, KH, nullptr); }
            GRID_BAR();
            { PHASE_ENTER(F); pg8::DenseOrder S; S.init(KH, (const bf16*)(KWS + WS_WGU), M, 2 * FF, D, F.G, F.bid);
              pg8::EpiSwiglu E{KACT, FF};
              pg8::gemm_phase<pg8::EpiSwiglu, pg8::DenseOrder, false>(F.lds, D, S, E); }
            GRID_BAR();
            { PHASE_ENTER(F); pg8::DenseOrder S; S.init(KACT, (const bf16*)(KWS + WS_WD), M, D, FF, F.G, F.bid);
              pg8::EpiResidual E{KOUT, KOUT, MODL(l) + 5 * D};
              pg8::gemm_phase<pg8::EpiResidual, pg8::DenseOrder, false>(F.lds, FF, S, E); }
            GRID_BAR();
#ifdef DIAG_STOP
            if (DIAG_STOP == 2) break;
#endif
        } else {
            { PHASE_ENTER(F); norm_phase<1>(F, KOUT, KIN(5) + l * D, MODL(l) + 3 * D, MODL(l) + 4 * D, KH, nullptr); }
            GRID_BAR();
            { PHASE_ENTER(F); route_phase(F); }
            GRID_BAR();
            for (int p = 0; p < 2; ++p) {
                { PHASE_ENTER(F); build_group_table(F, p, 2 * FFE / 256);
                  pg8::MoeOrder S; S.tab = (const LAS int*)(F.lds + LC_GT); S.A = KH; S.Bt = (const bf16*)(KWS + WS_MWGU); S.bstride = (size_t)2 * FFE * D * 2; S.list = (const int*)(KWS + WS_LIST) + p * LISTN;
                  S.K = D; S.nN = 2 * FFE / 256; S.G = F.G; S.c = F.bid; S.gather = true;
                  pg8::EpiSwiglu E{KACT, FFE};
                  pg8::gemm_phase<pg8::EpiSwiglu, pg8::MoeOrder, true>(F.lds, D, S, E, (LAS u32x4*)(F.lds + LC_GOFF)); }
                GRID_BAR();
                { PHASE_ENTER(F); build_group_table(F, p, D / 256);
                  pg8::MoeOrder S; S.tab = (const LAS int*)(F.lds + LC_GT); S.A = KACT; S.Bt = (const bf16*)(KWS + WS_MWD); S.bstride = (size_t)D * FFE * 2; S.list = nullptr;
                  S.K = FFE; S.nN = D / 256; S.G = F.G; S.c = F.bid; S.gather = false;
                  pg8::EpiMoeDown E{KOUT, (const int*)(KWS + WS_LIST) + p * LISTN, (const float*)(KWS + WS_WGT) + p * LISTN, MODL(1) + 5 * D};
                  pg8::gemm_phase<pg8::EpiMoeDown, pg8::MoeOrder, false>(F.lds, FFE, S, E); }
                GRID_BAR();
            }
        }
    }
    { PHASE_ENTER(F); norm_phase<2>(F, KOUT, KIN(26), nullptr, nullptr, nullptr, KOUT); }
}

extern "C" void kernel_launch(void* const* d_in, const int* in_sizes, int n_in, void* d_out, int out_size, void* d_ws, size_t ws_size, hipStream_t stream) {
    static int grid = 0;
    if (grid == 0) {
        if (n_in != 27 || in_sizes[0] != M * D || out_size != M * D || ws_size < WS_END) { fprintf(stderr, "kernel_launch: unexpected shapes (n_in %d, in0 %d, out %d, ws %zu < %zu); nothing launched\n", n_in, n_in > 0 ? in_sizes[0] : -1, out_size, ws_size, (size_t)WS_END); grid = -1; return; }
        int dev = 0, cus = 0, per_cu = 0;
        if (hipGetDevice(&dev) != hipSuccess || hipDeviceGetAttribute(&cus, hipDeviceAttributeMultiprocessorCount, dev) != hipSuccess) { grid = -1; return; }
        if (hipFuncSetAttribute((const void*)fwd_kernel, hipFuncAttributeMaxDynamicSharedMemorySize, LDS_BYTES) != hipSuccess) { fprintf(stderr, "kernel_launch: hipFuncSetAttribute failed\n"); grid = -1; return; }
        if (hipOccupancyMaxActiveBlocksPerMultiprocessor(&per_cu, (const void*)fwd_kernel, NTHREADS, LDS_BYTES) != hipSuccess || per_cu < 1) { fprintf(stderr, "kernel_launch: occupancy query says %d blocks per CU\n", per_cu); }
        (void)hipGetLastError();
        grid = cus;
    }
    if (grid < 0) return;
    if (hipMemsetAsync((char*)d_ws + WS_CTL, 0, CTL_ZERO_BYTES, stream) != hipSuccess) return;
    Args a{};
    for (int i = 0; i < 27; ++i) a.in[i] = (const float*)d_in[i];
    a.out = (float*)d_out; a.ws = (unsigned char*)d_ws;
    hipLaunchKernelGGL(fwd_kernel, dim3(grid), dim3(NTHREADS), LDS_BYTES, stream, a);
}
```

```cpp
#include <hip/hip_runtime.h>
#include <cstdio>
#include <cstdint>

#define GAS __attribute__((address_space(1)))
#define LAS __attribute__((address_space(3)))
typedef unsigned short bf16;
typedef short bf16x8 __attribute__((ext_vector_type(8)));
typedef float f32x4 __attribute__((ext_vector_type(4)));
typedef float f32x16 __attribute__((ext_vector_type(16)));
typedef unsigned u32x4 __attribute__((ext_vector_type(4)));
typedef unsigned u32x2 __attribute__((ext_vector_type(2)));
typedef int i32x4 __attribute__((ext_vector_type(4)));
typedef int i32x8 __attribute__((ext_vector_type(8)));
constexpr float SC_W = 256.0f, SC_H = 16.0f, SC_A = 4.0f;

constexpr int NWAVES = 8, NTHREADS = 512;
constexpr int BATCH = 8, SEQ = 8192, D = 1024, M = BATCH * SEQ;
constexpr int D_IN = 1792, FF = 2816, FFE = 3584, NE = 8, NMOD = 6 * D;
constexpr int CONVW = 384, CKW = 31, NH = 6;
constexpr float EPS = 1e-6f;
constexpr int LISTN = M + NE * 256;

constexpr size_t MiB = 1u << 20;
constexpr size_t WS_CTL = 0, CTL_ZERO_BYTES = 1 * MiB;
constexpr size_t WS_MOD = 1 * MiB;
constexpr size_t WS_HIST = 2 * MiB;
constexpr size_t WS_TOT = 2 * MiB + 65536;
constexpr size_t WS_DUMP = 2 * MiB + 131072;
constexpr size_t WS_REC = 3 * MiB;
constexpr size_t WS_LIST = 4 * MiB;
constexpr size_t WS_WGT = 5 * MiB;
constexpr size_t WS_SGUW = 6 * MiB;
constexpr size_t WS_WIN = 8 * MiB;
constexpr size_t WS_WOUT = 15 * MiB;
constexpr size_t WS_WGU = 19 * MiB;
constexpr size_t WS_WD = 30 * MiB;
constexpr size_t WS_MWGU = 36 * MiB;
constexpr size_t WS_MWD = 148 * MiB;
constexpr size_t WS_H = 204 * MiB;
constexpr size_t WS_BIG = 332 * MiB;
constexpr size_t WS_MIXED = WS_BIG + (size_t)M * D_IN * 2;
constexpr size_t WS_END = WS_BIG + (size_t)LISTN * FFE * 2;
static_assert(WS_MIXED + (size_t)M * D * 2 <= WS_END && (size_t)M * FF * 2 <= (size_t)LISTN * FFE * 2, "ws map");
constexpr int CW_BAR = 4096;

constexpr int RING_BYTES = 131072;
constexpr int LC_OFF = RING_BYTES;
constexpr int LC_MISC = LC_OFF;
constexpr int LC_HIST = LC_OFF + 64;
constexpr int LC_TOT = LC_OFF + 128;
constexpr int LC_PRE = LC_OFF + 192;
constexpr int LC_TBASE = LC_OFF + 256;
constexpr int LC_WCNT = LC_OFF + 320;
constexpr int LC_GT = LC_OFF + 1024;
constexpr int LC_GOFF = LC_OFF + 4096;
constexpr int LDS_BYTES = RING_BYTES + 4096 + 8192;

__device__ __forceinline__ unsigned f2bf(float f) { unsigned u = __builtin_bit_cast(unsigned, f); return (u + 0x7fffu + ((u >> 16) & 1u)) >> 16; }
__device__ __forceinline__ unsigned pk2(float lo, float hi) { return f2bf(lo) | (f2bf(hi) << 16); }
__device__ __forceinline__ float bf2f(unsigned b) { return __builtin_bit_cast(float, b << 16); }
__device__ __forceinline__ float bflo(unsigned u) { return __builtin_bit_cast(float, u << 16); }
__device__ __forceinline__ float bfhi(unsigned u) { return __builtin_bit_cast(float, u & 0xffff0000u); }
__device__ __forceinline__ float fast_sigmoid(float x) { return __builtin_amdgcn_rcpf(1.0f + __builtin_amdgcn_exp2f(-1.44269504089f * x)); }
__device__ __forceinline__ float silu_f(float x) { return x * fast_sigmoid(x); }
#define WS_SWZ(v, o) ((v) + __int_as_float(__builtin_amdgcn_ds_swizzle(__float_as_int(v), 0x1f | ((o) << 10))))
__device__ __forceinline__ float wave_sum(float v) {
    v = WS_SWZ(v, 1); v = WS_SWZ(v, 2); v = WS_SWZ(v, 4); v = WS_SWZ(v, 8); v = WS_SWZ(v, 16);
    return __int_as_float(__builtin_amdgcn_readlane(__float_as_int(v), 0)) + __int_as_float(__builtin_amdgcn_readlane(__float_as_int(v), 32));
}
__device__ __forceinline__ unsigned pk4_fp8(float a, float b, float c, float d) {
    a = __builtin_fminf(__builtin_fmaxf(a, -448.f), 448.f); b = __builtin_fminf(__builtin_fmaxf(b, -448.f), 448.f); c = __builtin_fminf(__builtin_fmaxf(c, -448.f), 448.f); d = __builtin_fminf(__builtin_fmaxf(d, -448.f), 448.f);
    unsigned w = 0; w = __builtin_amdgcn_cvt_pk_fp8_f32(a, b, w, false); w = __builtin_amdgcn_cvt_pk_fp8_f32(c, d, w, true); return w; }
#define LDS_WAIT() asm volatile("s_waitcnt lgkmcnt(0)" ::: "memory")

#define XB_TMO      128
#define XB_XCNT(j)  (256  + 64 * (j))
#define XB_XSUB(j)  (1280 + 64 * (j))
#define XB_XGEN(j)  (2304 + 64 * (j))
#define XB_TOP      3328
#define XB_TOPGEN   3392
#define XCD_BAR_WORDS 3456
#define XB_SPIN_CAP (1u << 18)
__device__ __forceinline__ unsigned xb_ld(unsigned* p)              { return __hip_atomic_load(p, __ATOMIC_RELAXED, __HIP_MEMORY_SCOPE_AGENT); }
__device__ __forceinline__ unsigned xb_add(unsigned* p, unsigned v) { return __hip_atomic_fetch_add(p, v, __ATOMIC_RELAXED, __HIP_MEMORY_SCOPE_AGENT); }
__device__ __forceinline__ unsigned xb_xcc_id() { return (unsigned)__builtin_amdgcn_s_getreg((3 << 11) | 20) & 0xFu; }
#define XB_SPIN(cond, bar) do { unsigned _sp = 0; while (cond) { __builtin_amdgcn_s_sleep(1); \
    if ((++_sp & 255u) == 0u) { if (xb_ld(&(bar)[XB_TMO])) break; if (_sp > XB_SPIN_CAP) { atomicAdd(&(bar)[XB_TMO], 1u); break; } } } } while (0)
struct XcdBarrier { unsigned* bar; unsigned x; volatile LAS unsigned* st; };
__device__ __forceinline__ XcdBarrier xcd_barrier_post(unsigned* bar, volatile LAS unsigned* st) {
    XcdBarrier b; b.bar = bar; b.x = xb_xcc_id(); b.st = st;
    if (threadIdx.x == 0) (void)xb_add(&bar[XB_XCNT(b.x)], 1u);
    return b;
}
__device__ __forceinline__ void xcd_barrier_complete(unsigned* bar, unsigned x, unsigned& nloc, unsigned& nx) {
    const unsigned G = gridDim.x * gridDim.y * gridDim.z;
    unsigned sum, cnt, mine, sp = 0u;
    for (;;) {
        sum = 0u; cnt = 0u; mine = 0u;
#pragma unroll
        for (unsigned j = 0; j < 16; ++j) { const unsigned c = xb_ld(&bar[XB_XCNT(j)]); sum += c; cnt += (c > 0u) ? 1u : 0u; mine = (j == x) ? c : mine; }
        if (sum == G) break;
        __builtin_amdgcn_s_sleep(1);
        if ((++sp & 255u) == 0u) { if (xb_ld(&bar[XB_TMO])) break; if (sp > XB_SPIN_CAP) { atomicAdd(&bar[XB_TMO], 1u); break; } }
    }
    nloc = mine > 0u ? mine : 1u; nx = cnt > 0u ? cnt : 1u;
}
__device__ __forceinline__ void xcd_barrier(const XcdBarrier& b) {
    asm volatile("s_waitcnt vmcnt(0)" ::: "memory");
    __syncthreads();
    if (threadIdx.x == 0) {
        unsigned* bar = b.bar;
        __builtin_amdgcn_s_waitcnt(0);
        unsigned nloc = b.st[0], nx = b.st[1];
        if (nloc == 0u) { xcd_barrier_complete(bar, b.x, nloc, nx); b.st[0] = nloc; b.st[1] = nx; }
        const unsigned old = xb_add(&bar[XB_XSUB(b.x)], 1u);
        const unsigned gen = old / nloc;
        if (old + 1u == (gen + 1u) * nloc) {
            __builtin_amdgcn_fence(__ATOMIC_RELEASE, "agent");
            asm volatile("s_waitcnt vmcnt(0)" ::: "memory");
            const unsigned og = xb_add(&bar[XB_TOP], 1u);
            const unsigned tg = og / nx;
            if (og + 1u == (tg + 1u) * nx) xb_add(&bar[XB_TOPGEN], 1u);
            else XB_SPIN(xb_ld(&bar[XB_TOPGEN]) == tg, bar);
            __builtin_amdgcn_fence(__ATOMIC_ACQUIRE, "agent");
            xb_add(&bar[XB_XGEN(b.x)], 1u);
            asm volatile("s_waitcnt vmcnt(0)" ::: "memory");
        } else {
            XB_SPIN(xb_ld(&bar[XB_XGEN(b.x)]) == gen, bar);
            __builtin_amdgcn_fence(__ATOMIC_ACQUIRE, "agent");
            asm volatile("s_waitcnt vmcnt(0)" ::: "memory");
        }
    }
    __syncthreads();
}

namespace pg8 {
constexpr int BM = 256, BK = 64, HALF = 128, HTB = HALF * BK * 2, STAGE_BYTES = 8 * HTB, NXCD = 8, WGM = 8;
__device__ __forceinline__ int lds_byte(int r, int c) { const int st = (r >> 4) * 2 + (c >> 5), rr = r & 15, cc = c & 31, ob = rr * 64 + cc * 2; return st * 1024 + (ob ^ (((ob >> 9) & 1) << 5)); }
__device__ __forceinline__ void stage_rc(int b, int& R, int& C) { const int st = b / 1024, sb = b % 1024, swz = sb ^ (((sb >> 9) & 1) << 5); R = (st >> 1) * 16 + swz / 64; C = (st & 1) * 32 + (swz % 64) / 2; }
__device__ __forceinline__ int perm32(int rho) { const int n = rho >> 4, i = rho & 15; return 8 * (i >> 2) + 4 * n + (i & 3); }
__device__ __forceinline__ unsigned cvt_pk_bf16(float lo, float hi) { unsigned r; asm volatile("v_cvt_pk_bf16_f32 %0, %1, %2" : "=v"(r) : "v"(lo), "v"(hi)); return r; }

struct Unit { int pm, pn, ex; };

__device__ __forceinline__ int xcd_remap(int wgid, int nwg) { const int q = nwg / NXCD, r = nwg % NXCD, xcd = wgid % NXCD, off = wgid / NXCD; return (xcd < r ? xcd * (q + 1) : r * (q + 1) + (xcd - r) * q) + off; }

struct DenseOrder {
    const bf16* A; const bf16* Bt; int K, nM, nN, nwg, G, c;
    __device__ __forceinline__ void init(const bf16* A_, const bf16* Bt_, int Mr, int N, int K_, int G_, int c_) { A = A_; Bt = Bt_; K = K_; nM = Mr / BM; nN = N / BM; nwg = nM * nN; G = G_; c = c_; }
    __device__ __forceinline__ bool next(int i, Unit& u) const {
        const long L = (long)i * G + c; if (L >= nwg) return false;
        const int wgid = xcd_remap((int)L, nwg);
        const int nig = WGM * nN, gid = wgid / nig, fm = gid * WGM, gsz = (nM - fm) < WGM ? (nM - fm) : WGM;
        u.pm = fm + ((wgid % nig) % gsz); u.pn = (wgid % nig) / gsz; u.ex = 0; return true;
    }
    __device__ __forceinline__ const char* a_ptr(const Unit& u) const { return (const char*)A + (size_t)u.pm * ((size_t)BM * K * 2); }
    __device__ __forceinline__ const char* b_ptr(const Unit& u) const { return (const char*)Bt + (size_t)u.pn * ((size_t)BM * K * 2); }
    __device__ __forceinline__ void rows_raw(const Unit&, int, unsigned (&)[2][2]) const {}
};
struct MoeOrder {
    const LAS int* tab; const bf16* A; const bf16* Bt; size_t bstride; const int* list; int K, nN, G, c; bool gather;
    __device__ __forceinline__ bool next(int i, Unit& u) const {
        const int U = __builtin_amdgcn_readfirstlane(tab[1]), ng = __builtin_amdgcn_readfirstlane(tab[0]);
        const long L = (long)i * G + c; if (L >= U) return false;
        const int wgid = xcd_remap((int)L, U);
        int g = 0, hi = ng;
        while (hi - g > 1) { const int mid = (g + hi) >> 1; const int v = __builtin_amdgcn_readfirstlane(tab[64 + mid]); if (v <= wgid) g = mid; else hi = mid; }
        const int g0 = __builtin_amdgcn_readfirstlane(tab[64 + g]), t0 = __builtin_amdgcn_readfirstlane(tab[128 + g]), gsz = __builtin_amdgcn_readfirstlane(tab[192 + g]), ex = __builtin_amdgcn_readfirstlane(tab[256 + g]);
        const int local = wgid - g0;
        u.pm = t0 + local % gsz; u.pn = local / gsz; u.ex = ex; return true;
    }
    __device__ __forceinline__ const char* a_ptr(const Unit& u) const { return gather ? (const char*)A : (const char*)A + (size_t)u.pm * ((size_t)BM * K * 2); }
    __device__ __forceinline__ const char* b_ptr(const Unit& u) const { return (const char*)Bt + (size_t)u.ex * bstride + (size_t)u.pn * ((size_t)BM * K * 2); }
    __device__ __forceinline__ void rows_raw(const Unit& u, int tid, unsigned (&raw)[2][2]) const {
        asm volatile("" : "+v"(tid));
        const __amdgpu_buffer_rsrc_t rs = __builtin_amdgcn_make_buffer_rsrc((void*)(list + (size_t)u.pm * BM), (short)0, BM * 4, 0x00020000);
#pragma unroll
        for (int i = 0; i < 2; ++i) { int R, C; stage_rc(tid * 16 + i * 8192, R, C);
#pragma unroll
            for (int h = 0; h < 2; ++h) raw[h][i] = (unsigned)__builtin_amdgcn_raw_buffer_load_b32(rs, (unsigned)(h * HALF + R) * 4u, 0, 0); }
    }
};

struct EpiBf16 {
    static constexpr bool PERM = true;
    bf16* O; int ldc;
    __device__ __forceinline__ void operator()(const f32x4 (&acc)[2][2][4][2], const Unit& u, int wr, int wc, int fr, int fq) const {
        const int row0 = u.pm * BM + wr * 64 + fr, col0 = u.pn * BM + wc * 32 + 8 * fq;
#pragma unroll
        for (int ai = 0; ai < 2; ++ai)
#pragma unroll
            for (int m = 0; m < 4; ++m) { bf16* rowp = O + (size_t)(row0 + ai * HALF + m * 16) * ldc + col0;
#pragma unroll
                for (int bj = 0; bj < 2; ++bj) { const f32x4 v0 = acc[ai][bj][m][0], v1 = acc[ai][bj][m][1];
                    u32x4 w; w.x = cvt_pk_bf16(v0[0], v0[1]); w.y = cvt_pk_bf16(v0[2], v0[3]); w.z = cvt_pk_bf16(v1[0], v1[1]); w.w = cvt_pk_bf16(v1[2], v1[3]);
                    *(u32x4*)(rowp + bj * HALF) = w; } }
    }
};
struct EpiSwiglu {
    static constexpr bool PERM = true;
    bf16* O; int ldc;
    __device__ __forceinline__ void operator()(const f32x4 (&acc)[2][2][4][2], const Unit& u, int wr, int wc, int fr, int fq) const {
        const int row0 = u.pm * BM + wr * 64 + fr, col0 = u.pn * HALF + wc * 32 + 8 * fq;
#pragma unroll
        for (int ai = 0; ai < 2; ++ai)
#pragma unroll
            for (int m = 0; m < 4; ++m) { bf16* rowp = O + (size_t)(row0 + ai * HALF + m * 16) * ldc + col0;
                float o[8];
#pragma unroll
                for (int n = 0; n < 2; ++n)
#pragma unroll
                    for (int j = 0; j < 4; ++j) { const float g = acc[ai][0][m][n][j], up = acc[ai][1][m][n][j]; o[n * 4 + j] = silu_f(g) * up; }
                u32x4 w; w.x = cvt_pk_bf16(o[0], o[1]); w.y = cvt_pk_bf16(o[2], o[3]); w.z = cvt_pk_bf16(o[4], o[5]); w.w = cvt_pk_bf16(o[6], o[7]);
                *(u32x4*)rowp = w; }
    }
};
struct EpiSwigluF8 {
    static constexpr bool PERM = true;
    unsigned char* O; int ldc;
    __device__ __forceinline__ void operator()(const f32x4 (&acc)[2][2][4][2], const Unit& u, int wr, int wc, int fr, int fq) const {
        const int row0 = u.pm * BM + wr * 64 + fr, col0 = u.pn * HALF + wc * 32 + 8 * fq;
        constexpr float si = 1.0f / (SC_H * SC_W);
#pragma unroll
        for (int ai = 0; ai < 2; ++ai)
#pragma unroll
            for (int m = 0; m < 4; ++m) { unsigned char* rowp = O + (size_t)(row0 + ai * HALF + m * 16) * ldc + col0;
                float o[8];
#pragma unroll
                for (int n = 0; n < 2; ++n)
#pragma unroll
                    for (int j = 0; j < 4; ++j) { const float g = acc[ai][0][m][n][j] * si, up = acc[ai][1][m][n][j] * (si * SC_A); o[n * 4 + j] = silu_f(g) * up; }
                u32x2 w; w.x = pk4_fp8(o[0], o[1], o[2], o[3]); w.y = pk4_fp8(o[4], o[5], o[6], o[7]);
                *(u32x2*)rowp = w; }
    }
};
struct EpiResidual {
    static constexpr bool PERM = false;
    const float* xin; float* out; const float* gate;
    __device__ __forceinline__ void operator()(const f32x4 (&acc)[2][2][4][2], const Unit& u, int wr, int wc, int fr, int fq) const {
        const int row0 = u.pm * BM + wr * 64 + fr, col0 = u.pn * BM + wc * 32 + 4 * fq, b = u.pm >> 5;
        f32x4 gv[2][2];
#pragma unroll
        for (int bj = 0; bj < 2; ++bj)
#pragma unroll
            for (int n = 0; n < 2; ++n) gv[bj][n] = *(const f32x4*)(gate + (size_t)b * NMOD + col0 + bj * HALF + n * 16);
#pragma unroll
        for (int ai = 0; ai < 2; ++ai)
#pragma unroll
            for (int m = 0; m < 4; ++m) { const size_t off = (size_t)(row0 + ai * HALF + m * 16) * D + col0;
#pragma unroll
                for (int bj = 0; bj < 2; ++bj)
#pragma unroll
                    for (int n = 0; n < 2; ++n) { const f32x4 xs = *(const f32x4*)(xin + off + bj * HALF + n * 16); *(f32x4*)(out + off + bj * HALF + n * 16) = xs + gv[bj][n] * acc[ai][bj][m][n]; }
                asm volatile("" ::: "memory"); }
    }
};
struct EpiMoeDown {
    static constexpr bool PERM = false;
    float* out; const int* list; const float* wgt; const float* gate; float ascale; float* dump;
    __device__ __forceinline__ void operator()(const f32x4 (&acc)[2][2][4][2], const Unit& u, int wr, int wc, int fr, int fq) const {
        const int pos0 = u.pm * BM + wr * 64 + fr, col0 = u.pn * BM + wc * 32 + 4 * fq;
#pragma unroll
        for (int ai = 0; ai < 2; ++ai)
#pragma unroll
            for (int m = 0; m < 4; ++m) { const int pos = pos0 + ai * HALF + m * 16; const int tk = list[pos]; const float w = wgt[pos] * ascale;
                float* orow = (tk >= 0 ? out + (size_t)tk * D : dump) + col0; const float* gp = gate + (size_t)(tk >= 0 ? (tk >> 13) : 0) * NMOD + col0;
#pragma unroll
                for (int bj = 0; bj < 2; ++bj)
#pragma unroll
                    for (int n = 0; n < 2; ++n) { const f32x4 gq = *(const f32x4*)(gp + bj * HALF + n * 16); const f32x4 xs = *(const f32x4*)(orow + bj * HALF + n * 16);
                        *(f32x4*)(orow + bj * HALF + n * 16) = xs + (gq * w) * acc[ai][bj][m][n]; }
                asm volatile("" ::: "memory"); }
    }
};

template <class Epi, class Sched, bool GATHER, bool FP8 = false>
__device__ __forceinline__ void gemm_phase(LAS unsigned char* lds, const int K, const Sched& S, const Epi& E, LAS u32x4* goff = nullptr) {
    int tid_ = threadIdx.x; asm volatile("" : "+v"(tid_));
    const int tid = tid_, wid = __builtin_amdgcn_readfirstlane(tid >> 6), lane = tid & 63, wr = wid >> 2, wc = wid & 3, fr = lane & 15, fq = lane >> 4;
    int nt = K / BK; asm volatile("" : "+s"(nt));
    unsigned voffB[2], ao[2][2], no[2][2];
    const size_t kstep = (size_t)(BK * 2);
    const size_t hstep = (size_t)HALF * K * 2;
#pragma unroll
    for (int i = 0; i < 2; ++i) { int R, C; stage_rc(tid * 16 + i * 8192, R, C); const int Rb = Epi::PERM ? ((R & ~31) + perm32(R & 31)) : R;
        voffB[i] = (unsigned)(Rb * K + C) * 2u;
        ao[0][i] = (unsigned)(R * K + C) * 2u; ao[1][i] = ao[0][i] + (unsigned)hstep; no[0][i] = ao[0][i]; no[1][i] = ao[1][i]; }
    const unsigned ldsw = (unsigned)wid * 1024u;
    const int aoff = lds_byte(wr * 64 + fr, fq * 8), boff = lds_byte(wc * 32 + fr, fq * 8);
#define PG8_CB(i) ([&]() { int t_ = tid; asm volatile("" : "+v"(t_)); int R_, C_; stage_rc(t_ * 16 + (i) * 8192, R_, C_); return (unsigned)C_ * 2u; }())
#define PG8_SA(b, h) (((b) * 2 + (h)) * HTB)
#define PG8_SB(b, h) ((4 + (b) * 2 + (h)) * HTB)
#define PG8_STAGEB(bufoff, gbase) do { _Pragma("unroll") for (int _i = 0; _i < 2; ++_i) \
        __builtin_amdgcn_global_load_lds((const unsigned*)((const char*)(gbase) + voffB[_i]), (LAS unsigned*)(lds + (bufoff) + ldsw + _i * 8192), 16, 0, 0); } while (0)
#define PG8_STAGEA(bufoff, gbase, offs, h) do { _Pragma("unroll") for (int _i = 0; _i < 2; ++_i) \
        __builtin_amdgcn_global_load_lds((const unsigned*)((const char*)(gbase) + (offs)[h][_i]), (LAS unsigned*)(lds + (bufoff) + ldsw + _i * 8192), 16, 0, 0); } while (0)
#define PG8_LD32(p) __builtin_shufflevector(*(const LAS i32x4*)(p), *(const LAS i32x4*)((p) + 1024), 0, 1, 2, 3, 4, 5, 6, 7)
#define PG8_LDA(dst, b, h) do { _Pragma("unroll") for (int m = 0; m < 4; ++m) { if constexpr (FP8) dst##8[m] = PG8_LD32(lds + PG8_SA(b, h) + aoff + m * 2048); \
        else { _Pragma("unroll") for (int k = 0; k < 2; ++k) dst[m][k] = *(const LAS bf16x8*)(lds + PG8_SA(b, h) + aoff + m * 2048 + k * 1024); } } } while (0)
#define PG8_LDB(dst, b, h) do { _Pragma("unroll") for (int n = 0; n < 2; ++n) { if constexpr (FP8) dst##8[n] = PG8_LD32(lds + PG8_SB(b, h) + boff + n * 2048); \
        else { _Pragma("unroll") for (int k = 0; k < 2; ++k) dst[n][k] = *(const LAS bf16x8*)(lds + PG8_SB(b, h) + boff + n * 2048 + k * 1024); } } } while (0)
#define PG8_MMA(ai, bj, At, Bt) do { __builtin_amdgcn_s_setprio(1); _Pragma("unroll") for (int m = 0; m < 4; ++m) _Pragma("unroll") for (int n = 0; n < 2; ++n) { \
        if constexpr (FP8) asm volatile("v_mfma_scale_f32_16x16x128_f8f6f4 %0, %1, %2, %0, %3, %3 op_sel_hi:[0,0,0]" : "+v"(acc[ai][bj][m][n]) : "v"(Bt##8[n]), "v"(At##8[m]), "v"(sc1));     \
        else { _Pragma("unroll") for (int k = 0; k < 2; ++k) acc[ai][bj][m][n] = __builtin_amdgcn_mfma_f32_16x16x32_bf16(Bt[n][k], At[m][k], acc[ai][bj][m][n], 0, 0, 0); } } \
        __builtin_amdgcn_s_setprio(0); } while (0)
#define PG8_WAIT_V(n) asm volatile("s_waitcnt vmcnt(" #n ")" ::: "memory")
#define PG8_WAIT_L(n) asm volatile("s_waitcnt lgkmcnt(" #n ")" ::: "memory")
#define PG8_BAR __builtin_amdgcn_s_barrier()
#define PG8_SCHED __builtin_amdgcn_sched_barrier(0)
    Unit cur, nxt, nn; int ui = 0;
    if (!S.next(0, cur)) return;
    bool has_next = S.next(1, nxt);
    if constexpr (GATHER) {
        unsigned raw[2][2]; S.rows_raw(cur, tid, raw);
#pragma unroll
        for (int h = 0; h < 2; ++h)
#pragma unroll
            for (int i = 0; i < 2; ++i) ao[h][i] = (raw[h][i] & 0xffffffu) * (unsigned)(K * 2) + PG8_CB(i);
        if (has_next) { S.rows_raw(nxt, tid, raw);
#pragma unroll
            for (int h = 0; h < 2; ++h)
#pragma unroll
                for (int i = 0; i < 2; ++i) no[h][i] = (raw[h][i] & 0xffffffu) * (unsigned)(K * 2) + PG8_CB(i); }
        else {
#pragma unroll
            for (int h = 0; h < 2; ++h)
#pragma unroll
                for (int i = 0; i < 2; ++i) no[h][i] = ao[h][i]; }
        goff[tid] = (u32x4){no[0][0], no[0][1], no[1][0], no[1][1]};
    }
    f32x4 acc[2][2][4][2];
#pragma unroll
    for (int a = 0; a < 2; ++a)
#pragma unroll
        for (int b = 0; b < 2; ++b)
#pragma unroll
            for (int m = 0; m < 4; ++m)
#pragma unroll
                for (int n = 0; n < 2; ++n) acc[a][b][m][n] = (f32x4){0.f, 0.f, 0.f, 0.f};
    const int sc1 = 0x7f7f7f7f;
    bf16x8 At[4][2], B0[2][2], B1[2][2];
    i32x8 At8[4], B08[2], B18[2];
    const char* cA = S.a_ptr(cur); const char* cB = S.b_ptr(cur);
    PG8_STAGEB(PG8_SB(0, 0), cB); PG8_STAGEB(PG8_SB(0, 1), cB + hstep); PG8_STAGEA(PG8_SA(0, 0), cA, ao, 0); PG8_STAGEA(PG8_SA(0, 1), cA, ao, 1);
    if (wr == 1) PG8_BAR;
    PG8_WAIT_V(2); PG8_BAR;
    PG8_STAGEB(PG8_SB(1, 0), cB + kstep); PG8_STAGEA(PG8_SA(1, 0), cA + kstep, ao, 0); PG8_STAGEB(PG8_SB(1, 1), cB + hstep + kstep);
    PG8_WAIT_V(6); PG8_BAR;
    for (;;) {
        const char* nA = has_next ? S.a_ptr(nxt) : cA; const char* nB = has_next ? S.b_ptr(nxt) : cB;
#pragma clang loop unroll(disable)
        for (int t = 0; t < nt; t += 2) {
            const bool last = (t == nt - 2);
            const char* a1 = cA + (size_t)(t + 1) * kstep;
            const char* a2 = last ? nA : cA + (size_t)(t + 2) * kstep; const char* b2 = last ? nB : cB + (size_t)(t + 2) * kstep;
            const char* a3 = a2 + kstep; const char* b3 = b2 + kstep;
            asm volatile("" : "+v"(voffB[0]), "+v"(voffB[1]), "+v"(ao[0][0]), "+v"(ao[0][1]), "+v"(ao[1][0]), "+v"(ao[1][1]));
            PG8_LDB(B0, 0, 0); PG8_LDB(B1, 0, 1); PG8_SCHED; PG8_LDA(At, 0, 0); PG8_STAGEA(PG8_SA(1, 1), a1, ao, 1);
            if constexpr (GATHER) { if (last) { const u32x4 q = goff[tid]; ao[0][0] = q[0]; ao[0][1] = q[1]; ao[1][0] = q[2]; ao[1][1] = q[3]; } }
            PG8_WAIT_V(8); PG8_WAIT_L(0); PG8_BAR; PG8_MMA(0, 0, At, B0); PG8_MMA(0, 1, At, B1); PG8_BAR; PG8_SCHED;
            PG8_LDA(At, 0, 1); PG8_STAGEB(PG8_SB(0, 0), b2); PG8_STAGEB(PG8_SB(0, 1), b2 + hstep); PG8_STAGEA(PG8_SA(0, 0), a2, ao, 0);
            PG8_WAIT_V(8); PG8_WAIT_L(0); PG8_BAR; PG8_MMA(1, 0, At, B0); PG8_MMA(1, 1, At, B1); PG8_BAR; PG8_SCHED;
            PG8_LDB(B0, 1, 0); PG8_LDB(B1, 1, 1); PG8_SCHED; PG8_LDA(At, 1, 0); PG8_STAGEA(PG8_SA(0, 1), a2, ao, 1);
            PG8_WAIT_V(8); PG8_WAIT_L(0); PG8_BAR; PG8_MMA(0, 0, At, B0); PG8_MMA(0, 1, At, B1); PG8_BAR; PG8_SCHED;
            PG8_LDA(At, 1, 1); PG8_STAGEB(PG8_SB(1, 0), b3); PG8_STAGEB(PG8_SB(1, 1), b3 + hstep); PG8_STAGEA(PG8_SA(1, 0), a3, ao, 0);
            PG8_WAIT_V(8); PG8_WAIT_L(0); PG8_BAR; PG8_MMA(1, 0, At, B0); PG8_MMA(1, 1, At, B1); PG8_BAR; PG8_SCHED;
        }
        if (wr == 0) PG8_BAR;
        if constexpr (FP8) asm volatile("s_nop 15\n\ts_nop 15\n\ts_nop 7" ::: "memory");
        bool has_nn = false; unsigned raw[2][2];
        if (has_next) has_nn = S.next(ui + 2, nn);
        if constexpr (GATHER) { if (has_nn) S.rows_raw(nn, tid, raw); }
        E(acc, cur, wr, wc, fr, fq);
        if (!has_next) break;
#pragma unroll
        for (int a = 0; a < 2; ++a)
#pragma unroll
            for (int b = 0; b < 2; ++b)
#pragma unroll
                for (int m = 0; m < 4; ++m)
#pragma unroll
                    for (int n = 0; n < 2; ++n) acc[a][b][m][n] = (f32x4){0.f, 0.f, 0.f, 0.f};
        if constexpr (GATHER) {
            if (has_nn) { u32x4 q;
#pragma unroll
                for (int h = 0; h < 2; ++h)
#pragma unroll
                    for (int i = 0; i < 2; ++i) q[h * 2 + i] = (raw[h][i] & 0xffffffu) * (unsigned)(K * 2) + PG8_CB(i);
                goff[tid] = q; }
        }
        cur = nxt; cA = nA; cB = nB; nxt = nn; has_next = has_nn; ++ui;
        if (wr == 1) PG8_BAR;
    }
    PG8_WAIT_V(0);
    PG8_BAR;
#undef PG8_SA
#undef PG8_CB
#undef PG8_SB
#undef PG8_STAGEA
#undef PG8_STAGEB
#undef PG8_LDA
#undef PG8_LDB
#undef PG8_MMA
#undef PG8_LD32
#undef PG8_WAIT_V
#undef PG8_WAIT_L
#undef PG8_BAR
#undef PG8_SCHED
}
}

struct Args { const float* in[27]; float* out; unsigned char* ws; };
typedef const float* cfp_t;
typedef __attribute__((address_space(4))) const cfp_t* kargp_t;
struct Frame {
    LAS unsigned char* lds;
    int tid, lane, wave, G, bid;
    kargp_t ka;
};
#define PHASE_ENTER(F) do { kargp_t _p = (F).ka; asm volatile("" : "+s"(_p)); (F).ka = _p; \
    int _t = threadIdx.x; asm volatile("" : "+v"(_t)); (F).tid = _t; (F).lane = _t & 63; (F).wave = __builtin_amdgcn_readfirstlane(_t >> 6); \
    int _g = gridDim.x; asm volatile("" : "+s"(_g)); (F).G = _g; int _b = blockIdx.x; asm volatile("" : "+s"(_b)); (F).bid = _b; } while (0)
#define KIN(k) ((F).ka[k])
#define KOUT ((float*)(F).ka[27])
#define KWS ((unsigned char*)(F).ka[28])
#define KMOD ((float*)(KWS + WS_MOD))
#define KH ((bf16*)(KWS + WS_H))
#define KPROJ ((bf16*)(KWS + WS_BIG))
#define KMIXED ((bf16*)(KWS + WS_MIXED))
#define KACT ((bf16*)(KWS + WS_BIG))

__device__ __forceinline__ void p0_transpose_item(const float* W, int K, int N, bf16* WT, int dst_row0, LAS float* scr, int kb, int nb, int lane) {
    const int k0 = 64 * kb, n0 = 32 * nb;
#pragma unroll 8
    for (int i = 0; i < 32; ++i) { const int kk = 2 * i + (lane >> 5); scr[kk * 33 + (lane & 31)] = W[(size_t)(k0 + kk) * N + n0 + (lane & 31)]; }
    LDS_WAIT(); asm volatile("" ::: "memory");
    const int c = lane & 7;
#pragma unroll
    for (int j = 0; j < 4; ++j) { const int n = (lane >> 3) + 8 * j; const LAS float* s = scr + (8 * c) * 33 + n;
        u32x4 o; o.x = pk2(s[0 * 33], s[1 * 33]); o.y = pk2(s[2 * 33], s[3 * 33]); o.z = pk2(s[4 * 33], s[5 * 33]); o.w = pk2(s[6 * 33], s[7 * 33]);
        *(u32x4*)(WT + (size_t)(dst_row0 + n) * K + k0 + 8 * c) = o; }
    LDS_WAIT(); asm volatile("" ::: "memory");
}
__device__ __forceinline__ void p0_transpose_item_f8(const float* W, int K, int N, unsigned char* WT, int dst_row0, LAS float* scr, int kb, int nb, int lane) {
    const int k0 = 64 * kb, n0 = 32 * nb;
#pragma unroll 8
    for (int i = 0; i < 32; ++i) { const int kk = 2 * i + (lane >> 5); scr[kk * 33 + (lane & 31)] = W[(size_t)(k0 + kk) * N + n0 + (lane & 31)]; }
    LDS_WAIT(); asm volatile("" ::: "memory");
    const int n = lane >> 1, kh = (lane & 1) * 32; const LAS float* sp = scr + kh * 33 + n;
#pragma unroll
    for (int q = 0; q < 2; ++q) { u32x4 o;
#pragma unroll
        for (int d = 0; d < 4; ++d) { const int kk = q * 16 + d * 4; o[d] = pk4_fp8(sp[(kk + 0) * 33] * SC_W, sp[(kk + 1) * 33] * SC_W, sp[(kk + 2) * 33] * SC_W, sp[(kk + 3) * 33] * SC_W); }
        *(u32x4*)(WT + (size_t)(dst_row0 + n) * K + k0 + kh + q * 16) = o; }
    LDS_WAIT(); asm volatile("" ::: "memory");
}
__device__ __forceinline__ int gu_row(int n) { return (n >> 7) * 256 + (n & 127); }

__device__ __forceinline__ void p0_prologue(Frame& F) {
    if (F.bid < 192) {
        LAS float* cond = (LAS float*)F.lds;
        LAS float* red = (LAS float*)(F.lds + 32768);
        const float* cin = KIN(1);
        for (int i = F.tid; i < BATCH * D; i += NTHREADS) cond[i] = silu_f(cin[i]);
        __syncthreads();
        for (int item = F.bid; item < 192; item += F.G) {
            const int l = item / 96, colbase = (item % 96) * 64, col = colbase + F.lane;
            const float* W = KIN(2) + (size_t)l * D * NMOD;
            float a[8];
#pragma unroll
            for (int b = 0; b < 8; ++b) a[b] = 0.f;
            for (int k = F.wave * 128; k < F.wave * 128 + 128; ++k) { const float w = W[(size_t)k * NMOD + col];
#pragma unroll
                for (int b = 0; b < 8; ++b) a[b] = fmaf(cond[b * D + k], w, a[b]); }
#pragma unroll
            for (int b = 0; b < 8; ++b) red[(F.wave * 8 + b) * 64 + F.lane] = a[b];
            __syncthreads();
            { const int b = F.tid >> 6, cl = F.tid & 63; float s = 0.f;
#pragma unroll
              for (int w = 0; w < 8; ++w) s += red[(w * 8 + b) * 64 + cl];
              KMOD[((size_t)l * BATCH + b) * NMOD + colbase + cl] = s + KIN(3)[(size_t)l * NMOD + colbase + cl]; }
            __syncthreads();
        }
    }
    LAS float* scr = (LAS float*)(F.lds + F.wave * 16384);
    const int gw = F.bid * NWAVES + F.wave, NGW = F.G * NWAVES;
    constexpr int I_IN = 16 * 56, I_OUT = 16 * 32, I_FG = 16 * 88, I_FD = 44 * 32, I_MG = 16 * 112, I_MD = 56 * 32;
    constexpr int NITEMS = 2 * I_IN + 2 * I_OUT + 2 * I_FG + I_FD + 16 * I_MG + 8 * I_MD;
    bf16* ws_b = (bf16*)KWS;
    for (int it = gw; it < NITEMS; it += NGW) {
        int r = it;
        if (r < 2 * I_IN) { const int l = r / I_IN; r -= l * I_IN; const int kb = r / 56, nb = r % 56;
            p0_transpose_item(KIN(6) + (size_t)l * D * D_IN, D, D_IN, (bf16*)(KWS + WS_WIN) + (size_t)l * D_IN * D, 32 * nb, scr, kb, nb, F.lane); continue; } r -= 2 * I_IN;
        if (r < 2 * I_OUT) { const int l = r / I_OUT; r -= l * I_OUT; const int kb = r / 32, nb = r % 32;
            p0_transpose_item(KIN(17) + (size_t)l * D * D, D, D, (bf16*)(KWS + WS_WOUT) + (size_t)l * D * D, 32 * nb, scr, kb, nb, F.lane); continue; } r -= 2 * I_OUT;
        if (r < 2 * I_FG) { const int up = r / I_FG; r -= up * I_FG; const int kb = r / 88, nb = r % 88;
            p0_transpose_item(up ? KIN(19) : KIN(18), D, FF, (bf16*)(KWS + WS_WGU), gu_row(32 * nb) + 128 * up, scr, kb, nb, F.lane); continue; } r -= 2 * I_FG;
        if (r < I_FD) { const int kb = r / 32, nb = r % 32;
            p0_transpose_item(KIN(20), FF, D, (bf16*)(KWS + WS_WD), 32 * nb, scr, kb, nb, F.lane); continue; } r -= I_FD;
        if (r < 16 * I_MG) { const int q = r / I_MG; r -= q * I_MG; const int up = q >> 3, e = q & 7; const int kb = r / 112, nb = r % 112;
            p0_transpose_item_f8((up ? KIN(24) : KIN(23)) + (size_t)e * D * FFE, D, FFE, (unsigned char*)(KWS + WS_MWGU) + (size_t)e * 2 * FFE * D, gu_row(32 * nb) + 128 * up, scr, kb, nb, F.lane); continue; } r -= 16 * I_MG;
        { const int e = r / I_MD; r -= e * I_MD; const int kb = r / 32, nb = r % 32;
            p0_transpose_item_f8(KIN(25) + (size_t)e * FFE * D, FFE, D, (unsigned char*)(KWS + WS_MWD) + (size_t)e * D * FFE, 32 * nb, scr, kb, nb, F.lane); }
    }
    (void)ws_b;
    if (F.bid == 0) for (int i = F.tid; i < D; i += NTHREADS) ((float*)(KWS + WS_DUMP))[i] = 0.f;
    { const float* sw = KIN(15); bf16* so = (bf16*)(KWS + WS_SGUW);
      for (int i = (F.bid * NTHREADS + F.tid) * 4; i < 2 * NH * 128 * 128; i += F.G * NTHREADS * 4) { const f32x4 v = *(const f32x4*)(sw + i); u32x2 o; o.x = pk2(v[0], v[1]); o.y = pk2(v[2], v[3]); *(u32x2*)(so + i) = o; } }
}

template <int MODE>
__device__ __forceinline__ void norm_phase(Frame& F, const float* xsrc, const float* g, const float* shiftp, const float* scalep, bf16* hdst, float* fdst) {
    LAS int* lhist = (LAS int*)(F.lds + LC_HIST);
    for (int tb = F.bid; tb < M / 256; tb += F.G) {
        const int row0 = tb * 256 + F.wave * 32, b = row0 >> 13;
        f32x4 gm[4], sh[4];
#pragma unroll
        for (int j = 0; j < 4; ++j) { const int col = 4 * F.lane + 256 * j; const f32x4 gg = *(const f32x4*)(g + col);
            if (MODE == 2) { gm[j] = gg; sh[j] = (f32x4){0.f, 0.f, 0.f, 0.f}; }
            else { const f32x4 sc = *(const f32x4*)(scalep + (size_t)b * NMOD + col); gm[j] = gg * (1.0f + sc); sh[j] = *(const f32x4*)(shiftp + (size_t)b * NMOD + col); } }
        float rbias[8];
        LAS float* rwl = (LAS float*)F.lds;
        if (MODE == 1) {
            for (int i = F.tid; i < D * NE; i += NTHREADS) rwl[(i & 7) * D + (i >> 3)] = KIN(21)[i];
#pragma unroll
            for (int e = 0; e < 8; ++e) rbias[e] = KIN(22)[e];
            if (F.tid < 16) lhist[F.tid] = 0;
            __syncthreads();
        }
        for (int r = 0; r < 32; ++r) {
            const int row = row0 + r;
            const f32x4* xr = (const f32x4*)(xsrc + (size_t)row * D) + F.lane;
            f32x4 v[4]; float ss = 0.f;
#pragma unroll
            for (int j = 0; j < 4; ++j) { v[j] = xr[64 * j]; ss += (v[j][0] * v[j][0] + v[j][1] * v[j][1]) + (v[j][2] * v[j][2] + v[j][3] * v[j][3]); }
            const float rstd = 1.0f / sqrtf(wave_sum(ss) * (1.0f / D) + EPS);
#pragma unroll
            for (int j = 0; j < 4; ++j) v[j] = (v[j] * rstd) * gm[j] + sh[j];
            if (MODE == 2) { f32x4* o = (f32x4*)(fdst + (size_t)row * D) + F.lane;
#pragma unroll
                for (int j = 0; j < 4; ++j) o[64 * j] = v[j]; }
            else if (MODE == 1) { unsigned* o = (unsigned*)((unsigned char*)hdst + (size_t)row * D) + F.lane;
#pragma unroll
                for (int j = 0; j < 4; ++j) o[64 * j] = pk4_fp8(v[j][0] * SC_H, v[j][1] * SC_H, v[j][2] * SC_H, v[j][3] * SC_H); }
            else { u32x2* o = (u32x2*)(hdst + (size_t)row * D) + F.lane;
#pragma unroll
                for (int j = 0; j < 4; ++j) { u32x2 w; w.x = pk2(v[j][0], v[j][1]); w.y = pk2(v[j][2], v[j][3]); o[64 * j] = w; } }
            if (MODE == 1) {
                float lg[8];
#pragma unroll
                for (int e = 0; e < 8; ++e) lg[e] = 0.f;
#pragma unroll
                for (int e = 0; e < 8; ++e)
#pragma unroll
                    for (int j = 0; j < 4; ++j) { const f32x4 wv = *(const LAS f32x4*)(rwl + e * D + 4 * F.lane + 256 * j);
                        lg[e] = fmaf(v[j][0], wv[0], lg[e]); lg[e] = fmaf(v[j][1], wv[1], lg[e]); lg[e] = fmaf(v[j][2], wv[2], lg[e]); lg[e] = fmaf(v[j][3], wv[3], lg[e]); }
#pragma unroll
                for (int e = 0; e < 8; ++e) lg[e] = wave_sum(lg[e]) + rbias[e];
                int i1 = 0; float v1 = lg[0];
#pragma unroll
                for (int e = 1; e < 8; ++e) if (lg[e] > v1) { v1 = lg[e]; i1 = e; }
                int i2 = -1; float v2 = -3.0e38f;
#pragma unroll
                for (int e = 0; e < 8; ++e) if (e != i1 && lg[e] > v2) { v2 = lg[e]; i2 = e; }
                const float ex = __expf(v2 - v1), w1 = 1.0f / (1.0f + ex), w2 = ex * w1;
                if (F.lane == 0) { u32x4 rec; rec.x = (unsigned)i1; rec.y = (unsigned)i2; rec.z = __float_as_uint(w1); rec.w = __float_as_uint(w2);
                    *(u32x4*)(KWS + WS_REC + (size_t)row * 16) = rec; __hip_atomic_fetch_add(&lhist[i1], 1, __ATOMIC_RELAXED, __HIP_MEMORY_SCOPE_WORKGROUP); __hip_atomic_fetch_add(&lhist[8 + i2], 1, __ATOMIC_RELAXED, __HIP_MEMORY_SCOPE_WORKGROUP); }
            }
        }
        if (MODE == 1) { __syncthreads(); if (F.tid < 16) ((int*)(KWS + WS_HIST))[tb * 16 + F.tid] = lhist[F.tid]; __syncthreads(); }
    }
}

__device__ __forceinline__ void route_phase(Frame& F) {
    LAS int* ltot = (LAS int*)(F.lds + LC_TOT); LAS int* lpre = (LAS int*)(F.lds + LC_PRE); LAS int* ltb = (LAS int*)(F.lds + LC_TBASE); LAS int* lwc = (LAS int*)(F.lds + LC_WCNT);
    const int* hist = (const int*)(KWS + WS_HIST);
    int* list = (int*)(KWS + WS_LIST); float* wgt = (float*)(KWS + WS_WGT);
    for (int tb = F.bid; tb < M / 256; tb += F.G) {
        if (F.tid < 16) { ltot[F.tid] = 0; lpre[F.tid] = 0; }
        __syncthreads();
        { const int pe = F.tid & 15, part = F.tid >> 4; int sa = 0, sp = 0;
#pragma unroll
          for (int k = 0; k < 8; ++k) { const int t = part * 8 + k; const int v = hist[t * 16 + pe]; sa += v; sp += (t < tb) ? v : 0; }
          __hip_atomic_fetch_add(&ltot[pe], sa, __ATOMIC_RELAXED, __HIP_MEMORY_SCOPE_WORKGROUP); __hip_atomic_fetch_add(&lpre[pe], sp, __ATOMIC_RELAXED, __HIP_MEMORY_SCOPE_WORKGROUP); }
        __syncthreads();
        if (F.tid < 2) { int base = 0; for (int e = 0; e < 8; ++e) { ltb[F.tid * 8 + e] = base; base += (ltot[F.tid * 8 + e] + 255) >> 8; } }
        __syncthreads();
        unsigned e01[2] = {0u, 0u}; float w01[2] = {0.f, 0.f}; int rk[2] = {0, 0};
        if (F.tid < 256) {
            const u32x4 rec = *(const u32x4*)(KWS + WS_REC + (size_t)(tb * 256 + F.tid) * 16);
            e01[0] = rec.x; e01[1] = rec.y; w01[0] = __uint_as_float(rec.z); w01[1] = __uint_as_float(rec.w);
#pragma unroll
            for (int p = 0; p < 2; ++p)
#pragma unroll
                for (int ee = 0; ee < 8; ++ee) { const unsigned long long mk = __ballot(e01[p] == (unsigned)ee);
                    if (e01[p] == (unsigned)ee) rk[p] = __builtin_popcountll(mk & ((1ull << F.lane) - 1ull));
                    if (F.lane == 0) lwc[(p * 4 + F.wave) * 8 + ee] = __builtin_popcountll(mk); }
        }
        __syncthreads();
        if (F.tid < 256) {
#pragma unroll
            for (int p = 0; p < 2; ++p) { const int e = (int)e01[p]; int off = 0;
                for (int w = 0; w < F.wave; ++w) off += lwc[(p * 4 + w) * 8 + e];
                const int pos = ltb[p * 8 + e] * 256 + lpre[p * 8 + e] + off + rk[p];
                list[p * LISTN + pos] = tb * 256 + F.tid; wgt[p * LISTN + pos] = w01[p]; }
        }
        if (tb < 16) { const int p = tb >> 3, e = tb & 7; const int lo = ltb[tb] * 256 + ltot[tb], hi = (ltb[tb] + ((ltot[tb] + 255) >> 8)) * 256;
            for (int i = lo + F.tid; i < hi; i += NTHREADS) { list[p * LISTN + i] = (int)0x80000000u; wgt[p * LISTN + i] = 0.f; } (void)e; }
        if (tb == 0 && F.tid < 16) ((int*)(KWS + WS_TOT))[F.tid] = ltot[F.tid];
        __syncthreads();
    }
}
__device__ __forceinline__ void build_group_table(Frame& F, int p, int nN) {
    LAS int* tab = (LAS int*)(F.lds + LC_GT);
    __syncthreads();
    if (F.tid == 0) { const int* tot = (const int*)(KWS + WS_TOT) + p * 8; int ng = 0, ustart = 0, tile = 0;
        for (int e = 0; e < 8; ++e) { int tl = (tot[e] + 255) >> 8;
            while (tl > 0) { const int gsz = tl < 8 ? tl : 8; tab[64 + ng] = ustart; tab[128 + ng] = tile; tab[192 + ng] = gsz; tab[256 + ng] = e; ustart += gsz * nN; tile += gsz; tl -= gsz; ++ng; } }
        tab[0] = ng; tab[1] = ustart; }
    __syncthreads();
}

__device__ __forceinline__ void mixer_unit(Frame& F, const int l, const int unit) {
    const bf16* P = KPROJ; bf16* MO = KMIXED;
    const int t0 = unit * 128, s0 = t0 & (SEQ - 1), rb = t0 - s0;
    const int lane = F.lane, wave = F.wave, tid = F.tid;
    {
        constexpr int YS = 392;
        LAS bf16* ybuf = (LAS bf16*)F.lds;
        const float* cw = KIN(9) + (size_t)l * CKW * CONVW; const float* cb = KIN(10) + (size_t)l * CONVW;
        for (int it = 0; it < 3; ++it) {
            const int wi = it * 8 + wave, seg = wi / 6, cg = wi - seg * 6, c = cg * 64 + lane;
            float w[31];
#pragma unroll
            for (int j = 0; j < 31; ++j) w[j] = cw[j * CONVW + c];
            const float bias = cb[c];
            float o[32];
#pragma unroll
            for (int i = 0; i < 32; ++i) o[i] = bias;
#pragma unroll
            for (int j = 0; j < 62; ++j) { const int s = s0 + seg * 32 - 15 + j; const bool ok = (s >= 0) && (s < SEQ); const int sc = ok ? s : s0;
                const bf16* pr = P + (size_t)(rb + sc) * D_IN + 256 + c; const float a = bf2f(pr[0]), gt = bf2f(pr[CONVW]); const float gl = ok ? a * fast_sigmoid(gt) : 0.f;
#pragma unroll
                for (int i = 0; i < 32; ++i) if (j - i >= 0 && j - i < 31) o[i] = fmaf(w[j - i], gl, o[i]); }
#pragma unroll
            for (int i = 0; i < 32; ++i) ybuf[(seg * 32 + i) * YS + c] = (bf16)f2bf(o[i]);
        }
        __syncthreads();
        float g6[6], b6[6];
#pragma unroll
        for (int k = 0; k < 3; ++k)
#pragma unroll
            for (int e = 0; e < 2; ++e) { g6[2 * k + e] = KIN(11)[l * CONVW + 128 * k + 2 * lane + e]; b6[2 * k + e] = KIN(12)[l * CONVW + 128 * k + 2 * lane + e]; }
        for (int r = 0; r < 16; ++r) { const int tk = wave * 16 + r;
            const LAS unsigned* yr = (const LAS unsigned*)(ybuf + tk * YS);
            float v[6]; float s = 0.f, q = 0.f;
#pragma unroll
            for (int k = 0; k < 3; ++k) { const unsigned u = yr[64 * k + lane]; v[2 * k] = bflo(u); v[2 * k + 1] = bfhi(u); }
#pragma unroll
            for (int k = 0; k < 6; ++k) { s += v[k]; q += v[k] * v[k]; }
            s = wave_sum(s); q = wave_sum(q);
            const float mean = s * (1.0f / CONVW), var = fmaxf(q * (1.0f / CONVW) - mean * mean, 0.f), rstd = 1.0f / sqrtf(var + EPS);
            unsigned* orow = (unsigned*)(MO + (size_t)(t0 + tk) * D + 256);
#pragma unroll
            for (int k = 0; k < 3; ++k) { const float o0 = silu_f((v[2 * k] - mean) * rstd * g6[2 * k] + b6[2 * k]), o1 = silu_f((v[2 * k + 1] - mean) * rstd * g6[2 * k + 1] + b6[2 * k + 1]);
                orow[64 * k + lane] = pk2(o0, o1); }
        }
        __syncthreads();
    }
    {
        constexpr int VS = 136;
        LAS bf16* vnT = (LAS bf16*)F.lds;
        float g6[6], b6[6];
#pragma unroll
        for (int k = 0; k < 3; ++k)
#pragma unroll
            for (int e = 0; e < 2; ++e) { g6[2 * k + e] = KIN(13)[l * CONVW + 128 * k + 2 * lane + e]; b6[2 * k + e] = KIN(14)[l * CONVW + 128 * k + 2 * lane + e]; }
        for (int r = 0; r < 16; ++r) { const int tk = wave * 16 + r;
            const unsigned* pv = (const unsigned*)(P + (size_t)(t0 + tk) * D_IN + 1408);
            float v[6]; float s = 0.f, q = 0.f;
#pragma unroll
            for (int k = 0; k < 3; ++k) { const unsigned u = pv[64 * k + lane]; v[2 * k] = bflo(u); v[2 * k + 1] = bfhi(u); }
#pragma unroll
            for (int k = 0; k < 6; ++k) { s += v[k]; q += v[k] * v[k]; }
            s = wave_sum(s); q = wave_sum(q);
            const float mean = s * (1.0f / CONVW), var = fmaxf(q * (1.0f / CONVW) - mean * mean, 0.f), rstd = 1.0f / sqrtf(var + EPS);
#pragma unroll
            for (int k = 0; k < 3; ++k)
#pragma unroll
                for (int e = 0; e < 2; ++e) vnT[(128 * k + 2 * lane + e) * VS + tk] = (bf16)f2bf((v[2 * k + e] - mean) * rstd * g6[2 * k + e] + b6[2 * k + e]);
        }
        __syncthreads();
        const bf16* sw = (const bf16*)(KWS + WS_SGUW);
        const float* sb = KIN(16) + (size_t)l * NH * 128;
        for (int tile = wave; tile < 24; tile += 8) { const int hh = tile >> 2, pb = tile & 3;
            f32x16 acc0, acc1;
#pragma unroll
            for (int i = 0; i < 16; ++i) { acc0[i] = 0.f; acc1[i] = 0.f; }
            const bf16* Wh = sw + ((size_t)((l * NH + hh) * 128 + pb * 32 + (lane & 31))) * 128 + 8 * (lane >> 5);
            const LAS bf16* Vb = vnT + (hh * 64 + (lane & 31)) * VS + 8 * (lane >> 5);
#pragma unroll
            for (int ks = 0; ks < 8; ++ks) { const bf16x8 a = *(const bf16x8*)(Wh + ks * 16);
                const bf16x8 b0 = *(const LAS bf16x8*)(Vb + ks * 16), b1 = *(const LAS bf16x8*)(Vb + 32 * VS + ks * 16);
                acc0 = __builtin_amdgcn_mfma_f32_32x32x16_bf16(a, b0, acc0, 0, 0, 0); acc1 = __builtin_amdgcn_mfma_f32_32x32x16_bf16(a, b1, acc1, 0, 0, 0); }
#pragma unroll
            for (int r = 0; r < 16; ++r) { const int p = pb * 32 + (r & 3) + 8 * (r >> 2) + 4 * (lane >> 5); const size_t row = (size_t)(t0 + p); const float bias = sb[hh * 128 + p];
                const int d0 = hh * 64 + (lane & 31);
                const float u0 = bf2f(P[row * D_IN + 1024 + d0]), u1 = bf2f(P[row * D_IN + 1024 + d0 + 32]);
                MO[row * D + 640 + d0] = (bf16)f2bf(u0 * (acc0[r] + bias)); MO[row * D + 640 + d0 + 32] = (bf16)f2bf(u1 * (acc1[r] + bias)); }
        }
        __syncthreads();
    }
    {
        constexpr int AS = 264;
        LAS bf16* abuf = (LAS bf16*)F.lds;
        LAS float* diff = (LAS float*)(F.lds + 144 * AS * 2);
        constexpr int DS = 68;
        for (int i = tid; i < 144 * 128; i += NTHREADS) { const int rr = i >> 7, cp = i & 127; const int s = s0 - 8 + rr; unsigned v = 0u;
            if (s >= 0 && s < SEQ) v = *(const unsigned*)(P + (size_t)(rb + s) * D_IN + 2 * cp);
            *(LAS unsigned*)(abuf + rr * AS + 2 * cp) = v; }
        __syncthreads();
        for (int g = 0; g < 4; ++g) {
            const int half = 1 << g;
            { const int ch = tid & 63;
              for (int k = 0; k < 16; ++k) { const int tk = (tid >> 6) + 8 * k; const int s = s0 + tk;
                  int lo = s - half; lo = lo < 0 ? 0 : lo; int hi = s + half; hi = hi > SEQ ? SEQ : hi;
                  float sum = 0.f;
                  for (int ss = lo; ss < hi; ++ss) sum += bf2f(abuf[(ss - s0 + 8) * AS + g * 64 + ch]);
                  diff[tk * DS + ch] = sum / (float)(hi - lo) - bf2f(abuf[(tk + 8) * AS + g * 64 + ch]); } }
            __syncthreads();
            { const int d = tid & 63; float w[64];
              const float* pw = KIN(7) + ((size_t)(l * 4 + g) * 64) * 64 + d;
#pragma unroll
              for (int c = 0; c < 64; ++c) w[c] = pw[c * 64];
              const float psc = KIN(8)[l * 256 + g * 64 + d];
              for (int k = 0; k < 16; ++k) { const int tk = (tid >> 6) + 8 * k; const LAS f32x4* dr = (const LAS f32x4*)(diff + tk * DS); float a = 0.f;
#pragma unroll
                  for (int c4 = 0; c4 < 16; ++c4) { const f32x4 dv = dr[c4]; a = fmaf(dv[0], w[4 * c4], a); a = fmaf(dv[1], w[4 * c4 + 1], a); a = fmaf(dv[2], w[4 * c4 + 2], a); a = fmaf(dv[3], w[4 * c4 + 3], a); }
                  MO[(size_t)(t0 + tk) * D + g * 64 + d] = (bf16)f2bf(a * psc); } }
            __syncthreads();
        }
    }
}

__global__ void __launch_bounds__(NTHREADS, 2) fwd_kernel(Args args) {
    extern __shared__ __attribute__((aligned(16))) unsigned char lds_raw[];
    Frame F;
    F.lds = (LAS unsigned char*)lds_raw;
    F.tid = threadIdx.x; F.lane = F.tid & 63; F.wave = __builtin_amdgcn_readfirstlane(F.tid >> 6); F.G = gridDim.x; F.bid = blockIdx.x;
    F.ka = (kargp_t)__builtin_amdgcn_kernarg_segment_ptr(); (void)args;
    for (int u = F.tid; u < (LDS_BYTES - LC_OFF) / 4; u += NTHREADS) ((LAS unsigned*)(F.lds + LC_OFF))[u] = 0u;
    __syncthreads();
    XcdBarrier bar = xcd_barrier_post((unsigned*)(KWS + WS_CTL) + CW_BAR, (volatile LAS unsigned*)(F.lds + LC_MISC) + 8);
#define GRID_BAR() xcd_barrier(bar)
#ifndef PROBE_DUP
#define PROBE_DUP 0
#endif
#define PROBE_REP(bit) for (int rep_ = 0; rep_ < ((PROBE_DUP & (bit)) ? 2 : 1); ++rep_)
#define MODL(l) (KMOD + (size_t)(l) * BATCH * NMOD)

    PROBE_REP(2) { PHASE_ENTER(F); p0_prologue(F); GRID_BAR(); }

#define LAYER_MIX(l) \
    PROBE_REP(2) { PHASE_ENTER(F); const float* xsrc = ((l) == 0) ? KIN(0) : (const float*)KOUT; \
        norm_phase<0>(F, xsrc, KIN(4) + (l) * D, MODL(l) + 0 * D, MODL(l) + 1 * D, KH, nullptr); GRID_BAR(); } \
    PROBE_REP(8) { PHASE_ENTER(F); pg8::DenseOrder S; S.init(KH, (const bf16*)(KWS + WS_WIN) + (size_t)(l) * D_IN * D, M, D_IN, D, F.G, F.bid); \
        pg8::EpiBf16 E{KPROJ, D_IN}; pg8::gemm_phase<pg8::EpiBf16, pg8::DenseOrder, false>(F.lds, D, S, E); GRID_BAR(); } \
    PROBE_REP(1) { PHASE_ENTER(F); for (int u = F.bid; u < M / 128; u += F.G) mixer_unit(F, (l), u); GRID_BAR(); } \
    { PHASE_ENTER(F); const float* xsrc = ((l) == 0) ? KIN(0) : (const float*)KOUT; \
        pg8::DenseOrder S; S.init(KMIXED, (const bf16*)(KWS + WS_WOUT) + (size_t)(l) * D * D, M, D, D, F.G, F.bid); \
        pg8::EpiResidual E{xsrc, KOUT, MODL(l) + 2 * D}; pg8::gemm_phase<pg8::EpiResidual, pg8::DenseOrder, false>(F.lds, D, S, E); GRID_BAR(); }
#define MOE_PASS(p) \
    PROBE_REP(4) { PHASE_ENTER(F); build_group_table(F, (p), 2 * FFE / 256); \
        pg8::MoeOrder S; S.tab = (const LAS int*)(F.lds + LC_GT); S.A = KH; S.Bt = (const bf16*)(KWS + WS_MWGU); S.bstride = (size_t)2 * FFE * D; S.list = (const int*)(KWS + WS_LIST) + (p) * LISTN; \
        S.K = D / 2; S.nN = 2 * FFE / 256; S.G = F.G; S.c = F.bid; S.gather = true; \
        pg8::EpiSwigluF8 E{(unsigned char*)KACT, FFE}; pg8::gemm_phase<pg8::EpiSwigluF8, pg8::MoeOrder, true, true>(F.lds, D / 2, S, E, (LAS u32x4*)(F.lds + LC_GOFF)); GRID_BAR(); } \
    { PHASE_ENTER(F); build_group_table(F, (p), D / 256); \
        pg8::MoeOrder S; S.tab = (const LAS int*)(F.lds + LC_GT); S.A = KACT; S.Bt = (const bf16*)(KWS + WS_MWD); S.bstride = (size_t)D * FFE; S.list = nullptr; \
        S.K = FFE / 2; S.nN = D / 256; S.G = F.G; S.c = F.bid; S.gather = false; \
        pg8::EpiMoeDown E{KOUT, (const int*)(KWS + WS_LIST) + (p) * LISTN, (const float*)(KWS + WS_WGT) + (p) * LISTN, MODL(1) + 5 * D, 1.0f / (SC_A * SC_W), (float*)(KWS + WS_DUMP)}; \
        pg8::gemm_phase<pg8::EpiMoeDown, pg8::MoeOrder, false, true>(F.lds, FFE / 2, S, E); GRID_BAR(); }

    LAYER_MIX(0)
    PROBE_REP(2) { PHASE_ENTER(F); norm_phase<0>(F, KOUT, KIN(5), MODL(0) + 3 * D, MODL(0) + 4 * D, KH, nullptr); GRID_BAR(); }
    PROBE_REP(16) { PHASE_ENTER(F); pg8::DenseOrder S; S.init(KH, (const bf16*)(KWS + WS_WGU), M, 2 * FF, D, F.G, F.bid);
        pg8::EpiSwiglu E{KACT, FF}; pg8::gemm_phase<pg8::EpiSwiglu, pg8::DenseOrder, false>(F.lds, D, S, E); GRID_BAR(); }
    { PHASE_ENTER(F); pg8::DenseOrder S; S.init(KACT, (const bf16*)(KWS + WS_WD), M, D, FF, F.G, F.bid);
        pg8::EpiResidual E{KOUT, KOUT, MODL(0) + 5 * D}; pg8::gemm_phase<pg8::EpiResidual, pg8::DenseOrder, false>(F.lds, FF, S, E); GRID_BAR(); }
    LAYER_MIX(1)
    PROBE_REP(2) { PHASE_ENTER(F); norm_phase<1>(F, KOUT, KIN(5) + D, MODL(1) + 3 * D, MODL(1) + 4 * D, KH, nullptr); GRID_BAR();
        PHASE_ENTER(F); route_phase(F); GRID_BAR(); }
    MOE_PASS(0)
    MOE_PASS(1)
    { PHASE_ENTER(F); norm_phase<2>(F, KOUT, KIN(26), nullptr, nullptr, nullptr, KOUT); }
}

extern "C" void kernel_launch(void* const* d_in, const int* in_sizes, int n_in, void* d_out, int out_size, void* d_ws, size_t ws_size, hipStream_t stream) {
    static int grid = 0;
    if (grid == 0) {
        if (n_in != 27 || in_sizes[0] != M * D || out_size != M * D || ws_size < WS_END) { fprintf(stderr, "kernel_launch: unexpected shapes (n_in %d, in0 %d, out %d, ws %zu < %zu); nothing launched\n", n_in, n_in > 0 ? in_sizes[0] : -1, out_size, ws_size, (size_t)WS_END); grid = -1; return; }
        int dev = 0, cus = 0, per_cu = 0;
        if (hipGetDevice(&dev) != hipSuccess || hipDeviceGetAttribute(&cus, hipDeviceAttributeMultiprocessorCount, dev) != hipSuccess) { grid = -1; return; }
        if (hipFuncSetAttribute((const void*)fwd_kernel, hipFuncAttributeMaxDynamicSharedMemorySize, LDS_BYTES) != hipSuccess) { fprintf(stderr, "kernel_launch: hipFuncSetAttribute failed\n"); grid = -1; return; }
        if (hipOccupancyMaxActiveBlocksPerMultiprocessor(&per_cu, (const void*)fwd_kernel, NTHREADS, LDS_BYTES) != hipSuccess || per_cu < 1) { fprintf(stderr, "kernel_launch: occupancy query says %d blocks per CU\n", per_cu); }
        (void)hipGetLastError();
        grid = cus;
    }
    if (grid < 0) return;
    if (hipMemsetAsync((char*)d_ws + WS_CTL, 0, CTL_ZERO_BYTES, stream) != hipSuccess) return;
    Args a{};
    for (int i = 0; i < 27; ++i) a.in[i] = (const float*)d_in[i];
    a.out = (float*)d_out; a.ws = (unsigned char*)d_ws;
    hipLaunchKernelGGL(fwd_kernel, dim3(grid), dim3(NTHREADS), LDS_BYTES, stream, a);
}
```

```cpp
#include <hip/hip_runtime.h>
#include <cstdio>
#include <cstdint>

#define GAS __attribute__((address_space(1)))
#define LAS __attribute__((address_space(3)))
typedef unsigned short bf16;
typedef short bf16x8 __attribute__((ext_vector_type(8)));
typedef float f32x4 __attribute__((ext_vector_type(4)));
typedef float f32x16 __attribute__((ext_vector_type(16)));
typedef unsigned u32x4 __attribute__((ext_vector_type(4)));
typedef unsigned u32x2 __attribute__((ext_vector_type(2)));
typedef int i32x4 __attribute__((ext_vector_type(4)));
typedef int i32x8 __attribute__((ext_vector_type(8)));
constexpr float SC_W = 256.0f, SC_H = 16.0f, SC_A = 4.0f;

constexpr int NWAVES = 8, NTHREADS = 512;
constexpr int BATCH = 8, SEQ = 8192, D = 1024, M = BATCH * SEQ;
constexpr int D_IN = 1792, FF = 2816, FFE = 3584, NE = 8, NMOD = 6 * D;
constexpr int CONVW = 384, CKW = 31, NH = 6;
constexpr float EPS = 1e-6f;
constexpr int LISTN = M + NE * 256;

constexpr size_t MiB = 1u << 20;
constexpr size_t WS_CTL = 0, CTL_ZERO_BYTES = 1 * MiB;
constexpr size_t WS_MOD = 1 * MiB;
constexpr size_t WS_HIST = 2 * MiB;
constexpr size_t WS_TOT = 2 * MiB + 65536;
constexpr size_t WS_DUMP = 2 * MiB + 131072;
constexpr size_t WS_REC = 3 * MiB;
constexpr size_t WS_LIST = 4 * MiB;
constexpr size_t WS_WGT = 5 * MiB;
constexpr size_t WS_SGUW = 6 * MiB;
constexpr size_t WS_POOLW = 6 * MiB + 524288;
constexpr size_t WS_WIN = 8 * MiB;
constexpr size_t WS_WOUT = 15 * MiB;
constexpr size_t WS_WGU = 19 * MiB;
constexpr size_t WS_WD = 30 * MiB;
constexpr size_t WS_MWGU = 36 * MiB;
constexpr size_t WS_MWD = 148 * MiB;
constexpr size_t WS_H = 204 * MiB;
constexpr size_t WS_BIG = 332 * MiB;
constexpr size_t WS_MIXED = WS_BIG + (size_t)M * D_IN * 2;
constexpr size_t WS_END = WS_BIG + (size_t)LISTN * FFE * 2;
static_assert(WS_MIXED + (size_t)M * D * 2 <= WS_END && (size_t)M * FF * 2 <= (size_t)LISTN * FFE * 2, "ws map");
constexpr int CW_BAR = 4096;

constexpr int RING_BYTES = 131072;
constexpr int LC_OFF = RING_BYTES;
constexpr int LC_MISC = LC_OFF;
constexpr int LC_HIST = LC_OFF + 64;
constexpr int LC_TOT = LC_OFF + 128;
constexpr int LC_PRE = LC_OFF + 192;
constexpr int LC_TBASE = LC_OFF + 256;
constexpr int LC_WCNT = LC_OFF + 320;
constexpr int LC_GT = LC_OFF + 1024;
constexpr int LC_GOFF = LC_OFF + 4096;
constexpr int LDS_BYTES = RING_BYTES + 4096 + 8192;

__device__ __forceinline__ unsigned f2bf(float f) { unsigned u = __builtin_bit_cast(unsigned, f); return (u + 0x7fffu + ((u >> 16) & 1u)) >> 16; }
__device__ __forceinline__ unsigned pk2(float lo, float hi) { return f2bf(lo) | (f2bf(hi) << 16); }
__device__ __forceinline__ float bf2f(unsigned b) { return __builtin_bit_cast(float, b << 16); }
__device__ __forceinline__ float bflo(unsigned u) { return __builtin_bit_cast(float, u << 16); }
__device__ __forceinline__ float bfhi(unsigned u) { return __builtin_bit_cast(float, u & 0xffff0000u); }
__device__ __forceinline__ float fast_sigmoid(float x) { return __builtin_amdgcn_rcpf(1.0f + __builtin_amdgcn_exp2f(-1.44269504089f * x)); }
__device__ __forceinline__ float silu_f(float x) { return x * fast_sigmoid(x); }
#define WS_SWZ(v, o) ((v) + __int_as_float(__builtin_amdgcn_ds_swizzle(__float_as_int(v), 0x1f | ((o) << 10))))
__device__ __forceinline__ float wave_sum(float v) {
    v = WS_SWZ(v, 1); v = WS_SWZ(v, 2); v = WS_SWZ(v, 4); v = WS_SWZ(v, 8); v = WS_SWZ(v, 16);
    return __int_as_float(__builtin_amdgcn_readlane(__float_as_int(v), 0)) + __int_as_float(__builtin_amdgcn_readlane(__float_as_int(v), 32));
}
__device__ __forceinline__ unsigned pk4_fp8(float a, float b, float c, float d) {
    a = __builtin_fminf(__builtin_fmaxf(a, -448.f), 448.f); b = __builtin_fminf(__builtin_fmaxf(b, -448.f), 448.f); c = __builtin_fminf(__builtin_fmaxf(c, -448.f), 448.f); d = __builtin_fminf(__builtin_fmaxf(d, -448.f), 448.f);
    unsigned w = 0; w = __builtin_amdgcn_cvt_pk_fp8_f32(a, b, w, false); w = __builtin_amdgcn_cvt_pk_fp8_f32(c, d, w, true); return w; }
#define LDS_WAIT() asm volatile("s_waitcnt lgkmcnt(0)" ::: "memory")

#define XB_TMO      128
#define XB_XCNT(j)  (256  + 64 * (j))
#define XB_XSUB(j)  (1280 + 64 * (j))
#define XB_XGEN(j)  (2304 + 64 * (j))
#define XB_TOP      3328
#define XB_TOPGEN   3392
#define XCD_BAR_WORDS 3456
#define XB_SPIN_CAP (1u << 18)
__device__ __forceinline__ unsigned xb_ld(unsigned* p)              { return __hip_atomic_load(p, __ATOMIC_RELAXED, __HIP_MEMORY_SCOPE_AGENT); }
__device__ __forceinline__ unsigned xb_add(unsigned* p, unsigned v) { return __hip_atomic_fetch_add(p, v, __ATOMIC_RELAXED, __HIP_MEMORY_SCOPE_AGENT); }
__device__ __forceinline__ unsigned xb_xcc_id() { return (unsigned)__builtin_amdgcn_s_getreg((3 << 11) | 20) & 0xFu; }
#define XB_SPIN(cond, bar) do { unsigned _sp = 0; while (cond) { __builtin_amdgcn_s_sleep(1); \
    if ((++_sp & 255u) == 0u) { if (xb_ld(&(bar)[XB_TMO])) break; if (_sp > XB_SPIN_CAP) { atomicAdd(&(bar)[XB_TMO], 1u); break; } } } } while (0)
struct XcdBarrier { unsigned* bar; unsigned x; volatile LAS unsigned* st; };
__device__ __forceinline__ XcdBarrier xcd_barrier_post(unsigned* bar, volatile LAS unsigned* st) {
    XcdBarrier b; b.bar = bar; b.x = xb_xcc_id(); b.st = st;
    if (threadIdx.x == 0) (void)xb_add(&bar[XB_XCNT(b.x)], 1u);
    return b;
}
__device__ __forceinline__ void xcd_barrier_complete(unsigned* bar, unsigned x, unsigned& nloc, unsigned& nx) {
    const unsigned G = gridDim.x * gridDim.y * gridDim.z;
    unsigned sum, cnt, mine, sp = 0u;
    for (;;) {
        sum = 0u; cnt = 0u; mine = 0u;
#pragma unroll
        for (unsigned j = 0; j < 16; ++j) { const unsigned c = xb_ld(&bar[XB_XCNT(j)]); sum += c; cnt += (c > 0u) ? 1u : 0u; mine = (j == x) ? c : mine; }
        if (sum == G) break;
        __builtin_amdgcn_s_sleep(1);
        if ((++sp & 255u) == 0u) { if (xb_ld(&bar[XB_TMO])) break; if (sp > XB_SPIN_CAP) { atomicAdd(&bar[XB_TMO], 1u); break; } }
    }
    nloc = mine > 0u ? mine : 1u; nx = cnt > 0u ? cnt : 1u;
}
__device__ __forceinline__ void xcd_barrier(const XcdBarrier& b) {
    asm volatile("s_waitcnt vmcnt(0)" ::: "memory");
    __syncthreads();
    if (threadIdx.x == 0) {
        unsigned* bar = b.bar;
        __builtin_amdgcn_s_waitcnt(0);
        unsigned nloc = b.st[0], nx = b.st[1];
        if (nloc == 0u) { xcd_barrier_complete(bar, b.x, nloc, nx); b.st[0] = nloc; b.st[1] = nx; }
        const unsigned old = xb_add(&bar[XB_XSUB(b.x)], 1u);
        const unsigned gen = old / nloc;
        if (old + 1u == (gen + 1u) * nloc) {
            __builtin_amdgcn_fence(__ATOMIC_RELEASE, "agent");
            asm volatile("s_waitcnt vmcnt(0)" ::: "memory");
            const unsigned og = xb_add(&bar[XB_TOP], 1u);
            const unsigned tg = og / nx;
            if (og + 1u == (tg + 1u) * nx) xb_add(&bar[XB_TOPGEN], 1u);
            else XB_SPIN(xb_ld(&bar[XB_TOPGEN]) == tg, bar);
            __builtin_amdgcn_fence(__ATOMIC_ACQUIRE, "agent");
            xb_add(&bar[XB_XGEN(b.x)], 1u);
            asm volatile("s_waitcnt vmcnt(0)" ::: "memory");
        } else {
            XB_SPIN(xb_ld(&bar[XB_XGEN(b.x)]) == gen, bar);
            __builtin_amdgcn_fence(__ATOMIC_ACQUIRE, "agent");
            asm volatile("s_waitcnt vmcnt(0)" ::: "memory");
        }
    }
    __syncthreads();
}

namespace pg8 {
constexpr int BM = 256, BK = 64, HALF = 128, HTB = HALF * BK * 2, STAGE_BYTES = 8 * HTB, NXCD = 8, WGM = 8;
__device__ __forceinline__ int lds_byte(int r, int c) { const int st = (r >> 4) * 2 + (c >> 5), rr = r & 15, cc = c & 31, ob = rr * 64 + cc * 2; return st * 1024 + (ob ^ (((ob >> 9) & 1) << 5)); }
__device__ __forceinline__ void stage_rc(int b, int& R, int& C) { const int st = b / 1024, sb = b % 1024, swz = sb ^ (((sb >> 9) & 1) << 5); R = (st >> 1) * 16 + swz / 64; C = (st & 1) * 32 + (swz % 64) / 2; }
__device__ __forceinline__ int perm32(int rho) { const int n = rho >> 4, i = rho & 15; return 8 * (i >> 2) + 4 * n + (i & 3); }
__device__ __forceinline__ unsigned cvt_pk_bf16(float lo, float hi) { unsigned r; asm volatile("v_cvt_pk_bf16_f32 %0, %1, %2" : "=v"(r) : "v"(lo), "v"(hi)); return r; }

struct Unit { int pm, pn, ex; };

__device__ __forceinline__ int xcd_remap(int wgid, int nwg) { const int q = nwg / NXCD, r = nwg % NXCD, xcd = wgid % NXCD, off = wgid / NXCD; return (xcd < r ? xcd * (q + 1) : r * (q + 1) + (xcd - r) * q) + off; }

struct DenseOrder {
    const bf16* A; const bf16* Bt; int K, nM, nN, nwg, G, c;
    __device__ __forceinline__ void init(const bf16* A_, const bf16* Bt_, int Mr, int N, int K_, int G_, int c_) { A = A_; Bt = Bt_; K = K_; nM = Mr / BM; nN = N / BM; nwg = nM * nN; G = G_; c = c_; }
    __device__ __forceinline__ bool next(int i, Unit& u) const {
        const long L = (long)i * G + c; if (L >= nwg) return false;
        const int wgid = xcd_remap((int)L, nwg);
        const int nig = WGM * nN, gid = wgid / nig, fm = gid * WGM, gsz = (nM - fm) < WGM ? (nM - fm) : WGM;
        u.pm = fm + ((wgid % nig) % gsz); u.pn = (wgid % nig) / gsz; u.ex = 0; return true;
    }
    __device__ __forceinline__ const char* a_ptr(const Unit& u) const { return (const char*)A + (size_t)u.pm * ((size_t)BM * K * 2); }
    __device__ __forceinline__ const char* b_ptr(const Unit& u) const { return (const char*)Bt + (size_t)u.pn * ((size_t)BM * K * 2); }
    __device__ __forceinline__ void rows_raw(const Unit&, int, unsigned (&)[2][2]) const {}
};
struct MoeOrder {
    const LAS int* tab; const bf16* A; const bf16* Bt; size_t bstride; const int* list; int K, nN, G, c; bool gather;
    __device__ __forceinline__ bool next(int i, Unit& u) const {
        const int U = __builtin_amdgcn_readfirstlane(tab[1]), ng = __builtin_amdgcn_readfirstlane(tab[0]);
        const long L = (long)i * G + c; if (L >= U) return false;
        const int wgid = xcd_remap((int)L, U);
        int g = 0, hi = ng;
        while (hi - g > 1) { const int mid = (g + hi) >> 1; const int v = __builtin_amdgcn_readfirstlane(tab[64 + mid]); if (v <= wgid) g = mid; else hi = mid; }
        const int g0 = __builtin_amdgcn_readfirstlane(tab[64 + g]), t0 = __builtin_amdgcn_readfirstlane(tab[128 + g]), gsz = __builtin_amdgcn_readfirstlane(tab[192 + g]), ex = __builtin_amdgcn_readfirstlane(tab[256 + g]);
        const int local = wgid - g0;
        u.pm = t0 + local % gsz; u.pn = local / gsz; u.ex = ex; return true;
    }
    __device__ __forceinline__ const char* a_ptr(const Unit& u) const { return gather ? (const char*)A : (const char*)A + (size_t)u.pm * ((size_t)BM * K * 2); }
    __device__ __forceinline__ const char* b_ptr(const Unit& u) const { return (const char*)Bt + (size_t)u.ex * bstride + (size_t)u.pn * ((size_t)BM * K * 2); }
    __device__ __forceinline__ void rows_raw(const Unit& u, int tid, unsigned (&raw)[2][2]) const {
        asm volatile("" : "+v"(tid));
        const __amdgpu_buffer_rsrc_t rs = __builtin_amdgcn_make_buffer_rsrc((void*)(list + (size_t)u.pm * BM), (short)0, BM * 4, 0x00020000);
#pragma unroll
        for (int i = 0; i < 2; ++i) { int R, C; stage_rc(tid * 16 + i * 8192, R, C);
#pragma unroll
            for (int h = 0; h < 2; ++h) raw[h][i] = (unsigned)__builtin_amdgcn_raw_buffer_load_b32(rs, (unsigned)(h * HALF + R) * 4u, 0, 0); }
    }
};

struct EpiBf16 {
    static constexpr bool PERM = true;
    bf16* O; int ldc;
    __device__ __forceinline__ void operator()(const f32x4 (&acc)[2][2][4][2], const Unit& u, int wr, int wc, int fr, int fq) const {
        const int row0 = u.pm * BM + wr * 64 + fr, col0 = u.pn * BM + wc * 32 + 8 * fq;
#pragma unroll
        for (int ai = 0; ai < 2; ++ai)
#pragma unroll
            for (int m = 0; m < 4; ++m) { bf16* rowp = O + (size_t)(row0 + ai * HALF + m * 16) * ldc + col0;
#pragma unroll
                for (int bj = 0; bj < 2; ++bj) { const f32x4 v0 = acc[ai][bj][m][0], v1 = acc[ai][bj][m][1];
                    u32x4 w; w.x = cvt_pk_bf16(v0[0], v0[1]); w.y = cvt_pk_bf16(v0[2], v0[3]); w.z = cvt_pk_bf16(v1[0], v1[1]); w.w = cvt_pk_bf16(v1[2], v1[3]);
                    *(u32x4*)(rowp + bj * HALF) = w; } }
    }
};
struct EpiSwiglu {
    static constexpr bool PERM = true;
    bf16* O; int ldc;
    __device__ __forceinline__ void operator()(const f32x4 (&acc)[2][2][4][2], const Unit& u, int wr, int wc, int fr, int fq) const {
        const int row0 = u.pm * BM + wr * 64 + fr, col0 = u.pn * HALF + wc * 32 + 8 * fq;
#pragma unroll
        for (int ai = 0; ai < 2; ++ai)
#pragma unroll
            for (int m = 0; m < 4; ++m) { bf16* rowp = O + (size_t)(row0 + ai * HALF + m * 16) * ldc + col0;
                float o[8];
#pragma unroll
                for (int n = 0; n < 2; ++n)
#pragma unroll
                    for (int j = 0; j < 4; ++j) { const float g = acc[ai][0][m][n][j], up = acc[ai][1][m][n][j]; o[n * 4 + j] = silu_f(g) * up; }
                u32x4 w; w.x = cvt_pk_bf16(o[0], o[1]); w.y = cvt_pk_bf16(o[2], o[3]); w.z = cvt_pk_bf16(o[4], o[5]); w.w = cvt_pk_bf16(o[6], o[7]);
                *(u32x4*)rowp = w; }
    }
};
struct EpiSwigluF8 {
    static constexpr bool PERM = true;
    unsigned char* O; int ldc;
    __device__ __forceinline__ void operator()(const f32x4 (&acc)[2][2][4][2], const Unit& u, int wr, int wc, int fr, int fq) const {
        const int row0 = u.pm * BM + wr * 64 + fr, col0 = u.pn * HALF + wc * 32 + 8 * fq;
        constexpr float si = 1.0f / (SC_H * SC_W);
#pragma unroll
        for (int ai = 0; ai < 2; ++ai)
#pragma unroll
            for (int m = 0; m < 4; ++m) { unsigned char* rowp = O + (size_t)(row0 + ai * HALF + m * 16) * ldc + col0;
                float o[8];
#pragma unroll
                for (int n = 0; n < 2; ++n)
#pragma unroll
                    for (int j = 0; j < 4; ++j) { const float g = acc[ai][0][m][n][j] * si, up = acc[ai][1][m][n][j] * (si * SC_A); o[n * 4 + j] = silu_f(g) * up; }
                u32x2 w; w.x = pk4_fp8(o[0], o[1], o[2], o[3]); w.y = pk4_fp8(o[4], o[5], o[6], o[7]);
                *(u32x2*)rowp = w; }
    }
};
struct EpiResidual {
    static constexpr bool PERM = false;
    const float* xin; float* out; const float* gate; float gs;
    __device__ __forceinline__ void operator()(const f32x4 (&acc)[2][2][4][2], const Unit& u, int wr, int wc, int fr, int fq) const {
        const int row0 = u.pm * BM + wr * 64 + fr, col0 = u.pn * BM + wc * 32 + 4 * fq, b = u.pm >> 5;
        f32x4 gv[2][2];
#pragma unroll
        for (int bj = 0; bj < 2; ++bj)
#pragma unroll
            for (int n = 0; n < 2; ++n) gv[bj][n] = *(const f32x4*)(gate + (size_t)b * NMOD + col0 + bj * HALF + n * 16) * gs;
#pragma unroll
        for (int ai = 0; ai < 2; ++ai)
#pragma unroll
            for (int m = 0; m < 4; ++m) { const size_t off = (size_t)(row0 + ai * HALF + m * 16) * D + col0;
#pragma unroll
                for (int bj = 0; bj < 2; ++bj)
#pragma unroll
                    for (int n = 0; n < 2; ++n) { const f32x4 xs = *(const f32x4*)(xin + off + bj * HALF + n * 16); *(f32x4*)(out + off + bj * HALF + n * 16) = xs + gv[bj][n] * acc[ai][bj][m][n]; }
                asm volatile("" ::: "memory"); }
    }
};
struct EpiMoeDown {
    static constexpr bool PERM = false;
    float* out; const int* list; const float* wgt; const float* gate; float ascale; float* dump;
    __device__ __forceinline__ void operator()(const f32x4 (&acc)[2][2][4][2], const Unit& u, int wr, int wc, int fr, int fq) const {
        const int pos0 = u.pm * BM + wr * 64 + fr, col0 = u.pn * BM + wc * 32 + 4 * fq;
#pragma unroll
        for (int ai = 0; ai < 2; ++ai)
#pragma unroll
            for (int m = 0; m < 4; ++m) { const int pos = pos0 + ai * HALF + m * 16; const int tk = list[pos]; const float w = wgt[pos] * ascale;
                float* orow = (tk >= 0 ? out + (size_t)tk * D : dump) + col0; const float* gp = gate + (size_t)(tk >= 0 ? (tk >> 13) : 0) * NMOD + col0;
#pragma unroll
                for (int bj = 0; bj < 2; ++bj)
#pragma unroll
                    for (int n = 0; n < 2; ++n) { const f32x4 gq = *(const f32x4*)(gp + bj * HALF + n * 16); const f32x4 xs = *(const f32x4*)(orow + bj * HALF + n * 16);
                        *(f32x4*)(orow + bj * HALF + n * 16) = xs + (gq * w) * acc[ai][bj][m][n]; }
                asm volatile("" ::: "memory"); }
    }
};

template <class Epi, class Sched, bool GATHER, bool FP8 = false>
__device__ __forceinline__ void gemm_phase(LAS unsigned char* lds, const int K, const Sched& S, const Epi& E, LAS u32x4* goff = nullptr) {
    int tid_ = threadIdx.x; asm volatile("" : "+v"(tid_));
    const int tid = tid_, wid = __builtin_amdgcn_readfirstlane(tid >> 6), lane = tid & 63, wr = wid >> 2, wc = wid & 3, fr = lane & 15, fq = lane >> 4;
    int nt = K / BK; asm volatile("" : "+s"(nt));
    unsigned voffB[2], ao[2][2], no[2][2];
    const size_t kstep = (size_t)(BK * 2);
    const size_t hstep = (size_t)HALF * K * 2;
#pragma unroll
    for (int i = 0; i < 2; ++i) { int R, C; stage_rc(tid * 16 + i * 8192, R, C); const int Rb = Epi::PERM ? ((R & ~31) + perm32(R & 31)) : R;
        voffB[i] = (unsigned)(Rb * K + C) * 2u;
        ao[0][i] = (unsigned)(R * K + C) * 2u; ao[1][i] = ao[0][i] + (unsigned)hstep; no[0][i] = ao[0][i]; no[1][i] = ao[1][i]; }
    const unsigned ldsw = (unsigned)wid * 1024u;
    const int aoff = lds_byte(wr * 64 + fr, fq * 8), boff = lds_byte(wc * 32 + fr, fq * 8);
#define PG8_CB(i) ([&]() { int t_ = tid; asm volatile("" : "+v"(t_)); int R_, C_; stage_rc(t_ * 16 + (i) * 8192, R_, C_); return (unsigned)C_ * 2u; }())
#define PG8_SA(b, h) (((b) * 2 + (h)) * HTB)
#define PG8_SB(b, h) ((4 + (b) * 2 + (h)) * HTB)
#define PG8_STAGEB(bufoff, gbase) do { _Pragma("unroll") for (int _i = 0; _i < 2; ++_i) \
        __builtin_amdgcn_global_load_lds((const unsigned*)((const char*)(gbase) + voffB[_i]), (LAS unsigned*)(lds + (bufoff) + ldsw + _i * 8192), 16, 0, 0); } while (0)
#define PG8_STAGEA(bufoff, gbase, offs, h) do { _Pragma("unroll") for (int _i = 0; _i < 2; ++_i) \
        __builtin_amdgcn_global_load_lds((const unsigned*)((const char*)(gbase) + (offs)[h][_i]), (LAS unsigned*)(lds + (bufoff) + ldsw + _i * 8192), 16, 0, 0); } while (0)
#define PG8_LD32(p) __builtin_shufflevector(*(const LAS i32x4*)(p), *(const LAS i32x4*)((p) + 1024), 0, 1, 2, 3, 4, 5, 6, 7)
#define PG8_LDA(dst, b, h) do { _Pragma("unroll") for (int m = 0; m < 4; ++m) { if constexpr (FP8) dst##8[m] = PG8_LD32(lds + PG8_SA(b, h) + aoff + m * 2048); \
        else { _Pragma("unroll") for (int k = 0; k < 2; ++k) dst[m][k] = *(const LAS bf16x8*)(lds + PG8_SA(b, h) + aoff + m * 2048 + k * 1024); } } } while (0)
#define PG8_LDB(dst, b, h) do { _Pragma("unroll") for (int n = 0; n < 2; ++n) { if constexpr (FP8) dst##8[n] = PG8_LD32(lds + PG8_SB(b, h) + boff + n * 2048); \
        else { _Pragma("unroll") for (int k = 0; k < 2; ++k) dst[n][k] = *(const LAS bf16x8*)(lds + PG8_SB(b, h) + boff + n * 2048 + k * 1024); } } } while (0)
#define PG8_MMA(ai, bj, At, Bt) do { __builtin_amdgcn_s_setprio(1); _Pragma("unroll") for (int m = 0; m < 4; ++m) _Pragma("unroll") for (int n = 0; n < 2; ++n) { \
        if constexpr (FP8) asm volatile("v_mfma_scale_f32_16x16x128_f8f6f4 %0, %1, %2, %0, %3, %3 op_sel_hi:[0,0,0]" : "+v"(acc[ai][bj][m][n]) : "v"(Bt##8[n]), "v"(At##8[m]), "v"(sc1));     \
        else { _Pragma("unroll") for (int k = 0; k < 2; ++k) acc[ai][bj][m][n] = __builtin_amdgcn_mfma_f32_16x16x32_bf16(Bt[n][k], At[m][k], acc[ai][bj][m][n], 0, 0, 0); } } \
        __builtin_amdgcn_s_setprio(0); } while (0)
#define PG8_WAIT_V(n) asm volatile("s_waitcnt vmcnt(" #n ")" ::: "memory")
#define PG8_WAIT_L(n) asm volatile("s_waitcnt lgkmcnt(" #n ")" ::: "memory")
#define PG8_BAR __builtin_amdgcn_s_barrier()
#define PG8_SCHED __builtin_amdgcn_sched_barrier(0)
    Unit cur, nxt, nn; int ui = 0;
    if (!S.next(0, cur)) return;
    bool has_next = S.next(1, nxt);
    if constexpr (GATHER) {
        unsigned raw[2][2]; S.rows_raw(cur, tid, raw);
#pragma unroll
        for (int h = 0; h < 2; ++h)
#pragma unroll
            for (int i = 0; i < 2; ++i) ao[h][i] = (raw[h][i] & 0xffffffu) * (unsigned)(K * 2) + PG8_CB(i);
        if (has_next) { S.rows_raw(nxt, tid, raw);
#pragma unroll
            for (int h = 0; h < 2; ++h)
#pragma unroll
                for (int i = 0; i < 2; ++i) no[h][i] = (raw[h][i] & 0xffffffu) * (unsigned)(K * 2) + PG8_CB(i); }
        else {
#pragma unroll
            for (int h = 0; h < 2; ++h)
#pragma unroll
                for (int i = 0; i < 2; ++i) no[h][i] = ao[h][i]; }
        goff[tid] = (u32x4){no[0][0], no[0][1], no[1][0], no[1][1]};
    }
    f32x4 acc[2][2][4][2];
#pragma unroll
    for (int a = 0; a < 2; ++a)
#pragma unroll
        for (int b = 0; b < 2; ++b)
#pragma unroll
            for (int m = 0; m < 4; ++m)
#pragma unroll
                for (int n = 0; n < 2; ++n) acc[a][b][m][n] = (f32x4){0.f, 0.f, 0.f, 0.f};
    const int sc1 = 0x7f7f7f7f;
    bf16x8 At[4][2], B0[2][2], B1[2][2];
    i32x8 At8[4], B08[2], B18[2];
    const char* cA = S.a_ptr(cur); const char* cB = S.b_ptr(cur);
    PG8_STAGEB(PG8_SB(0, 0), cB); PG8_STAGEB(PG8_SB(0, 1), cB + hstep); PG8_STAGEA(PG8_SA(0, 0), cA, ao, 0); PG8_STAGEA(PG8_SA(0, 1), cA, ao, 1);
    if (wr == 1) PG8_BAR;
    PG8_WAIT_V(2); PG8_BAR;
    PG8_STAGEB(PG8_SB(1, 0), cB + kstep); PG8_STAGEA(PG8_SA(1, 0), cA + kstep, ao, 0); PG8_STAGEB(PG8_SB(1, 1), cB + hstep + kstep);
    PG8_WAIT_V(6); PG8_BAR;
    for (;;) {
        const char* nA = has_next ? S.a_ptr(nxt) : cA; const char* nB = has_next ? S.b_ptr(nxt) : cB;
#pragma clang loop unroll(disable)
        for (int t = 0; t < nt; t += 2) {
            const bool last = (t == nt - 2);
            const char* a1 = cA + (size_t)(t + 1) * kstep;
            const char* a2 = last ? nA : cA + (size_t)(t + 2) * kstep; const char* b2 = last ? nB : cB + (size_t)(t + 2) * kstep;
            const char* a3 = a2 + kstep; const char* b3 = b2 + kstep;
            asm volatile("" : "+v"(voffB[0]), "+v"(voffB[1]), "+v"(ao[0][0]), "+v"(ao[0][1]), "+v"(ao[1][0]), "+v"(ao[1][1]));
            PG8_LDB(B0, 0, 0); PG8_LDB(B1, 0, 1); PG8_SCHED; PG8_LDA(At, 0, 0); PG8_STAGEA(PG8_SA(1, 1), a1, ao, 1);
            if constexpr (GATHER) { if (last) { const u32x4 q = goff[tid]; ao[0][0] = q[0]; ao[0][1] = q[1]; ao[1][0] = q[2]; ao[1][1] = q[3]; } }
            PG8_WAIT_V(8); PG8_WAIT_L(0); PG8_BAR; PG8_MMA(0, 0, At, B0); PG8_MMA(0, 1, At, B1); PG8_BAR; PG8_SCHED;
            PG8_LDA(At, 0, 1); PG8_STAGEB(PG8_SB(0, 0), b2); PG8_STAGEB(PG8_SB(0, 1), b2 + hstep); PG8_STAGEA(PG8_SA(0, 0), a2, ao, 0);
            PG8_WAIT_V(8); PG8_WAIT_L(0); PG8_BAR; PG8_MMA(1, 0, At, B0); PG8_MMA(1, 1, At, B1); PG8_BAR; PG8_SCHED;
            PG8_LDB(B0, 1, 0); PG8_LDB(B1, 1, 1); PG8_SCHED; PG8_LDA(At, 1, 0); PG8_STAGEA(PG8_SA(0, 1), a2, ao, 1);
            PG8_WAIT_V(8); PG8_WAIT_L(0); PG8_BAR; PG8_MMA(0, 0, At, B0); PG8_MMA(0, 1, At, B1); PG8_BAR; PG8_SCHED;
            PG8_LDA(At, 1, 1); PG8_STAGEB(PG8_SB(1, 0), b3); PG8_STAGEB(PG8_SB(1, 1), b3 + hstep); PG8_STAGEA(PG8_SA(1, 0), a3, ao, 0);
            PG8_WAIT_V(8); PG8_WAIT_L(0); PG8_BAR; PG8_MMA(1, 0, At, B0); PG8_MMA(1, 1, At, B1); PG8_BAR; PG8_SCHED;
        }
        if (wr == 0) PG8_BAR;
        if constexpr (FP8) asm volatile("s_nop 15\n\ts_nop 15\n\ts_nop 7" ::: "memory");
        bool has_nn = false; unsigned raw[2][2];
        if (has_next) has_nn = S.next(ui + 2, nn);
        if constexpr (GATHER) { if (has_nn) S.rows_raw(nn, tid, raw); }
        E(acc, cur, wr, wc, fr, fq);
        if (!has_next) break;
#pragma unroll
        for (int a = 0; a < 2; ++a)
#pragma unroll
            for (int b = 0; b < 2; ++b)
#pragma unroll
                for (int m = 0; m < 4; ++m)
#pragma unroll
                    for (int n = 0; n < 2; ++n) acc[a][b][m][n] = (f32x4){0.f, 0.f, 0.f, 0.f};
        if constexpr (GATHER) {
            if (has_nn) { u32x4 q;
#pragma unroll
                for (int h = 0; h < 2; ++h)
#pragma unroll
                    for (int i = 0; i < 2; ++i) q[h * 2 + i] = (raw[h][i] & 0xffffffu) * (unsigned)(K * 2) + PG8_CB(i);
                goff[tid] = q; }
        }
        cur = nxt; cA = nA; cB = nB; nxt = nn; has_next = has_nn; ++ui;
        if (wr == 1) PG8_BAR;
    }
    PG8_WAIT_V(0);
    PG8_BAR;
#undef PG8_SA
#undef PG8_CB
#undef PG8_SB
#undef PG8_STAGEA
#undef PG8_STAGEB
#undef PG8_LDA
#undef PG8_LDB
#undef PG8_MMA
#undef PG8_LD32
#undef PG8_WAIT_V
#undef PG8_WAIT_L
#undef PG8_BAR
#undef PG8_SCHED
}
}

struct Args { const float* in[27]; float* out; unsigned char* ws; };
typedef const float* cfp_t;
typedef __attribute__((address_space(4))) const cfp_t* kargp_t;
struct Frame {
    LAS unsigned char* lds;
    int tid, lane, wave, G, bid;
    kargp_t ka;
};
#define PHASE_ENTER(F) do { kargp_t _p = (F).ka; asm volatile("" : "+s"(_p)); (F).ka = _p; \
    int _t = threadIdx.x; asm volatile("" : "+v"(_t)); (F).tid = _t; (F).lane = _t & 63; (F).wave = __builtin_amdgcn_readfirstlane(_t >> 6); \
    int _g = gridDim.x; asm volatile("" : "+s"(_g)); (F).G = _g; int _b = blockIdx.x; asm volatile("" : "+s"(_b)); (F).bid = _b; } while (0)
#define KIN(k) ((F).ka[k])
#define KOUT ((float*)(F).ka[27])
#define KWS ((unsigned char*)(F).ka[28])
#define KMOD ((float*)(KWS + WS_MOD))
#define KH ((bf16*)(KWS + WS_H))
#define KPROJ ((bf16*)(KWS + WS_BIG))
#define KMIXED ((bf16*)(KWS + WS_MIXED))
#define KACT ((bf16*)(KWS + WS_BIG))

__device__ __forceinline__ void p0_transpose_item(const float* W, int K, int N, bf16* WT, int dst_row0, LAS float* scr, int kb, int nb, int lane) {
    const int k0 = 64 * kb, n0 = 32 * nb;
#pragma unroll 8
    for (int i = 0; i < 32; ++i) { const int kk = 2 * i + (lane >> 5); scr[kk * 33 + (lane & 31)] = W[(size_t)(k0 + kk) * N + n0 + (lane & 31)]; }
    LDS_WAIT(); asm volatile("" ::: "memory");
    const int c = lane & 7;
#pragma unroll
    for (int j = 0; j < 4; ++j) { const int n = (lane >> 3) + 8 * j; const LAS float* s = scr + (8 * c) * 33 + n;
        u32x4 o; o.x = pk2(s[0 * 33], s[1 * 33]); o.y = pk2(s[2 * 33], s[3 * 33]); o.z = pk2(s[4 * 33], s[5 * 33]); o.w = pk2(s[6 * 33], s[7 * 33]);
        *(u32x4*)(WT + (size_t)(dst_row0 + n) * K + k0 + 8 * c) = o; }
    LDS_WAIT(); asm volatile("" ::: "memory");
}
__device__ __forceinline__ void p0_transpose_item_f8(const float* W, int K, int N, unsigned char* WT, int dst_row0, LAS float* scr, int kb, int nb, int lane) {
    const int k0 = 64 * kb, n0 = 32 * nb;
#pragma unroll 8
    for (int i = 0; i < 32; ++i) { const int kk = 2 * i + (lane >> 5); scr[kk * 33 + (lane & 31)] = W[(size_t)(k0 + kk) * N + n0 + (lane & 31)]; }
    LDS_WAIT(); asm volatile("" ::: "memory");
    const int n = lane >> 1, kh = (lane & 1) * 32; const LAS float* sp = scr + kh * 33 + n;
#pragma unroll
    for (int q = 0; q < 2; ++q) { u32x4 o;
#pragma unroll
        for (int d = 0; d < 4; ++d) { const int kk = q * 16 + d * 4; o[d] = pk4_fp8(sp[(kk + 0) * 33] * SC_W, sp[(kk + 1) * 33] * SC_W, sp[(kk + 2) * 33] * SC_W, sp[(kk + 3) * 33] * SC_W); }
        *(u32x4*)(WT + (size_t)(dst_row0 + n) * K + k0 + kh + q * 16) = o; }
    LDS_WAIT(); asm volatile("" ::: "memory");
}
__device__ __forceinline__ int gu_row(int n) { return (n >> 7) * 256 + (n & 127); }

__device__ __forceinline__ void p0_prologue(Frame& F) {
    if (F.bid < 192) {
        LAS float* cond = (LAS float*)F.lds;
        LAS float* red = (LAS float*)(F.lds + 32768);
        const float* cin = KIN(1);
        for (int i = F.tid; i < BATCH * D; i += NTHREADS) cond[i] = silu_f(cin[i]);
        __syncthreads();
        for (int item = F.bid; item < 192; item += F.G) {
            const int l = item / 96, colbase = (item % 96) * 64, col = colbase + F.lane;
            const float* W = KIN(2) + (size_t)l * D * NMOD;
            float a[8];
#pragma unroll
            for (int b = 0; b < 8; ++b) a[b] = 0.f;
            for (int k = F.wave * 128; k < F.wave * 128 + 128; ++k) { const float w = W[(size_t)k * NMOD + col];
#pragma unroll
                for (int b = 0; b < 8; ++b) a[b] = fmaf(cond[b * D + k], w, a[b]); }
#pragma unroll
            for (int b = 0; b < 8; ++b) red[(F.wave * 8 + b) * 64 + F.lane] = a[b];
            __syncthreads();
            { const int b = F.tid >> 6, cl = F.tid & 63; float s = 0.f;
#pragma unroll
              for (int w = 0; w < 8; ++w) s += red[(w * 8 + b) * 64 + cl];
              KMOD[((size_t)l * BATCH + b) * NMOD + colbase + cl] = s + KIN(3)[(size_t)l * NMOD + colbase + cl]; }
            __syncthreads();
        }
    }
    LAS float* scr = (LAS float*)(F.lds + F.wave * 16384);
    const int gw = F.bid * NWAVES + F.wave, NGW = F.G * NWAVES;
    constexpr int I_IN = 16 * 56, I_OUT = 16 * 32, I_FG = 16 * 88, I_FD = 44 * 32, I_MG = 16 * 112, I_MD = 56 * 32;
    constexpr int NITEMS = 2 * I_IN + 2 * I_OUT + 2 * I_FG + I_FD + 16 * I_MG + 8 * I_MD;
    bf16* ws_b = (bf16*)KWS;
    for (int it = gw; it < NITEMS; it += NGW) {
        int r = it;
        if (r < 2 * I_IN) { const int l = r / I_IN; r -= l * I_IN; const int kb = r / 56, nb = r % 56;
            p0_transpose_item(KIN(6) + (size_t)l * D * D_IN, D, D_IN, (bf16*)(KWS + WS_WIN) + (size_t)l * D_IN * D, 32 * nb, scr, kb, nb, F.lane); continue; } r -= 2 * I_IN;
        if (r < 2 * I_OUT) { const int l = r / I_OUT; r -= l * I_OUT; const int kb = r / 32, nb = r % 32;
            p0_transpose_item(KIN(17) + (size_t)l * D * D, D, D, (bf16*)(KWS + WS_WOUT) + (size_t)l * D * D, 32 * nb, scr, kb, nb, F.lane); continue; } r -= 2 * I_OUT;
        if (r < 2 * I_FG) { const int up = r / I_FG; r -= up * I_FG; const int kb = r / 88, nb = r % 88;
            p0_transpose_item(up ? KIN(19) : KIN(18), D, FF, (bf16*)(KWS + WS_WGU), gu_row(32 * nb) + 128 * up, scr, kb, nb, F.lane); continue; } r -= 2 * I_FG;
        if (r < I_FD) { const int kb = r / 32, nb = r % 32;
            p0_transpose_item(KIN(20), FF, D, (bf16*)(KWS + WS_WD), 32 * nb, scr, kb, nb, F.lane); continue; } r -= I_FD;
        if (r < 16 * I_MG) { const int q = r / I_MG; r -= q * I_MG; const int up = q >> 3, e = q & 7; const int kb = r / 112, nb = r % 112;
            p0_transpose_item_f8((up ? KIN(24) : KIN(23)) + (size_t)e * D * FFE, D, FFE, (unsigned char*)(KWS + WS_MWGU) + (size_t)e * 2 * FFE * D, gu_row(32 * nb) + 128 * up, scr, kb, nb, F.lane); continue; } r -= 16 * I_MG;
        { const int e = r / I_MD; r -= e * I_MD; const int kb = r / 32, nb = r % 32;
            p0_transpose_item_f8(KIN(25) + (size_t)e * FFE * D, FFE, D, (unsigned char*)(KWS + WS_MWD) + (size_t)e * D * FFE, 32 * nb, scr, kb, nb, F.lane); }
    }
    (void)ws_b;
    if (F.bid == 0) for (int i = F.tid; i < D; i += NTHREADS) ((float*)(KWS + WS_DUMP))[i] = 0.f;
    { bf16* pw = (bf16*)(KWS + WS_POOLW);
      for (int i = F.bid * NTHREADS + F.tid; i < 2 * 4 * 64 * 64; i += F.G * NTHREADS) { const int c = i & 63, d = (i >> 6) & 63, lg = i >> 12;
          pw[i] = (bf16)f2bf(KIN(7)[((size_t)lg * 64 + c) * 64 + d] * KIN(8)[lg * 64 + d]); } }
    { const float* sw = KIN(15); bf16* so = (bf16*)(KWS + WS_SGUW);
      for (int i = (F.bid * NTHREADS + F.tid) * 4; i < 2 * NH * 128 * 128; i += F.G * NTHREADS * 4) { const f32x4 v = *(const f32x4*)(sw + i); u32x2 o; o.x = pk2(v[0], v[1]); o.y = pk2(v[2], v[3]); *(u32x2*)(so + i) = o; } }
}

template <int MODE>
__device__ __forceinline__ void norm_phase(Frame& F, const float* xsrc, const float* g, const float* shiftp, const float* scalep, bf16* hdst, float* fdst) {
    LAS int* lhist = (LAS int*)(F.lds + LC_HIST);
    for (int tb = F.bid; tb < M / 256; tb += F.G) {
        const int row0 = tb * 256 + F.wave * 32, b = row0 >> 13;
        f32x4 gm[4], sh[4];
#pragma unroll
        for (int j = 0; j < 4; ++j) { const int col = 4 * F.lane + 256 * j; const f32x4 gg = *(const f32x4*)(g + col);
            if (MODE == 2) { gm[j] = gg; sh[j] = (f32x4){0.f, 0.f, 0.f, 0.f}; }
            else { const f32x4 sc = *(const f32x4*)(scalep + (size_t)b * NMOD + col); gm[j] = gg * (1.0f + sc); sh[j] = *(const f32x4*)(shiftp + (size_t)b * NMOD + col); } }
        float rbias[8];
        LAS float* rwl = (LAS float*)F.lds;
        if (MODE == 1) {
            for (int i = F.tid; i < D * NE; i += NTHREADS) rwl[(i & 7) * D + (i >> 3)] = KIN(21)[i];
#pragma unroll
            for (int e = 0; e < 8; ++e) rbias[e] = KIN(22)[e];
            if (F.tid < 16) lhist[F.tid] = 0;
            __syncthreads();
        }
        for (int r = 0; r < 32; ++r) {
            const int row = row0 + r;
            const f32x4* xr = (const f32x4*)(xsrc + (size_t)row * D) + F.lane;
            f32x4 v[4]; float ss = 0.f;
#pragma unroll
            for (int j = 0; j < 4; ++j) { v[j] = xr[64 * j]; ss += (v[j][0] * v[j][0] + v[j][1] * v[j][1]) + (v[j][2] * v[j][2] + v[j][3] * v[j][3]); }
            const float rstd = 1.0f / sqrtf(wave_sum(ss) * (1.0f / D) + EPS);
#pragma unroll
            for (int j = 0; j < 4; ++j) v[j] = (v[j] * rstd) * gm[j] + sh[j];
            if (MODE == 2) { f32x4* o = (f32x4*)(fdst + (size_t)row * D) + F.lane;
#pragma unroll
                for (int j = 0; j < 4; ++j) o[64 * j] = v[j]; }
            else if (MODE == 1) { unsigned* o = (unsigned*)((unsigned char*)hdst + (size_t)row * D) + F.lane;
#pragma unroll
                for (int j = 0; j < 4; ++j) o[64 * j] = pk4_fp8(v[j][0] * SC_H, v[j][1] * SC_H, v[j][2] * SC_H, v[j][3] * SC_H); }
            else { u32x2* o = (u32x2*)(hdst + (size_t)row * D) + F.lane;
#pragma unroll
                for (int j = 0; j < 4; ++j) { u32x2 w; w.x = pk2(v[j][0], v[j][1]); w.y = pk2(v[j][2], v[j][3]); o[64 * j] = w; } }
            if (MODE == 1) {
                float lg[8];
#pragma unroll
                for (int e = 0; e < 8; ++e) lg[e] = 0.f;
#pragma unroll
                for (int e = 0; e < 8; ++e)
#pragma unroll
                    for (int j = 0; j < 4; ++j) { const f32x4 wv = *(const LAS f32x4*)(rwl + e * D + 4 * F.lane + 256 * j);
                        lg[e] = fmaf(v[j][0], wv[0], lg[e]); lg[e] = fmaf(v[j][1], wv[1], lg[e]); lg[e] = fmaf(v[j][2], wv[2], lg[e]); lg[e] = fmaf(v[j][3], wv[3], lg[e]); }
#pragma unroll
                for (int e = 0; e < 8; ++e) lg[e] = wave_sum(lg[e]) + rbias[e];
                int i1 = 0; float v1 = lg[0];
#pragma unroll
                for (int e = 1; e < 8; ++e) if (lg[e] > v1) { v1 = lg[e]; i1 = e; }
                int i2 = -1; float v2 = -3.0e38f;
#pragma unroll
                for (int e = 0; e < 8; ++e) if (e != i1 && lg[e] > v2) { v2 = lg[e]; i2 = e; }
                const float ex = __expf(v2 - v1), w1 = 1.0f / (1.0f + ex), w2 = ex * w1;
                if (F.lane == 0) { u32x4 rec; rec.x = (unsigned)i1; rec.y = (unsigned)i2; rec.z = __float_as_uint(w1); rec.w = __float_as_uint(w2);
                    *(u32x4*)(KWS + WS_REC + (size_t)row * 16) = rec; __hip_atomic_fetch_add(&lhist[i1], 1, __ATOMIC_RELAXED, __HIP_MEMORY_SCOPE_WORKGROUP); __hip_atomic_fetch_add(&lhist[8 + i2], 1, __ATOMIC_RELAXED, __HIP_MEMORY_SCOPE_WORKGROUP); }
            }
        }
        if (MODE == 1) { __syncthreads(); if (F.tid < 16) ((int*)(KWS + WS_HIST))[tb * 16 + F.tid] = lhist[F.tid]; __syncthreads(); }
    }
}

__device__ __forceinline__ void route_phase(Frame& F) {
    LAS int* ltot = (LAS int*)(F.lds + LC_TOT); LAS int* lpre = (LAS int*)(F.lds + LC_PRE); LAS int* ltb = (LAS int*)(F.lds + LC_TBASE); LAS int* lwc = (LAS int*)(F.lds + LC_WCNT);
    const int* hist = (const int*)(KWS + WS_HIST);
    int* list = (int*)(KWS + WS_LIST); float* wgt = (float*)(KWS + WS_WGT);
    for (int tb = F.bid; tb < M / 256; tb += F.G) {
        if (F.tid < 16) { ltot[F.tid] = 0; lpre[F.tid] = 0; }
        __syncthreads();
        { const int pe = F.tid & 15, part = F.tid >> 4; int sa = 0, sp = 0;
#pragma unroll
          for (int k = 0; k < 8; ++k) { const int t = part * 8 + k; const int v = hist[t * 16 + pe]; sa += v; sp += (t < tb) ? v : 0; }
          __hip_atomic_fetch_add(&ltot[pe], sa, __ATOMIC_RELAXED, __HIP_MEMORY_SCOPE_WORKGROUP); __hip_atomic_fetch_add(&lpre[pe], sp, __ATOMIC_RELAXED, __HIP_MEMORY_SCOPE_WORKGROUP); }
        __syncthreads();
        if (F.tid < 2) { int base = 0; for (int e = 0; e < 8; ++e) { ltb[F.tid * 8 + e] = base; base += (ltot[F.tid * 8 + e] + 255) >> 8; } }
        __syncthreads();
        unsigned e01[2] = {0u, 0u}; float w01[2] = {0.f, 0.f}; int rk[2] = {0, 0};
        if (F.tid < 256) {
            const u32x4 rec = *(const u32x4*)(KWS + WS_REC + (size_t)(tb * 256 + F.tid) * 16);
            e01[0] = rec.x; e01[1] = rec.y; w01[0] = __uint_as_float(rec.z); w01[1] = __uint_as_float(rec.w);
#pragma unroll
            for (int p = 0; p < 2; ++p)
#pragma unroll
                for (int ee = 0; ee < 8; ++ee) { const unsigned long long mk = __ballot(e01[p] == (unsigned)ee);
                    if (e01[p] == (unsigned)ee) rk[p] = __builtin_popcountll(mk & ((1ull << F.lane) - 1ull));
                    if (F.lane == 0) lwc[(p * 4 + F.wave) * 8 + ee] = __builtin_popcountll(mk); }
        }
        __syncthreads();
        if (F.tid < 256) {
#pragma unroll
            for (int p = 0; p < 2; ++p) { const int e = (int)e01[p]; int off = 0;
                for (int w = 0; w < F.wave; ++w) off += lwc[(p * 4 + w) * 8 + e];
                const int pos = ltb[p * 8 + e] * 256 + lpre[p * 8 + e] + off + rk[p];
                list[p * LISTN + pos] = tb * 256 + F.tid; wgt[p * LISTN + pos] = w01[p]; }
        }
        if (tb < 16) { const int p = tb >> 3, e = tb & 7; const int lo = ltb[tb] * 256 + ltot[tb], hi = (ltb[tb] + ((ltot[tb] + 255) >> 8)) * 256;
            for (int i = lo + F.tid; i < hi; i += NTHREADS) { list[p * LISTN + i] = (int)0x80000000u; wgt[p * LISTN + i] = 0.f; } (void)e; }
        if (tb == 0 && F.tid < 16) ((int*)(KWS + WS_TOT))[F.tid] = ltot[F.tid];
        __syncthreads();
    }
}
__device__ __forceinline__ void build_group_table(Frame& F, int p, int nN) {
    LAS int* tab = (LAS int*)(F.lds + LC_GT);
    __syncthreads();
    if (F.tid == 0) { const int* tot = (const int*)(KWS + WS_TOT) + p * 8; int ng = 0, ustart = 0, tile = 0;
        for (int e = 0; e < 8; ++e) { int tl = (tot[e] + 255) >> 8;
            while (tl > 0) { const int gsz = tl < 8 ? tl : 8; tab[64 + ng] = ustart; tab[128 + ng] = tile; tab[192 + ng] = gsz; tab[256 + ng] = e; ustart += gsz * nN; tile += gsz; tl -= gsz; ++ng; } }
        tab[0] = ng; tab[1] = ustart; }
    __syncthreads();
}

__device__ __forceinline__ void mixer_unit(Frame& F, const int l, const int unit) {
    const bf16* P = KPROJ; bf16* MO = KMIXED;
    const int t0 = unit * 128, s0 = t0 & (SEQ - 1), rb = t0 - s0;
    const int lane = F.lane, wave = F.wave, tid = F.tid;
    {
        typedef float f32x2 __attribute__((ext_vector_type(2)));
        constexpr int GS = 392;
        LAS bf16* gbuf = (LAS bf16*)F.lds;
        const __amdgpu_buffer_rsrc_t rsw = __builtin_amdgcn_make_buffer_rsrc((void*)(KIN(9) + (size_t)l * CKW * CONVW), (short)0, CKW * CONVW * 4, 0x00020000);
        const __amdgpu_buffer_rsrc_t rsb = __builtin_amdgcn_make_buffer_rsrc((void*)(KIN(10) + (size_t)l * CONVW), (short)0, CONVW * 4, 0x00020000);
        float g6[6], b6[6];
#pragma unroll
        for (int k = 0; k < 3; ++k)
#pragma unroll
            for (int e = 0; e < 2; ++e) { g6[2 * k + e] = KIN(11)[l * CONVW + 128 * k + 2 * lane + e]; b6[2 * k + e] = KIN(12)[l * CONVW + 128 * k + 2 * lane + e]; }
        for (int hf = 0; hf < 2; ++hf) {
            const int sbase = s0 + 64 * hf - 15;
            for (int j0 = 0; j0 < 9; j0 += 3) {
                u32x4 va[3], vg[3];
#pragma unroll
                for (int jj = 0; jj < 3; ++jj) { const int i = tid + (j0 + jj) * NTHREADS, rr = i / 48, cp = i - rr * 48, sq = sbase + rr;
                    va[jj] = (u32x4){0u, 0u, 0u, 0u}; vg[jj] = va[jj];
                    if (i < 94 * 48 && sq >= 0 && sq < SEQ) { const bf16* pr = P + (size_t)(rb + sq) * D_IN + 256 + 8 * cp; va[jj] = *(const u32x4*)pr; vg[jj] = *(const u32x4*)(pr + CONVW); } }
#pragma unroll
                for (int jj = 0; jj < 3; ++jj) { const int i = tid + (j0 + jj) * NTHREADS, rr = i / 48, cp = i - rr * 48;
                    if (i < 94 * 48) { u32x4 o;
#pragma unroll
                        for (int d = 0; d < 4; ++d) o[d] = pk2(bflo(va[jj][d]) * fast_sigmoid(bflo(vg[jj][d])), bfhi(va[jj][d]) * fast_sigmoid(bfhi(vg[jj][d])));
                        *(LAS u32x4*)(gbuf + rr * GS + 8 * cp) = o; } }
            }
            __syncthreads();
            f32x2 o[3][8];
#pragma unroll
            for (int pg = 0; pg < 3; ++pg) {
                asm volatile("" ::: "memory");
                f32x2 w[31];
#pragma unroll
                for (int j = 0; j < 31; ++j) w[j] = __builtin_bit_cast(f32x2, __builtin_amdgcn_raw_buffer_load_b64(rsw, (unsigned)lane * 8u, (j * CONVW + 128 * pg) * 4, 0));
                const f32x2 bias = __builtin_bit_cast(f32x2, __builtin_amdgcn_raw_buffer_load_b64(rsb, (unsigned)lane * 8u, 128 * pg * 4, 0));
#pragma unroll
                for (int i = 0; i < 8; ++i) o[pg][i] = bias;
                const LAS unsigned* gp = (const LAS unsigned*)gbuf + (8 * wave) * (GS / 2) + 64 * pg + lane;
#pragma unroll
                for (int r = 0; r < 38; ++r) { const unsigned u = gp[r * (GS / 2)]; const f32x2 gl = {bflo(u), bfhi(u)};
#pragma unroll
                    for (int i = 0; i < 8; ++i) if (r - i >= 0 && r - i < 31) o[pg][i] = w[r - i] * gl + o[pg][i]; }
            }
#pragma unroll
            for (int i = 0; i < 8; ++i) { float sm = 0.f, q = 0.f;
#pragma unroll
                for (int pg = 0; pg < 3; ++pg) { sm += o[pg][i][0] + o[pg][i][1]; q += o[pg][i][0] * o[pg][i][0] + o[pg][i][1] * o[pg][i][1]; }
                sm = wave_sum(sm); q = wave_sum(q);
                const float mean = sm * (1.0f / CONVW), var = fmaxf(q * (1.0f / CONVW) - mean * mean, 0.f), rstd = 1.0f / sqrtf(var + EPS);
                unsigned* orow = (unsigned*)(MO + (size_t)(t0 + 64 * hf + 8 * wave + i) * D + 256);
#pragma unroll
                for (int pg = 0; pg < 3; ++pg) { const float o0 = silu_f((o[pg][i][0] - mean) * rstd * g6[2 * pg] + b6[2 * pg]), o1 = silu_f((o[pg][i][1] - mean) * rstd * g6[2 * pg + 1] + b6[2 * pg + 1]);
                    orow[64 * pg + lane] = pk2(o0, o1); } }
            __syncthreads();
        }
    }
    {
        constexpr int VS = 136;
        LAS bf16* vnT = (LAS bf16*)F.lds;
        float g6[6], b6[6];
#pragma unroll
        for (int k = 0; k < 3; ++k)
#pragma unroll
            for (int e = 0; e < 2; ++e) { g6[2 * k + e] = KIN(13)[l * CONVW + 128 * k + 2 * lane + e]; b6[2 * k + e] = KIN(14)[l * CONVW + 128 * k + 2 * lane + e]; }
        for (int rh = 0; rh < 2; ++rh) {
            unsigned raw[8][3];
#pragma unroll
            for (int r = 0; r < 8; ++r) { const unsigned* pv = (const unsigned*)(P + (size_t)(t0 + wave * 16 + rh * 8 + r) * D_IN + 1408);
#pragma unroll
                for (int k = 0; k < 3; ++k) raw[r][k] = pv[64 * k + lane]; }
#pragma unroll
            for (int r = 0; r < 8; ++r) { const int tk = wave * 16 + rh * 8 + r;
                float v[6]; float s = 0.f, q = 0.f;
#pragma unroll
                for (int k = 0; k < 3; ++k) { v[2 * k] = bflo(raw[r][k]); v[2 * k + 1] = bfhi(raw[r][k]); }
#pragma unroll
                for (int k = 0; k < 6; ++k) { s += v[k]; q += v[k] * v[k]; }
                s = wave_sum(s); q = wave_sum(q);
                const float mean = s * (1.0f / CONVW), var = fmaxf(q * (1.0f / CONVW) - mean * mean, 0.f), rstd = 1.0f / sqrtf(var + EPS);
#pragma unroll
                for (int k = 0; k < 3; ++k)
#pragma unroll
                    for (int e = 0; e < 2; ++e) vnT[(128 * k + 2 * lane + e) * VS + tk] = (bf16)f2bf((v[2 * k + e] - mean) * rstd * g6[2 * k + e] + b6[2 * k + e]);
            }
        }
        __syncthreads();
        const bf16* sw = (const bf16*)(KWS + WS_SGUW);
        const float* sb = KIN(16) + (size_t)l * NH * 128;
        for (int tile = wave; tile < 24; tile += 8) { const int hh = tile >> 2, pb = tile & 3;
            f32x16 acc0, acc1;
#pragma unroll
            for (int i = 0; i < 16; ++i) { acc0[i] = 0.f; acc1[i] = 0.f; }
            const bf16* Wh = sw + ((size_t)((l * NH + hh) * 128 + pb * 32 + (lane & 31))) * 128 + 8 * (lane >> 5);
            const LAS bf16* Vb = vnT + (hh * 64 + (lane & 31)) * VS + 8 * (lane >> 5);
            bf16x8 wf[8];
#pragma unroll
            for (int ks = 0; ks < 8; ++ks) wf[ks] = *(const bf16x8*)(Wh + ks * 16);
            const int p = pb * 32 + (lane & 31); const size_t row = (size_t)(t0 + p); const float bias = sb[hh * 128 + p];
            const bf16* up = P + row * D_IN + 1024 + hh * 64 + 4 * (lane >> 5);
            u32x2 uu[2][4];
#pragma unroll
            for (int dh = 0; dh < 2; ++dh)
#pragma unroll
                for (int a = 0; a < 4; ++a) uu[dh][a] = *(const u32x2*)(up + dh * 32 + 8 * a);
#pragma unroll
            for (int ks = 0; ks < 8; ++ks) { const bf16x8 v0 = *(const LAS bf16x8*)(Vb + ks * 16), v1 = *(const LAS bf16x8*)(Vb + 32 * VS + ks * 16);
                acc0 = __builtin_amdgcn_mfma_f32_32x32x16_bf16(v0, wf[ks], acc0, 0, 0, 0); acc1 = __builtin_amdgcn_mfma_f32_32x32x16_bf16(v1, wf[ks], acc1, 0, 0, 0); }
            bf16* op = MO + row * D + 640 + hh * 64 + 4 * (lane >> 5);
#pragma unroll
            for (int a = 0; a < 4; ++a) {
                { const unsigned u0 = uu[0][a].x, u1 = uu[0][a].y; u32x2 o; o.x = pk2(bflo(u0) * (acc0[4 * a + 0] + bias), bfhi(u0) * (acc0[4 * a + 1] + bias)); o.y = pk2(bflo(u1) * (acc0[4 * a + 2] + bias), bfhi(u1) * (acc0[4 * a + 3] + bias)); *(u32x2*)(op + 8 * a) = o; }
                { const unsigned u0 = uu[1][a].x, u1 = uu[1][a].y; u32x2 o; o.x = pk2(bflo(u0) * (acc1[4 * a + 0] + bias), bfhi(u0) * (acc1[4 * a + 1] + bias)); o.y = pk2(bflo(u1) * (acc1[4 * a + 2] + bias), bfhi(u1) * (acc1[4 * a + 3] + bias)); *(u32x2*)(op + 32 + 8 * a) = o; }
            }
        }
        __syncthreads();
    }
    {
        constexpr int AS = 264;
        constexpr int DS = 136;
        LAS bf16* abuf = (LAS bf16*)F.lds;
        LAS bf16* dbuf = (LAS bf16*)(F.lds + 144 * AS * 2);
        { u32x4 st[9];
#pragma unroll
          for (int j = 0; j < 9; ++j) { const int i = tid + j * NTHREADS, rr = i >> 5, cp = i & 31; const int sq = s0 - 8 + rr; st[j] = (u32x4){0u, 0u, 0u, 0u};
              if (sq >= 0 && sq < SEQ) st[j] = *(const u32x4*)(P + (size_t)(rb + sq) * D_IN + 8 * cp); }
#pragma unroll
          for (int j = 0; j < 9; ++j) { const int i = tid + j * NTHREADS, rr = i >> 5, cp = i & 31; *(LAS u32x4*)(abuf + rr * AS + 8 * cp) = st[j]; } }
        __syncthreads();
        const bf16* pwt = (const bf16*)(KWS + WS_POOLW) + (size_t)l * 4 * 64 * 64;
        for (int gp = 0; gp < 2; ++gp) {
            { const int cc = tid & 127, run = tid >> 7, g = 2 * gp + (cc >> 6), half = 1 << g, ch = g * 64 + (cc & 63);
              const int tk0 = run * 32; float sum = 0.f;
              for (int j = -half; j < half; ++j) sum += bf2f(abuf[(tk0 + j + 8) * AS + ch]);
              for (int k = 0; k < 32; ++k) { const int tk = tk0 + k, sq = s0 + tk; int lo = sq - half; lo = lo < 0 ? 0 : lo; int hi = sq + half; hi = hi > SEQ ? SEQ : hi;
                  const float a = bf2f(abuf[(tk + 8) * AS + ch]);
                  dbuf[tk * DS + cc] = (bf16)f2bf(sum / (float)(hi - lo) - a);
                  sum += bf2f(abuf[(tk + half + 8) * AS + ch]) - bf2f(abuf[(tk - half + 8) * AS + ch]); } }
            __syncthreads();
            { const int fr = lane & 15, fq = lane >> 4;
#pragma unroll
              for (int gg = 0; gg < 2; ++gg) { const int g = 2 * gp + gg;
                  bf16x8 af[2];
#pragma unroll
                  for (int ks = 0; ks < 2; ++ks) af[ks] = *(const LAS bf16x8*)(dbuf + (wave * 16 + fr) * DS + gg * 64 + ks * 32 + 8 * fq);
                  bf16* op = MO + (size_t)(t0 + wave * 16 + fr) * D + g * 64 + 4 * fq;
#pragma unroll
                  for (int nt = 0; nt < 4; ++nt) { f32x4 acc = {0.f, 0.f, 0.f, 0.f};
#pragma unroll
                      for (int ks = 0; ks < 2; ++ks) { const bf16x8 wfr = *(const bf16x8*)(pwt + ((size_t)(g * 64 + nt * 16 + fr)) * 64 + ks * 32 + 8 * fq);
                          acc = __builtin_amdgcn_mfma_f32_16x16x32_bf16(wfr, af[ks], acc, 0, 0, 0); }
                      u32x2 o; o.x = pk2(acc[0], acc[1]); o.y = pk2(acc[2], acc[3]); *(u32x2*)(op + nt * 16) = o; } } }
            __syncthreads();
        }
    }
}

__global__ void __launch_bounds__(NTHREADS, 2) fwd_kernel(Args args) {
    extern __shared__ __attribute__((aligned(16))) unsigned char lds_raw[];
    Frame F;
    F.lds = (LAS unsigned char*)lds_raw;
    F.tid = threadIdx.x; F.lane = F.tid & 63; F.wave = __builtin_amdgcn_readfirstlane(F.tid >> 6); F.G = gridDim.x; F.bid = blockIdx.x;
    F.ka = (kargp_t)__builtin_amdgcn_kernarg_segment_ptr(); (void)args;
    for (int u = F.tid; u < (LDS_BYTES - LC_OFF) / 4; u += NTHREADS) ((LAS unsigned*)(F.lds + LC_OFF))[u] = 0u;
    __syncthreads();
    XcdBarrier bar = xcd_barrier_post((unsigned*)(KWS + WS_CTL) + CW_BAR, (volatile LAS unsigned*)(F.lds + LC_MISC) + 8);
#define GRID_BAR() xcd_barrier(bar)
#ifndef PROBE_DUP
#define PROBE_DUP 0
#endif
#define PROBE_REP(bit) for (int rep_ = 0; rep_ < ((PROBE_DUP & (bit)) ? 2 : 1); ++rep_)
#define MODL(l) (KMOD + (size_t)(l) * BATCH * NMOD)

    PROBE_REP(2) { PHASE_ENTER(F); p0_prologue(F); GRID_BAR(); }

#define LAYER_MIX(l) \
    PROBE_REP(2) { PHASE_ENTER(F); const float* xsrc = ((l) == 0) ? KIN(0) : (const float*)KOUT; \
        norm_phase<0>(F, xsrc, KIN(4) + (l) * D, MODL(l) + 0 * D, MODL(l) + 1 * D, KH, nullptr); GRID_BAR(); } \
    PROBE_REP(8) { PHASE_ENTER(F); pg8::DenseOrder S; S.init(KH, (const bf16*)(KWS + WS_WIN) + (size_t)(l) * D_IN * D, M, D_IN, D, F.G, F.bid); \
        pg8::EpiBf16 E{KPROJ, D_IN}; pg8::gemm_phase<pg8::EpiBf16, pg8::DenseOrder, false>(F.lds, D, S, E); GRID_BAR(); } \
    PROBE_REP(1) { PHASE_ENTER(F); for (int u = F.bid; u < M / 128; u += F.G) mixer_unit(F, (l), u); GRID_BAR(); } \
    for (int rep_ = 0; rep_ < (((PROBE_DUP & 32) && (l) == 0) ? 2 : 1); ++rep_) { PHASE_ENTER(F); const float* xsrc = ((l) == 0) ? KIN(0) : (const float*)KOUT; \
        pg8::DenseOrder S; S.init(KMIXED, (const bf16*)(KWS + WS_WOUT) + (size_t)(l) * D * D, M, D, D, F.G, F.bid); \
        pg8::EpiResidual E{xsrc, KOUT, MODL(l) + 2 * D, 1.0f}; pg8::gemm_phase<pg8::EpiResidual, pg8::DenseOrder, false>(F.lds, D, S, E); GRID_BAR(); }
#define MOE_PASS(p) \
    PROBE_REP(4) { PHASE_ENTER(F); build_group_table(F, (p), 2 * FFE / 256); \
        pg8::MoeOrder S; S.tab = (const LAS int*)(F.lds + LC_GT); S.A = KH; S.Bt = (const bf16*)(KWS + WS_MWGU); S.bstride = (size_t)2 * FFE * D; S.list = (const int*)(KWS + WS_LIST) + (p) * LISTN; \
        S.K = D / 2; S.nN = 2 * FFE / 256; S.G = F.G; S.c = F.bid; S.gather = true; \
        pg8::EpiSwigluF8 E{(unsigned char*)KACT, FFE}; pg8::gemm_phase<pg8::EpiSwigluF8, pg8::MoeOrder, true, true>(F.lds, D / 2, S, E, (LAS u32x4*)(F.lds + LC_GOFF)); GRID_BAR(); } \
    { PHASE_ENTER(F); build_group_table(F, (p), D / 256); \
        pg8::MoeOrder S; S.tab = (const LAS int*)(F.lds + LC_GT); S.A = KACT; S.Bt = (const bf16*)(KWS + WS_MWD); S.bstride = (size_t)D * FFE; S.list = nullptr; \
        S.K = FFE / 2; S.nN = D / 256; S.G = F.G; S.c = F.bid; S.gather = false; \
        pg8::EpiMoeDown E{KOUT, (const int*)(KWS + WS_LIST) + (p) * LISTN, (const float*)(KWS + WS_WGT) + (p) * LISTN, MODL(1) + 5 * D, 1.0f / (SC_A * SC_W), (float*)(KWS + WS_DUMP)}; \
        pg8::gemm_phase<pg8::EpiMoeDown, pg8::MoeOrder, false, true>(F.lds, FFE / 2, S, E); GRID_BAR(); \
        if (PROBE_DUP & 128) { pg8::EpiMoeDown E0 = E; E0.ascale = 0.f; pg8::gemm_phase<pg8::EpiMoeDown, pg8::MoeOrder, false, true>(F.lds, FFE / 2, S, E0); GRID_BAR(); } }

    LAYER_MIX(0)
    PROBE_REP(2) { PHASE_ENTER(F); norm_phase<0>(F, KOUT, KIN(5), MODL(0) + 3 * D, MODL(0) + 4 * D, KH, nullptr); GRID_BAR(); }
    PROBE_REP(16) { PHASE_ENTER(F); pg8::DenseOrder S; S.init(KH, (const bf16*)(KWS + WS_WGU), M, 2 * FF, D, F.G, F.bid);
        pg8::EpiSwiglu E{KACT, FF}; pg8::gemm_phase<pg8::EpiSwiglu, pg8::DenseOrder, false>(F.lds, D, S, E); GRID_BAR(); }
    { PHASE_ENTER(F); pg8::DenseOrder S; S.init(KACT, (const bf16*)(KWS + WS_WD), M, D, FF, F.G, F.bid);
        pg8::EpiResidual E{KOUT, KOUT, MODL(0) + 5 * D, 1.0f}; pg8::gemm_phase<pg8::EpiResidual, pg8::DenseOrder, false>(F.lds, FF, S, E); GRID_BAR(); }
    if (PROBE_DUP & 64) { PHASE_ENTER(F); pg8::DenseOrder S; S.init(KACT, (const bf16*)(KWS + WS_WD), M, D, FF, F.G, F.bid);
        pg8::EpiResidual E{KOUT, KOUT, MODL(0) + 5 * D, 0.0f}; pg8::gemm_phase<pg8::EpiResidual, pg8::DenseOrder, false>(F.lds, FF, S, E); GRID_BAR(); }
    LAYER_MIX(1)
    PROBE_REP(2) { PHASE_ENTER(F); norm_phase<1>(F, KOUT, KIN(5) + D, MODL(1) + 3 * D, MODL(1) + 4 * D, KH, nullptr); GRID_BAR();
        PHASE_ENTER(F); route_phase(F); GRID_BAR(); }
    MOE_PASS(0)
    MOE_PASS(1)
    { PHASE_ENTER(F); norm_phase<2>(F, KOUT, KIN(26), nullptr, nullptr, nullptr, KOUT); }
}

extern "C" void kernel_launch(void* const* d_in, const int* in_sizes, int n_in, void* d_out, int out_size, void* d_ws, size_t ws_size, hipStream_t stream) {
    static int grid = 0;
    if (grid == 0) {
        if (n_in != 27 || in_sizes[0] != M * D || out_size != M * D || ws_size < WS_END) { fprintf(stderr, "kernel_launch: unexpected shapes (n_in %d, in0 %d, out %d, ws %zu < %zu); nothing launched\n", n_in, n_in > 0 ? in_sizes[0] : -1, out_size, ws_size, (size_t)WS_END); grid = -1; return; }
        int dev = 0, cus = 0, per_cu = 0;
        if (hipGetDevice(&dev) != hipSuccess || hipDeviceGetAttribute(&cus, hipDeviceAttributeMultiprocessorCount, dev) != hipSuccess) { grid = -1; return; }
        if (hipFuncSetAttribute((const void*)fwd_kernel, hipFuncAttributeMaxDynamicSharedMemorySize, LDS_BYTES) != hipSuccess) { fprintf(stderr, "kernel_launch: hipFuncSetAttribute failed\n"); grid = -1; return; }
        if (hipOccupancyMaxActiveBlocksPerMultiprocessor(&per_cu, (const void*)fwd_kernel, NTHREADS, LDS_BYTES) != hipSuccess || per_cu < 1) { fprintf(stderr, "kernel_launch: occupancy query says %d blocks per CU\n", per_cu); }
        (void)hipGetLastError();
        grid = cus;
    }
    if (grid < 0) return;
    if (hipMemsetAsync((char*)d_ws + WS_CTL, 0, CTL_ZERO_BYTES, stream) != hipSuccess) return;
    Args a{};
    for (int i = 0; i < 27; ++i) a.in[i] = (const float*)d_in[i];
    a.out = (float*)d_out; a.ws = (unsigned char*)d_ws;
    hipLaunchKernelGGL(fwd_kernel, dim3(grid), dim3(NTHREADS), LDS_BYTES, stream, a);
}
```

```cpp
#include <hip/hip_runtime.h>
#include <cstdio>
#include <cstdint>

#define GAS __attribute__((address_space(1)))
#define LAS __attribute__((address_space(3)))
typedef unsigned short bf16;
typedef short bf16x8 __attribute__((ext_vector_type(8)));
typedef float f32x4 __attribute__((ext_vector_type(4)));
typedef float f32x16 __attribute__((ext_vector_type(16)));
typedef unsigned u32x4 __attribute__((ext_vector_type(4)));
typedef unsigned u32x2 __attribute__((ext_vector_type(2)));
typedef int i32x4 __attribute__((ext_vector_type(4)));
typedef int i32x8 __attribute__((ext_vector_type(8)));
constexpr float SC_W = 256.0f, SC_H = 16.0f, SC_A = 4.0f;

constexpr int NWAVES = 8, NTHREADS = 512;
constexpr int BATCH = 8, SEQ = 8192, D = 1024, M = BATCH * SEQ;
constexpr int D_IN = 1792, FF = 2816, FFE = 3584, NE = 8, NMOD = 6 * D;
constexpr int CONVW = 384, CKW = 31, NH = 6;
constexpr float EPS = 1e-6f;
constexpr int LISTN = M + NE * 256;

constexpr size_t MiB = 1u << 20;
constexpr size_t WS_CTL = 0, CTL_ZERO_BYTES = 1 * MiB;
constexpr size_t WS_MOD = 1 * MiB;
constexpr size_t WS_HIST = 2 * MiB;
constexpr size_t WS_TOT = 2 * MiB + 65536;
constexpr size_t WS_DUMP = 2 * MiB + 131072;
constexpr size_t WS_REC = 3 * MiB;
constexpr size_t WS_LIST = 4 * MiB;
constexpr size_t WS_WGT = 5 * MiB;
constexpr size_t WS_SGUW = 6 * MiB;
constexpr size_t WS_POOLW = 6 * MiB + 524288;
constexpr size_t WS_WIN = 8 * MiB;
constexpr size_t WS_WOUT = 15 * MiB;
constexpr size_t WS_WGU = 19 * MiB;
constexpr size_t WS_WD = 30 * MiB;
constexpr size_t WS_MWGU = 36 * MiB;
constexpr size_t WS_MWD = 148 * MiB;
constexpr size_t WS_H = 204 * MiB;
constexpr size_t WS_BIG = 332 * MiB;
constexpr size_t WS_MIXED = WS_BIG + (size_t)M * D_IN * 2;
constexpr size_t WS_ACT_END = WS_BIG + (size_t)LISTN * FFE * 2;
constexpr size_t WS_XB = (WS_ACT_END + 255) / 256 * 256;
constexpr size_t WS_END = WS_XB + (size_t)M * D * 2;
static_assert(WS_MIXED + (size_t)M * D * 2 <= WS_ACT_END && (size_t)M * FF * 2 <= (size_t)LISTN * FFE * 2, "ws map");
constexpr int CW_BAR = 4096;

constexpr int RING_BYTES = 131072;
constexpr int LC_OFF = RING_BYTES;
constexpr int LC_MISC = LC_OFF;
constexpr int LC_HIST = LC_OFF + 64;
constexpr int LC_TOT = LC_OFF + 128;
constexpr int LC_PRE = LC_OFF + 192;
constexpr int LC_TBASE = LC_OFF + 256;
constexpr int LC_WCNT = LC_OFF + 320;
constexpr int LC_GT = LC_OFF + 1024;
constexpr int LC_GOFF = LC_OFF + 4096;
constexpr int LDS_BYTES = RING_BYTES + 4096 + 8192;

__device__ __forceinline__ unsigned f2bf(float f) { unsigned u = __builtin_bit_cast(unsigned, f); return (u + 0x7fffu + ((u >> 16) & 1u)) >> 16; }
__device__ __forceinline__ unsigned pk2(float lo, float hi) { return f2bf(lo) | (f2bf(hi) << 16); }
__device__ __forceinline__ float bf2f(unsigned b) { return __builtin_bit_cast(float, b << 16); }
__device__ __forceinline__ float bflo(unsigned u) { return __builtin_bit_cast(float, u << 16); }
__device__ __forceinline__ float bfhi(unsigned u) { return __builtin_bit_cast(float, u & 0xffff0000u); }
__device__ __forceinline__ float fast_sigmoid(float x) { return __builtin_amdgcn_rcpf(1.0f + __builtin_amdgcn_exp2f(-1.44269504089f * x)); }
__device__ __forceinline__ float silu_f(float x) { return x * fast_sigmoid(x); }
#define WS_SWZ(v, o) ((v) + __int_as_float(__builtin_amdgcn_ds_swizzle(__float_as_int(v), 0x1f | ((o) << 10))))
__device__ __forceinline__ float wave_sum(float v) {
    v = WS_SWZ(v, 1); v = WS_SWZ(v, 2); v = WS_SWZ(v, 4); v = WS_SWZ(v, 8); v = WS_SWZ(v, 16);
    return __int_as_float(__builtin_amdgcn_readlane(__float_as_int(v), 0)) + __int_as_float(__builtin_amdgcn_readlane(__float_as_int(v), 32));
}
__device__ __forceinline__ unsigned pk4_fp8(float a, float b, float c, float d) {
    a = __builtin_fminf(__builtin_fmaxf(a, -448.f), 448.f); b = __builtin_fminf(__builtin_fmaxf(b, -448.f), 448.f); c = __builtin_fminf(__builtin_fmaxf(c, -448.f), 448.f); d = __builtin_fminf(__builtin_fmaxf(d, -448.f), 448.f);
    unsigned w = 0; w = __builtin_amdgcn_cvt_pk_fp8_f32(a, b, w, false); w = __builtin_amdgcn_cvt_pk_fp8_f32(c, d, w, true); return w; }
#define LDS_WAIT() asm volatile("s_waitcnt lgkmcnt(0)" ::: "memory")

#define XB_TMO      128
#define XB_XCNT(j)  (256  + 64 * (j))
#define XB_XSUB(j)  (1280 + 64 * (j))
#define XB_XGEN(j)  (2304 + 64 * (j))
#define XB_TOP      3328
#define XB_TOPGEN   3392
#define XCD_BAR_WORDS 3456
#define XB_SPIN_CAP (1u << 18)
__device__ __forceinline__ unsigned xb_ld(unsigned* p)              { return __hip_atomic_load(p, __ATOMIC_RELAXED, __HIP_MEMORY_SCOPE_AGENT); }
__device__ __forceinline__ unsigned xb_add(unsigned* p, unsigned v) { return __hip_atomic_fetch_add(p, v, __ATOMIC_RELAXED, __HIP_MEMORY_SCOPE_AGENT); }
__device__ __forceinline__ unsigned xb_xcc_id() { return (unsigned)__builtin_amdgcn_s_getreg((3 << 11) | 20) & 0xFu; }
#define XB_SPIN(cond, bar) do { unsigned _sp = 0; while (cond) { __builtin_amdgcn_s_sleep(1); \
    if ((++_sp & 255u) == 0u) { if (xb_ld(&(bar)[XB_TMO])) break; if (_sp > XB_SPIN_CAP) { atomicAdd(&(bar)[XB_TMO], 1u); break; } } } } while (0)
struct XcdBarrier { unsigned* bar; unsigned x; volatile LAS unsigned* st; };
__device__ __forceinline__ XcdBarrier xcd_barrier_post(unsigned* bar, volatile LAS unsigned* st) {
    XcdBarrier b; b.bar = bar; b.x = xb_xcc_id(); b.st = st;
    if (threadIdx.x == 0) (void)xb_add(&bar[XB_XCNT(b.x)], 1u);
    return b;
}
__device__ __forceinline__ void xcd_barrier_complete(unsigned* bar, unsigned x, unsigned& nloc, unsigned& nx) {
    const unsigned G = gridDim.x * gridDim.y * gridDim.z;
    unsigned sum, cnt, mine, sp = 0u;
    for (;;) {
        sum = 0u; cnt = 0u; mine = 0u;
#pragma unroll
        for (unsigned j = 0; j < 16; ++j) { const unsigned c = xb_ld(&bar[XB_XCNT(j)]); sum += c; cnt += (c > 0u) ? 1u : 0u; mine = (j == x) ? c : mine; }
        if (sum == G) break;
        __builtin_amdgcn_s_sleep(1);
        if ((++sp & 255u) == 0u) { if (xb_ld(&bar[XB_TMO])) break; if (sp > XB_SPIN_CAP) { atomicAdd(&bar[XB_TMO], 1u); break; } }
    }
    nloc = mine > 0u ? mine : 1u; nx = cnt > 0u ? cnt : 1u;
}
__device__ __forceinline__ void xcd_barrier(const XcdBarrier& b) {
    asm volatile("s_waitcnt vmcnt(0)" ::: "memory");
    __syncthreads();
    if (threadIdx.x == 0) {
        unsigned* bar = b.bar;
        __builtin_amdgcn_s_waitcnt(0);
        unsigned nloc = b.st[0], nx = b.st[1];
        if (nloc == 0u) { xcd_barrier_complete(bar, b.x, nloc, nx); b.st[0] = nloc; b.st[1] = nx; }
        const unsigned old = xb_add(&bar[XB_XSUB(b.x)], 1u);
        const unsigned gen = old / nloc;
        if (old + 1u == (gen + 1u) * nloc) {
            __builtin_amdgcn_fence(__ATOMIC_RELEASE, "agent");
            asm volatile("s_waitcnt vmcnt(0)" ::: "memory");
            const unsigned og = xb_add(&bar[XB_TOP], 1u);
            const unsigned tg = og / nx;
            if (og + 1u == (tg + 1u) * nx) xb_add(&bar[XB_TOPGEN], 1u);
            else XB_SPIN(xb_ld(&bar[XB_TOPGEN]) == tg, bar);
            __builtin_amdgcn_fence(__ATOMIC_ACQUIRE, "agent");
            xb_add(&bar[XB_XGEN(b.x)], 1u);
            asm volatile("s_waitcnt vmcnt(0)" ::: "memory");
        } else {
            XB_SPIN(xb_ld(&bar[XB_XGEN(b.x)]) == gen, bar);
            __builtin_amdgcn_fence(__ATOMIC_ACQUIRE, "agent");
            asm volatile("s_waitcnt vmcnt(0)" ::: "memory");
        }
    }
    __syncthreads();
}

namespace pg8 {
constexpr int BM = 256, BK = 64, HALF = 128, HTB = HALF * BK * 2, STAGE_BYTES = 8 * HTB, NXCD = 8, WGM = 8;
__device__ __forceinline__ int lds_byte(int r, int c) { const int st = (r >> 4) * 2 + (c >> 5), rr = r & 15, cc = c & 31, ob = rr * 64 + cc * 2; return st * 1024 + (ob ^ (((ob >> 9) & 1) << 5)); }
__device__ __forceinline__ void stage_rc(int b, int& R, int& C) { const int st = b / 1024, sb = b % 1024, swz = sb ^ (((sb >> 9) & 1) << 5); R = (st >> 1) * 16 + swz / 64; C = (st & 1) * 32 + (swz % 64) / 2; }
__device__ __forceinline__ int perm32(int rho) { const int n = rho >> 4, i = rho & 15; return 8 * (i >> 2) + 4 * n + (i & 3); }
__device__ __forceinline__ unsigned cvt_pk_bf16(float lo, float hi) { unsigned r; asm volatile("v_cvt_pk_bf16_f32 %0, %1, %2" : "=v"(r) : "v"(lo), "v"(hi)); return r; }

struct Unit { int pm, pn, ex; };

__device__ __forceinline__ int xcd_remap(int wgid, int nwg) { const int q = nwg / NXCD, r = nwg % NXCD, xcd = wgid % NXCD, off = wgid / NXCD; return (xcd < r ? xcd * (q + 1) : r * (q + 1) + (xcd - r) * q) + off; }

struct DenseOrder {
    const bf16* A; const bf16* Bt; int K, nM, nN, nwg, G, c;
    __device__ __forceinline__ void init(const bf16* A_, const bf16* Bt_, int Mr, int N, int K_, int G_, int c_) { A = A_; Bt = Bt_; K = K_; nM = Mr / BM; nN = N / BM; nwg = nM * nN; G = G_; c = c_; }
    __device__ __forceinline__ bool next(int i, Unit& u) const {
        const long L = (long)i * G + c; if (L >= nwg) return false;
        const int wgid = xcd_remap((int)L, nwg);
        const int nig = WGM * nN, gid = wgid / nig, fm = gid * WGM, gsz = (nM - fm) < WGM ? (nM - fm) : WGM;
        u.pm = fm + ((wgid % nig) % gsz); u.pn = (wgid % nig) / gsz; u.ex = 0; return true;
    }
    __device__ __forceinline__ const char* a_ptr(const Unit& u) const { return (const char*)A + (size_t)u.pm * ((size_t)BM * K * 2); }
    __device__ __forceinline__ const char* b_ptr(const Unit& u) const { return (const char*)Bt + (size_t)u.pn * ((size_t)BM * K * 2); }
    __device__ __forceinline__ void rows_raw(const Unit&, int, unsigned (&)[2][2]) const {}
};
struct MoeOrder {
    const LAS int* tab; const bf16* A; const bf16* Bt; size_t bstride; const int* list; int K, nN, G, c; bool gather;
    __device__ __forceinline__ bool next(int i, Unit& u) const {
        const int U = __builtin_amdgcn_readfirstlane(tab[1]), ng = __builtin_amdgcn_readfirstlane(tab[0]);
        const long L = (long)i * G + c; if (L >= U) return false;
        const int wgid = xcd_remap((int)L, U);
        int g = 0, hi = ng;
        while (hi - g > 1) { const int mid = (g + hi) >> 1; const int v = __builtin_amdgcn_readfirstlane(tab[64 + mid]); if (v <= wgid) g = mid; else hi = mid; }
        const int g0 = __builtin_amdgcn_readfirstlane(tab[64 + g]), t0 = __builtin_amdgcn_readfirstlane(tab[128 + g]), gsz = __builtin_amdgcn_readfirstlane(tab[192 + g]), ex = __builtin_amdgcn_readfirstlane(tab[256 + g]);
        const int local = wgid - g0;
        u.pm = t0 + local % gsz; u.pn = local / gsz; u.ex = ex; return true;
    }
    __device__ __forceinline__ const char* a_ptr(const Unit& u) const { return gather ? (const char*)A : (const char*)A + (size_t)u.pm * ((size_t)BM * K * 2); }
    __device__ __forceinline__ const char* b_ptr(const Unit& u) const { return (const char*)Bt + (size_t)u.ex * bstride + (size_t)u.pn * ((size_t)BM * K * 2); }
    __device__ __forceinline__ void rows_raw(const Unit& u, int tid, unsigned (&raw)[2][2]) const {
        asm volatile("" : "+v"(tid));
        const __amdgpu_buffer_rsrc_t rs = __builtin_amdgcn_make_buffer_rsrc((void*)(list + (size_t)u.pm * BM), (short)0, BM * 4, 0x00020000);
#pragma unroll
        for (int i = 0; i < 2; ++i) { int R, C; stage_rc(tid * 16 + i * 8192, R, C);
#pragma unroll
            for (int h = 0; h < 2; ++h) raw[h][i] = (unsigned)__builtin_amdgcn_raw_buffer_load_b32(rs, (unsigned)(h * HALF + R) * 4u, 0, 0); }
    }
};

struct EpiBf16 {
    static constexpr bool PERM = true;
    bf16* O; int ldc; int skip;
    __device__ __forceinline__ void operator()(const f32x4 (&acc)[2][2][4][2], const Unit& u, int wr, int wc, int fr, int fq) const {
        const int row0 = u.pm * BM + wr * 64 + fr, col0 = u.pn * BM + wc * 32 + 8 * fq;
        if (skip) { if (acc[0][0][0][0][0] == 12345.678f) O[0] = 1; return; }
#pragma unroll
        for (int ai = 0; ai < 2; ++ai)
#pragma unroll
            for (int m = 0; m < 4; ++m) { bf16* rowp = O + (size_t)(row0 + ai * HALF + m * 16) * ldc + col0;
#pragma unroll
                for (int bj = 0; bj < 2; ++bj) { const f32x4 v0 = acc[ai][bj][m][0], v1 = acc[ai][bj][m][1];
                    u32x4 w; w.x = cvt_pk_bf16(v0[0], v0[1]); w.y = cvt_pk_bf16(v0[2], v0[3]); w.z = cvt_pk_bf16(v1[0], v1[1]); w.w = cvt_pk_bf16(v1[2], v1[3]);
                    *(u32x4*)(rowp + bj * HALF) = w; } }
    }
};
struct EpiSwiglu {
    static constexpr bool PERM = true;
    bf16* O; int ldc;
    __device__ __forceinline__ void operator()(const f32x4 (&acc)[2][2][4][2], const Unit& u, int wr, int wc, int fr, int fq) const {
        const int row0 = u.pm * BM + wr * 64 + fr, col0 = u.pn * HALF + wc * 32 + 8 * fq;
#pragma unroll
        for (int ai = 0; ai < 2; ++ai)
#pragma unroll
            for (int m = 0; m < 4; ++m) { bf16* rowp = O + (size_t)(row0 + ai * HALF + m * 16) * ldc + col0;
                float o[8];
#pragma unroll
                for (int n = 0; n < 2; ++n)
#pragma unroll
                    for (int j = 0; j < 4; ++j) { const float g = acc[ai][0][m][n][j], up = acc[ai][1][m][n][j]; o[n * 4 + j] = silu_f(g) * up; }
                u32x4 w; w.x = cvt_pk_bf16(o[0], o[1]); w.y = cvt_pk_bf16(o[2], o[3]); w.z = cvt_pk_bf16(o[4], o[5]); w.w = cvt_pk_bf16(o[6], o[7]);
                *(u32x4*)rowp = w; }
    }
};
struct EpiSwigluF8 {
    static constexpr bool PERM = true;
    unsigned char* O; int ldc;
    __device__ __forceinline__ void operator()(const f32x4 (&acc)[2][2][4][2], const Unit& u, int wr, int wc, int fr, int fq) const {
        const int row0 = u.pm * BM + wr * 64 + fr, col0 = u.pn * HALF + wc * 32 + 8 * fq;
        constexpr float si = 1.0f / (SC_H * SC_W);
#pragma unroll
        for (int ai = 0; ai < 2; ++ai)
#pragma unroll
            for (int m = 0; m < 4; ++m) { unsigned char* rowp = O + (size_t)(row0 + ai * HALF + m * 16) * ldc + col0;
                float o[8];
#pragma unroll
                for (int n = 0; n < 2; ++n)
#pragma unroll
                    for (int j = 0; j < 4; ++j) { const float g = acc[ai][0][m][n][j] * si, up = acc[ai][1][m][n][j] * (si * SC_A); o[n * 4 + j] = silu_f(g) * up; }
                u32x2 w; w.x = pk4_fp8(o[0], o[1], o[2], o[3]); w.y = pk4_fp8(o[4], o[5], o[6], o[7]);
                *(u32x2*)rowp = w; }
    }
};
template <bool XF32> struct EpiResidual {
    static constexpr bool PERM = true;
    const void* xin; bf16* out; const float* gate; float gs;
    __device__ __forceinline__ void operator()(const f32x4 (&acc)[2][2][4][2], const Unit& u, int wr, int wc, int fr, int fq) const {
        const int row0 = u.pm * BM + wr * 64 + fr, col0 = u.pn * BM + wc * 32 + 8 * fq, b = u.pm >> 5;
        f32x4 gv[2][2];
#pragma unroll
        for (int bj = 0; bj < 2; ++bj)
#pragma unroll
            for (int n = 0; n < 2; ++n) gv[bj][n] = *(const f32x4*)(gate + (size_t)b * NMOD + col0 + bj * HALF + n * 4) * gs;
#pragma unroll
        for (int ai = 0; ai < 2; ++ai)
#pragma unroll
            for (int m = 0; m < 4; ++m) { const size_t off = (size_t)(row0 + ai * HALF + m * 16) * D + col0;
#pragma unroll
                for (int bj = 0; bj < 2; ++bj) { f32x4 x0, x1;
                    if (XF32) { x0 = *(const f32x4*)((const float*)xin + off + bj * HALF); x1 = *(const f32x4*)((const float*)xin + off + bj * HALF + 4); }
                    else { const u32x4 xr = *(const u32x4*)((const bf16*)xin + off + bj * HALF); x0 = (f32x4){bflo(xr.x), bfhi(xr.x), bflo(xr.y), bfhi(xr.y)}; x1 = (f32x4){bflo(xr.z), bfhi(xr.z), bflo(xr.w), bfhi(xr.w)}; }
                    const f32x4 r0 = x0 + gv[bj][0] * acc[ai][bj][m][0], r1 = x1 + gv[bj][1] * acc[ai][bj][m][1];
                    u32x4 w; w.x = cvt_pk_bf16(r0[0], r0[1]); w.y = cvt_pk_bf16(r0[2], r0[3]); w.z = cvt_pk_bf16(r1[0], r1[1]); w.w = cvt_pk_bf16(r1[2], r1[3]);
                    *(u32x4*)(out + off + bj * HALF) = w; }
                asm volatile("" ::: "memory"); }
    }
};
struct EpiMoeDown {
    static constexpr bool PERM = true;
    bf16* out; const int* list; const float* wgt; const float* gate; float ascale; bf16* dump;
    __device__ __forceinline__ void operator()(const f32x4 (&acc)[2][2][4][2], const Unit& u, int wr, int wc, int fr, int fq) const {
        const int pos0 = u.pm * BM + wr * 64 + fr, col0 = u.pn * BM + wc * 32 + 8 * fq;
#pragma unroll
        for (int ai = 0; ai < 2; ++ai)
#pragma unroll
            for (int m = 0; m < 4; ++m) { const int pos = pos0 + ai * HALF + m * 16; const int tk = list[pos]; const float w = wgt[pos] * ascale;
                bf16* orow = (tk >= 0 ? out + (size_t)tk * D : dump) + col0; const float* gp = gate + (size_t)(tk >= 0 ? (tk >> 13) : 0) * NMOD + col0;
#pragma unroll
                for (int bj = 0; bj < 2; ++bj) { const f32x4 g0 = *(const f32x4*)(gp + bj * HALF), g1 = *(const f32x4*)(gp + bj * HALF + 4);
                    const u32x4 xr = *(const u32x4*)(orow + bj * HALF);
                    const f32x4 x0 = {bflo(xr.x), bfhi(xr.x), bflo(xr.y), bfhi(xr.y)}, x1 = {bflo(xr.z), bfhi(xr.z), bflo(xr.w), bfhi(xr.w)};
                    const f32x4 r0 = x0 + (g0 * w) * acc[ai][bj][m][0], r1 = x1 + (g1 * w) * acc[ai][bj][m][1];
                    u32x4 o; o.x = cvt_pk_bf16(r0[0], r0[1]); o.y = cvt_pk_bf16(r0[2], r0[3]); o.z = cvt_pk_bf16(r1[0], r1[1]); o.w = cvt_pk_bf16(r1[2], r1[3]);
                    *(u32x4*)(orow + bj * HALF) = o; }
                asm volatile("" ::: "memory"); }
    }
};

template <class Epi, class Sched, bool GATHER, bool FP8 = false>
__device__ __forceinline__ void gemm_phase(LAS unsigned char* lds, const int K, const Sched& S, const Epi& E, LAS u32x4* goff = nullptr, int ntdiv = 1) {
    int tid_ = threadIdx.x; asm volatile("" : "+v"(tid_));
    const int tid = tid_, wid = __builtin_amdgcn_readfirstlane(tid >> 6), lane = tid & 63, wr = wid >> 2, wc = wid & 3, fr = lane & 15, fq = lane >> 4;
    int nt = K / BK / ntdiv; asm volatile("" : "+s"(nt));
    unsigned voffB[2], ao[2][2], no[2][2];
    const size_t kstep = (size_t)(BK * 2);
    const size_t hstep = (size_t)HALF * K * 2;
#pragma unroll
    for (int i = 0; i < 2; ++i) { int R, C; stage_rc(tid * 16 + i * 8192, R, C); const int Rb = Epi::PERM ? ((R & ~31) + perm32(R & 31)) : R;
        voffB[i] = (unsigned)(Rb * K + C) * 2u;
        ao[0][i] = (unsigned)(R * K + C) * 2u; ao[1][i] = ao[0][i] + (unsigned)hstep; no[0][i] = ao[0][i]; no[1][i] = ao[1][i]; }
    const unsigned ldsw = (unsigned)wid * 1024u;
    const int aoff = lds_byte(wr * 64 + fr, fq * 8), boff = lds_byte(wc * 32 + fr, fq * 8);
#define PG8_CB(i) ([&]() { int t_ = tid; asm volatile("" : "+v"(t_)); int R_, C_; stage_rc(t_ * 16 + (i) * 8192, R_, C_); return (unsigned)C_ * 2u; }())
#define PG8_SA(b, h) (((b) * 2 + (h)) * HTB)
#define PG8_SB(b, h) ((4 + (b) * 2 + (h)) * HTB)
#define PG8_STAGEB(bufoff, gbase) do { _Pragma("unroll") for (int _i = 0; _i < 2; ++_i) \
        __builtin_amdgcn_global_load_lds((const unsigned*)((const char*)(gbase) + voffB[_i]), (LAS unsigned*)(lds + (bufoff) + ldsw + _i * 8192), 16, 0, 0); } while (0)
#define PG8_STAGEA(bufoff, gbase, offs, h) do { _Pragma("unroll") for (int _i = 0; _i < 2; ++_i) \
        __builtin_amdgcn_global_load_lds((const unsigned*)((const char*)(gbase) + (offs)[h][_i]), (LAS unsigned*)(lds + (bufoff) + ldsw + _i * 8192), 16, 0, 0); } while (0)
#define PG8_LD32(p) __builtin_shufflevector(*(const LAS i32x4*)(p), *(const LAS i32x4*)((p) + 1024), 0, 1, 2, 3, 4, 5, 6, 7)
#define PG8_LDA(dst, b, h) do { _Pragma("unroll") for (int m = 0; m < 4; ++m) { if constexpr (FP8) dst##8[m] = PG8_LD32(lds + PG8_SA(b, h) + aoff + m * 2048); \
        else { _Pragma("unroll") for (int k = 0; k < 2; ++k) dst[m][k] = *(const LAS bf16x8*)(lds + PG8_SA(b, h) + aoff + m * 2048 + k * 1024); } } } while (0)
#define PG8_LDB(dst, b, h) do { _Pragma("unroll") for (int n = 0; n < 2; ++n) { if constexpr (FP8) dst##8[n] = PG8_LD32(lds + PG8_SB(b, h) + boff + n * 2048); \
        else { _Pragma("unroll") for (int k = 0; k < 2; ++k) dst[n][k] = *(const LAS bf16x8*)(lds + PG8_SB(b, h) + boff + n * 2048 + k * 1024); } } } while (0)
#define PG8_MMA(ai, bj, At, Bt) do { __builtin_amdgcn_s_setprio(1); _Pragma("unroll") for (int m = 0; m < 4; ++m) _Pragma("unroll") for (int n = 0; n < 2; ++n) { \
        if constexpr (FP8) asm volatile("v_mfma_scale_f32_16x16x128_f8f6f4 %0, %1, %2, %0, %3, %3 op_sel_hi:[0,0,0]" : "+v"(acc[ai][bj][m][n]) : "v"(Bt##8[n]), "v"(At##8[m]), "v"(sc1));     \
        else { _Pragma("unroll") for (int k = 0; k < 2; ++k) acc[ai][bj][m][n] = __builtin_amdgcn_mfma_f32_16x16x32_bf16(Bt[n][k], At[m][k], acc[ai][bj][m][n], 0, 0, 0); } } \
        __builtin_amdgcn_s_setprio(0); } while (0)
#define PG8_WAIT_V(n) asm volatile("s_waitcnt vmcnt(" #n ")" ::: "memory")
#define PG8_WAIT_L(n) asm volatile("s_waitcnt lgkmcnt(" #n ")" ::: "memory")
#define PG8_BAR __builtin_amdgcn_s_barrier()
#define PG8_SCHED __builtin_amdgcn_sched_barrier(0)
    Unit cur, nxt, nn; int ui = 0;
    if (!S.next(0, cur)) return;
    bool has_next = S.next(1, nxt);
    if constexpr (GATHER) {
        unsigned raw[2][2]; S.rows_raw(cur, tid, raw);
#pragma unroll
        for (int h = 0; h < 2; ++h)
#pragma unroll
            for (int i = 0; i < 2; ++i) ao[h][i] = (raw[h][i] & 0xffffffu) * (unsigned)(K * 2) + PG8_CB(i);
        if (has_next) { S.rows_raw(nxt, tid, raw);
#pragma unroll
            for (int h = 0; h < 2; ++h)
#pragma unroll
                for (int i = 0; i < 2; ++i) no[h][i] = (raw[h][i] & 0xffffffu) * (unsigned)(K * 2) + PG8_CB(i); }
        else {
#pragma unroll
            for (int h = 0; h < 2; ++h)
#pragma unroll
                for (int i = 0; i < 2; ++i) no[h][i] = ao[h][i]; }
        goff[tid] = (u32x4){no[0][0], no[0][1], no[1][0], no[1][1]};
    }
    f32x4 acc[2][2][4][2];
#pragma unroll
    for (int a = 0; a < 2; ++a)
#pragma unroll
        for (int b = 0; b < 2; ++b)
#pragma unroll
            for (int m = 0; m < 4; ++m)
#pragma unroll
                for (int n = 0; n < 2; ++n) acc[a][b][m][n] = (f32x4){0.f, 0.f, 0.f, 0.f};
    const int sc1 = 0x7f7f7f7f;
    bf16x8 At[4][2], B0[2][2], B1[2][2];
    i32x8 At8[4], B08[2], B18[2];
    const char* cA = S.a_ptr(cur); const char* cB = S.b_ptr(cur);
    PG8_STAGEB(PG8_SB(0, 0), cB); PG8_STAGEB(PG8_SB(0, 1), cB + hstep); PG8_STAGEA(PG8_SA(0, 0), cA, ao, 0); PG8_STAGEA(PG8_SA(0, 1), cA, ao, 1);
    if (wr == 1) PG8_BAR;
    PG8_WAIT_V(2); PG8_BAR;
    PG8_STAGEB(PG8_SB(1, 0), cB + kstep); PG8_STAGEA(PG8_SA(1, 0), cA + kstep, ao, 0); PG8_STAGEB(PG8_SB(1, 1), cB + hstep + kstep);
    PG8_WAIT_V(6); PG8_BAR;
    for (;;) {
        const char* nA = has_next ? S.a_ptr(nxt) : cA; const char* nB = has_next ? S.b_ptr(nxt) : cB;
#pragma clang loop unroll(disable)
        for (int t = 0; t < nt; t += 2) {
            const bool last = (t == nt - 2);
            const char* a1 = cA + (size_t)(t + 1) * kstep;
            const char* a2 = last ? nA : cA + (size_t)(t + 2) * kstep; const char* b2 = last ? nB : cB + (size_t)(t + 2) * kstep;
            const char* a3 = a2 + kstep; const char* b3 = b2 + kstep;
            asm volatile("" : "+v"(voffB[0]), "+v"(voffB[1]), "+v"(ao[0][0]), "+v"(ao[0][1]), "+v"(ao[1][0]), "+v"(ao[1][1]));
            PG8_LDB(B0, 0, 0); PG8_LDB(B1, 0, 1); PG8_SCHED; PG8_LDA(At, 0, 0); PG8_STAGEA(PG8_SA(1, 1), a1, ao, 1);
            if constexpr (GATHER) { if (last) { const u32x4 q = goff[tid]; ao[0][0] = q[0]; ao[0][1] = q[1]; ao[1][0] = q[2]; ao[1][1] = q[3]; } }
            PG8_WAIT_V(8); PG8_WAIT_L(0); PG8_BAR; PG8_MMA(0, 0, At, B0); PG8_MMA(0, 1, At, B1); PG8_BAR; PG8_SCHED;
            PG8_LDA(At, 0, 1); PG8_STAGEB(PG8_SB(0, 0), b2); PG8_STAGEB(PG8_SB(0, 1), b2 + hstep); PG8_STAGEA(PG8_SA(0, 0), a2, ao, 0);
            PG8_WAIT_V(8); PG8_WAIT_L(0); PG8_BAR; PG8_MMA(1, 0, At, B0); PG8_MMA(1, 1, At, B1); PG8_BAR; PG8_SCHED;
            PG8_LDB(B0, 1, 0); PG8_LDB(B1, 1, 1); PG8_SCHED; PG8_LDA(At, 1, 0); PG8_STAGEA(PG8_SA(0, 1), a2, ao, 1);
            PG8_WAIT_V(8); PG8_WAIT_L(0); PG8_BAR; PG8_MMA(0, 0, At, B0); PG8_MMA(0, 1, At, B1); PG8_BAR; PG8_SCHED;
            PG8_LDA(At, 1, 1); PG8_STAGEB(PG8_SB(1, 0), b3); PG8_STAGEB(PG8_SB(1, 1), b3 + hstep); PG8_STAGEA(PG8_SA(1, 0), a3, ao, 0);
            PG8_WAIT_V(8); PG8_WAIT_L(0); PG8_BAR; PG8_MMA(1, 0, At, B0); PG8_MMA(1, 1, At, B1); PG8_BAR; PG8_SCHED;
        }
        if (wr == 0) PG8_BAR;
        if constexpr (FP8) asm volatile("s_nop 15\n\ts_nop 15\n\ts_nop 7" ::: "memory");
        bool has_nn = false; unsigned raw[2][2];
        if (has_next) has_nn = S.next(ui + 2, nn);
        if constexpr (GATHER) { if (has_nn) S.rows_raw(nn, tid, raw); }
        E(acc, cur, wr, wc, fr, fq);
        if (!has_next) break;
#pragma unroll
        for (int a = 0; a < 2; ++a)
#pragma unroll
            for (int b = 0; b < 2; ++b)
#pragma unroll
                for (int m = 0; m < 4; ++m)
#pragma unroll
                    for (int n = 0; n < 2; ++n) acc[a][b][m][n] = (f32x4){0.f, 0.f, 0.f, 0.f};
        if constexpr (GATHER) {
            if (has_nn) { u32x4 q;
#pragma unroll
                for (int h = 0; h < 2; ++h)
#pragma unroll
                    for (int i = 0; i < 2; ++i) q[h * 2 + i] = (raw[h][i] & 0xffffffu) * (unsigned)(K * 2) + PG8_CB(i);
                goff[tid] = q; }
        }
        cur = nxt; cA = nA; cB = nB; nxt = nn; has_next = has_nn; ++ui;
        if (wr == 1) PG8_BAR;
    }
    PG8_WAIT_V(0);
    PG8_BAR;
#undef PG8_SA
#undef PG8_CB
#undef PG8_SB
#undef PG8_STAGEA
#undef PG8_STAGEB
#undef PG8_LDA
#undef PG8_LDB
#undef PG8_MMA
#undef PG8_LD32
#undef PG8_WAIT_V
#undef PG8_WAIT_L
#undef PG8_BAR
#undef PG8_SCHED
}
}

struct Args { const float* in[27]; float* out; unsigned char* ws; };
typedef const float* cfp_t;
typedef __attribute__((address_space(4))) const cfp_t* kargp_t;
struct Frame {
    LAS unsigned char* lds;
    int tid, lane, wave, G, bid;
    kargp_t ka;
};
#define PHASE_ENTER(F) do { kargp_t _p = (F).ka; asm volatile("" : "+s"(_p)); (F).ka = _p; \
    int _t = threadIdx.x; asm volatile("" : "+v"(_t)); (F).tid = _t; (F).lane = _t & 63; (F).wave = __builtin_amdgcn_readfirstlane(_t >> 6); \
    int _g = gridDim.x; asm volatile("" : "+s"(_g)); (F).G = _g; int _b = blockIdx.x; asm volatile("" : "+s"(_b)); (F).bid = _b; } while (0)
#define KIN(k) ((F).ka[k])
#define KOUT ((float*)(F).ka[27])
#define KWS ((unsigned char*)(F).ka[28])
#define KMOD ((float*)(KWS + WS_MOD))
#define KH ((bf16*)(KWS + WS_H))
#define KPROJ ((bf16*)(KWS + WS_BIG))
#define KMIXED ((bf16*)(KWS + WS_MIXED))
#define KACT ((bf16*)(KWS + WS_BIG))
#define KXB ((bf16*)(KWS + WS_XB))

__device__ __forceinline__ void p0_transpose_item(const float* W, int K, int N, bf16* WT, int dst_row0, LAS float* scr, int kb, int nb, int lane) {
    const int k0 = 64 * kb, n0 = 32 * nb;
#pragma unroll 8
    for (int i = 0; i < 32; ++i) { const int kk = 2 * i + (lane >> 5); scr[kk * 33 + (lane & 31)] = W[(size_t)(k0 + kk) * N + n0 + (lane & 31)]; }
    LDS_WAIT(); asm volatile("" ::: "memory");
    const int c = lane & 7;
#pragma unroll
    for (int j = 0; j < 4; ++j) { const int n = (lane >> 3) + 8 * j; const LAS float* s = scr + (8 * c) * 33 + n;
        u32x4 o; o.x = pk2(s[0 * 33], s[1 * 33]); o.y = pk2(s[2 * 33], s[3 * 33]); o.z = pk2(s[4 * 33], s[5 * 33]); o.w = pk2(s[6 * 33], s[7 * 33]);
        *(u32x4*)(WT + (size_t)(dst_row0 + n) * K + k0 + 8 * c) = o; }
    LDS_WAIT(); asm volatile("" ::: "memory");
}
__device__ __forceinline__ void p0_transpose_item_f8(const float* W, int K, int N, unsigned char* WT, int dst_row0, LAS float* scr, int kb, int nb, int lane) {
    const int k0 = 64 * kb, n0 = 32 * nb;
#pragma unroll 8
    for (int i = 0; i < 32; ++i) { const int kk = 2 * i + (lane >> 5); scr[kk * 33 + (lane & 31)] = W[(size_t)(k0 + kk) * N + n0 + (lane & 31)]; }
    LDS_WAIT(); asm volatile("" ::: "memory");
    const int n = lane >> 1, kh = (lane & 1) * 32; const LAS float* sp = scr + kh * 33 + n;
#pragma unroll
    for (int q = 0; q < 2; ++q) { u32x4 o;
#pragma unroll
        for (int d = 0; d < 4; ++d) { const int kk = q * 16 + d * 4; o[d] = pk4_fp8(sp[(kk + 0) * 33] * SC_W, sp[(kk + 1) * 33] * SC_W, sp[(kk + 2) * 33] * SC_W, sp[(kk + 3) * 33] * SC_W); }
        *(u32x4*)(WT + (size_t)(dst_row0 + n) * K + k0 + kh + q * 16) = o; }
    LDS_WAIT(); asm volatile("" ::: "memory");
}
__device__ __forceinline__ int gu_row(int n) { return (n >> 7) * 256 + (n & 127); }

__device__ __forceinline__ void p0_prologue(Frame& F) {
    if (F.bid < 192) {
        LAS float* cond = (LAS float*)F.lds;
        LAS float* red = (LAS float*)(F.lds + 32768);
        const float* cin = KIN(1);
        for (int i = F.tid; i < BATCH * D; i += NTHREADS) cond[i] = silu_f(cin[i]);
        __syncthreads();
        for (int item = F.bid; item < 192; item += F.G) {
            const int l = item / 96, colbase = (item % 96) * 64, col = colbase + F.lane;
            const float* W = KIN(2) + (size_t)l * D * NMOD;
            float a[8];
#pragma unroll
            for (int b = 0; b < 8; ++b) a[b] = 0.f;
            for (int k = F.wave * 128; k < F.wave * 128 + 128; ++k) { const float w = W[(size_t)k * NMOD + col];
#pragma unroll
                for (int b = 0; b < 8; ++b) a[b] = fmaf(cond[b * D + k], w, a[b]); }
#pragma unroll
            for (int b = 0; b < 8; ++b) red[(F.wave * 8 + b) * 64 + F.lane] = a[b];
            __syncthreads();
            { const int b = F.tid >> 6, cl = F.tid & 63; float s = 0.f;
#pragma unroll
              for (int w = 0; w < 8; ++w) s += red[(w * 8 + b) * 64 + cl];
              KMOD[((size_t)l * BATCH + b) * NMOD + colbase + cl] = s + KIN(3)[(size_t)l * NMOD + colbase + cl]; }
            __syncthreads();
        }
    }
    LAS float* scr = (LAS float*)(F.lds + F.wave * 16384);
    const int gw = F.bid * NWAVES + F.wave, NGW = F.G * NWAVES;
    constexpr int I_IN = 16 * 56, I_OUT = 16 * 32, I_FG = 16 * 88, I_FD = 44 * 32, I_MG = 16 * 112, I_MD = 56 * 32;
    constexpr int NITEMS = 2 * I_IN + 2 * I_OUT + 2 * I_FG + I_FD + 16 * I_MG + 8 * I_MD;
    bf16* ws_b = (bf16*)KWS;
    for (int it = gw; it < NITEMS; it += NGW) {
        int r = it;
        if (r < 2 * I_IN) { const int l = r / I_IN; r -= l * I_IN; const int kb = r / 56, nb = r % 56;
            p0_transpose_item(KIN(6) + (size_t)l * D * D_IN, D, D_IN, (bf16*)(KWS + WS_WIN) + (size_t)l * D_IN * D, 32 * nb, scr, kb, nb, F.lane); continue; } r -= 2 * I_IN;
        if (r < 2 * I_OUT) { const int l = r / I_OUT; r -= l * I_OUT; const int kb = r / 32, nb = r % 32;
            p0_transpose_item(KIN(17) + (size_t)l * D * D, D, D, (bf16*)(KWS + WS_WOUT) + (size_t)l * D * D, 32 * nb, scr, kb, nb, F.lane); continue; } r -= 2 * I_OUT;
        if (r < 2 * I_FG) { const int up = r / I_FG; r -= up * I_FG; const int kb = r / 88, nb = r % 88;
            p0_transpose_item(up ? KIN(19) : KIN(18), D, FF, (bf16*)(KWS + WS_WGU), gu_row(32 * nb) + 128 * up, scr, kb, nb, F.lane); continue; } r -= 2 * I_FG;
        if (r < I_FD) { const int kb = r / 32, nb = r % 32;
            p0_transpose_item(KIN(20), FF, D, (bf16*)(KWS + WS_WD), 32 * nb, scr, kb, nb, F.lane); continue; } r -= I_FD;
        if (r < 16 * I_MG) { const int q = r / I_MG; r -= q * I_MG; const int up = q >> 3, e = q & 7; const int kb = r / 112, nb = r % 112;
            p0_transpose_item_f8((up ? KIN(24) : KIN(23)) + (size_t)e * D * FFE, D, FFE, (unsigned char*)(KWS + WS_MWGU) + (size_t)e * 2 * FFE * D, gu_row(32 * nb) + 128 * up, scr, kb, nb, F.lane); continue; } r -= 16 * I_MG;
        { const int e = r / I_MD; r -= e * I_MD; const int kb = r / 32, nb = r % 32;
            p0_transpose_item_f8(KIN(25) + (size_t)e * FFE * D, FFE, D, (unsigned char*)(KWS + WS_MWD) + (size_t)e * D * FFE, 32 * nb, scr, kb, nb, F.lane); }
    }
    (void)ws_b;
    if (F.bid == 0) for (int i = F.tid; i < D; i += NTHREADS) ((float*)(KWS + WS_DUMP))[i] = 0.f;
    { bf16* pw = (bf16*)(KWS + WS_POOLW);
      for (int i = F.bid * NTHREADS + F.tid; i < 2 * 4 * 64 * 64; i += F.G * NTHREADS) { const int c = i & 63, d = (i >> 6) & 63, lg = i >> 12;
          pw[i] = (bf16)f2bf(KIN(7)[((size_t)lg * 64 + c) * 64 + d] * KIN(8)[lg * 64 + d]); } }
    { const float* sw = KIN(15); bf16* so = (bf16*)(KWS + WS_SGUW);
      for (int i = (F.bid * NTHREADS + F.tid) * 4; i < 2 * NH * 128 * 128; i += F.G * NTHREADS * 4) { const f32x4 v = *(const f32x4*)(sw + i); u32x2 o; o.x = pk2(v[0], v[1]); o.y = pk2(v[2], v[3]); *(u32x2*)(so + i) = o; } }
}

template <int MODE, bool SRCB>
__device__ __forceinline__ void norm_phase(Frame& F, const void* xsrc, const float* g, const float* shiftp, const float* scalep, bf16* hdst, float* fdst) {
    LAS int* lhist = (LAS int*)(F.lds + LC_HIST);
    for (int tb = F.bid; tb < M / 256; tb += F.G) {
        const int row0 = tb * 256 + F.wave * 32, b = row0 >> 13;
        f32x4 gm[4], sh[4];
#pragma unroll
        for (int j = 0; j < 4; ++j) { const int col = 4 * F.lane + 256 * j; const f32x4 gg = *(const f32x4*)(g + col);
            if (MODE == 2) { gm[j] = gg; sh[j] = (f32x4){0.f, 0.f, 0.f, 0.f}; }
            else { const f32x4 sc = *(const f32x4*)(scalep + (size_t)b * NMOD + col); gm[j] = gg * (1.0f + sc); sh[j] = *(const f32x4*)(shiftp + (size_t)b * NMOD + col); } }
        float rbias[8];
        LAS float* rwl = (LAS float*)F.lds;
        if (MODE == 1) {
            for (int i = F.tid; i < D * NE; i += NTHREADS) rwl[(i & 7) * D + (i >> 3)] = KIN(21)[i];
#pragma unroll
            for (int e = 0; e < 8; ++e) rbias[e] = KIN(22)[e];
            if (F.tid < 16) lhist[F.tid] = 0;
            __syncthreads();
        }
        for (int r = 0; r < 32; ++r) {
            const int row = row0 + r;
            f32x4 v[4]; float ss = 0.f;
            if (SRCB) { const u32x2* xr = (const u32x2*)((const bf16*)xsrc + (size_t)row * D) + F.lane;
#pragma unroll
                for (int j = 0; j < 4; ++j) { const u32x2 t = xr[64 * j]; v[j] = (f32x4){bflo(t.x), bfhi(t.x), bflo(t.y), bfhi(t.y)}; } }
            else { const f32x4* xr = (const f32x4*)((const float*)xsrc + (size_t)row * D) + F.lane;
#pragma unroll
                for (int j = 0; j < 4; ++j) v[j] = xr[64 * j]; }
#pragma unroll
            for (int j = 0; j < 4; ++j) { ss += (v[j][0] * v[j][0] + v[j][1] * v[j][1]) + (v[j][2] * v[j][2] + v[j][3] * v[j][3]); }
            const float rstd = 1.0f / sqrtf(wave_sum(ss) * (1.0f / D) + EPS);
#pragma unroll
            for (int j = 0; j < 4; ++j) v[j] = (v[j] * rstd) * gm[j] + sh[j];
            if (MODE == 2) { f32x4* o = (f32x4*)(fdst + (size_t)row * D) + F.lane;
#pragma unroll
                for (int j = 0; j < 4; ++j) o[64 * j] = v[j]; }
            else if (MODE == 1) { unsigned* o = (unsigned*)((unsigned char*)hdst + (size_t)row * D) + F.lane;
#pragma unroll
                for (int j = 0; j < 4; ++j) o[64 * j] = pk4_fp8(v[j][0] * SC_H, v[j][1] * SC_H, v[j][2] * SC_H, v[j][3] * SC_H); }
            else { u32x2* o = (u32x2*)(hdst + (size_t)row * D) + F.lane;
#pragma unroll
                for (int j = 0; j < 4; ++j) { u32x2 w; w.x = pk2(v[j][0], v[j][1]); w.y = pk2(v[j][2], v[j][3]); o[64 * j] = w; } }
            if (MODE == 1) {
                float lg[8];
#pragma unroll
                for (int e = 0; e < 8; ++e) lg[e] = 0.f;
#pragma unroll
                for (int e = 0; e < 8; ++e)
#pragma unroll
                    for (int j = 0; j < 4; ++j) { const f32x4 wv = *(const LAS f32x4*)(rwl + e * D + 4 * F.lane + 256 * j);
                        lg[e] = fmaf(v[j][0], wv[0], lg[e]); lg[e] = fmaf(v[j][1], wv[1], lg[e]); lg[e] = fmaf(v[j][2], wv[2], lg[e]); lg[e] = fmaf(v[j][3], wv[3], lg[e]); }
#pragma unroll
                for (int e = 0; e < 8; ++e) lg[e] = wave_sum(lg[e]) + rbias[e];
                int i1 = 0; float v1 = lg[0];
#pragma unroll
                for (int e = 1; e < 8; ++e) if (lg[e] > v1) { v1 = lg[e]; i1 = e; }
                int i2 = -1; float v2 = -3.0e38f;
#pragma unroll
                for (int e = 0; e < 8; ++e) if (e != i1 && lg[e] > v2) { v2 = lg[e]; i2 = e; }
                const float ex = __expf(v2 - v1), w1 = 1.0f / (1.0f + ex), w2 = ex * w1;
                if (F.lane == 0) { u32x4 rec; rec.x = (unsigned)i1; rec.y = (unsigned)i2; rec.z = __float_as_uint(w1); rec.w = __float_as_uint(w2);
                    *(u32x4*)(KWS + WS_REC + (size_t)row * 16) = rec; __hip_atomic_fetch_add(&lhist[i1], 1, __ATOMIC_RELAXED, __HIP_MEMORY_SCOPE_WORKGROUP); __hip_atomic_fetch_add(&lhist[8 + i2], 1, __ATOMIC_RELAXED, __HIP_MEMORY_SCOPE_WORKGROUP); }
            }
        }
        if (MODE == 1) { __syncthreads(); if (F.tid < 16) ((int*)(KWS + WS_HIST))[tb * 16 + F.tid] = lhist[F.tid]; __syncthreads(); }
    }
}

__device__ __forceinline__ void route_phase(Frame& F) {
    LAS int* ltot = (LAS int*)(F.lds + LC_TOT); LAS int* lpre = (LAS int*)(F.lds + LC_PRE); LAS int* ltb = (LAS int*)(F.lds + LC_TBASE); LAS int* lwc = (LAS int*)(F.lds + LC_WCNT);
    const int* hist = (const int*)(KWS + WS_HIST);
    int* list = (int*)(KWS + WS_LIST); float* wgt = (float*)(KWS + WS_WGT);
    for (int tb = F.bid; tb < M / 256; tb += F.G) {
        if (F.tid < 16) { ltot[F.tid] = 0; lpre[F.tid] = 0; }
        __syncthreads();
        { const int pe = F.tid & 15, part = F.tid >> 4; int sa = 0, sp = 0;
#pragma unroll
          for (int k = 0; k < 8; ++k) { const int t = part * 8 + k; const int v = hist[t * 16 + pe]; sa += v; sp += (t < tb) ? v : 0; }
          __hip_atomic_fetch_add(&ltot[pe], sa, __ATOMIC_RELAXED, __HIP_MEMORY_SCOPE_WORKGROUP); __hip_atomic_fetch_add(&lpre[pe], sp, __ATOMIC_RELAXED, __HIP_MEMORY_SCOPE_WORKGROUP); }
        __syncthreads();
        if (F.tid < 2) { int base = 0; for (int e = 0; e < 8; ++e) { ltb[F.tid * 8 + e] = base; base += (ltot[F.tid * 8 + e] + 255) >> 8; } }
        __syncthreads();
        unsigned e01[2] = {0u, 0u}; float w01[2] = {0.f, 0.f}; int rk[2] = {0, 0};
        if (F.tid < 256) {
            const u32x4 rec = *(const u32x4*)(KWS + WS_REC + (size_t)(tb * 256 + F.tid) * 16);
            e01[0] = rec.x; e01[1] = rec.y; w01[0] = __uint_as_float(rec.z); w01[1] = __uint_as_float(rec.w);
#pragma unroll
            for (int p = 0; p < 2; ++p)
#pragma unroll
                for (int ee = 0; ee < 8; ++ee) { const unsigned long long mk = __ballot(e01[p] == (unsigned)ee);
                    if (e01[p] == (unsigned)ee) rk[p] = __builtin_popcountll(mk & ((1ull << F.lane) - 1ull));
                    if (F.lane == 0) lwc[(p * 4 + F.wave) * 8 + ee] = __builtin_popcountll(mk); }
        }
        __syncthreads();
        if (F.tid < 256) {
#pragma unroll
            for (int p = 0; p < 2; ++p) { const int e = (int)e01[p]; int off = 0;
                for (int w = 0; w < F.wave; ++w) off += lwc[(p * 4 + w) * 8 + e];
                const int pos = ltb[p * 8 + e] * 256 + lpre[p * 8 + e] + off + rk[p];
                list[p * LISTN + pos] = tb * 256 + F.tid; wgt[p * LISTN + pos] = w01[p]; }
        }
        if (tb < 16) { const int p = tb >> 3, e = tb & 7; const int lo = ltb[tb] * 256 + ltot[tb], hi = (ltb[tb] + ((ltot[tb] + 255) >> 8)) * 256;
            for (int i = lo + F.tid; i < hi; i += NTHREADS) { list[p * LISTN + i] = (int)0x80000000u; wgt[p * LISTN + i] = 0.f; } (void)e; }
        if (tb == 0 && F.tid < 16) ((int*)(KWS + WS_TOT))[F.tid] = ltot[F.tid];
        __syncthreads();
    }
}
__device__ __forceinline__ void build_group_table(Frame& F, int p, int nN) {
    LAS int* tab = (LAS int*)(F.lds + LC_GT);
    __syncthreads();
    if (F.tid == 0) { const int* tot = (const int*)(KWS + WS_TOT) + p * 8; int ng = 0, ustart = 0, tile = 0;
        for (int e = 0; e < 8; ++e) { int tl = (tot[e] + 255) >> 8;
            while (tl > 0) { const int gsz = tl < 8 ? tl : 8; tab[64 + ng] = ustart; tab[128 + ng] = tile; tab[192 + ng] = gsz; tab[256 + ng] = e; ustart += gsz * nN; tile += gsz; tl -= gsz; ++ng; } }
        tab[0] = ng; tab[1] = ustart; }
    __syncthreads();
}

__device__ __forceinline__ void mixer_unit(Frame& F, const int l, const int unit) {
    const bf16* P = KPROJ; bf16* MO = KMIXED;
    const int t0 = unit * 128, s0 = t0 & (SEQ - 1), rb = t0 - s0;
    const int lane = F.lane, wave = F.wave, tid = F.tid;
    {
        typedef float f32x2 __attribute__((ext_vector_type(2)));
        constexpr int GS = 392;
        LAS bf16* gbuf = (LAS bf16*)F.lds;
        const __amdgpu_buffer_rsrc_t rsw = __builtin_amdgcn_make_buffer_rsrc((void*)(KIN(9) + (size_t)l * CKW * CONVW), (short)0, CKW * CONVW * 4, 0x00020000);
        const __amdgpu_buffer_rsrc_t rsb = __builtin_amdgcn_make_buffer_rsrc((void*)(KIN(10) + (size_t)l * CONVW), (short)0, CONVW * 4, 0x00020000);
        float g6[6], b6[6];
#pragma unroll
        for (int k = 0; k < 3; ++k)
#pragma unroll
            for (int e = 0; e < 2; ++e) { g6[2 * k + e] = KIN(11)[l * CONVW + 128 * k + 2 * lane + e]; b6[2 * k + e] = KIN(12)[l * CONVW + 128 * k + 2 * lane + e]; }
        for (int hf = 0; hf < 2; ++hf) {
            const int sbase = s0 + 64 * hf - 15;
            for (int j0 = 0; j0 < 9; j0 += 3) {
                u32x4 va[3], vg[3];
#pragma unroll
                for (int jj = 0; jj < 3; ++jj) { const int i = tid + (j0 + jj) * NTHREADS, rr = i / 48, cp = i - rr * 48, sq = sbase + rr;
                    va[jj] = (u32x4){0u, 0u, 0u, 0u}; vg[jj] = va[jj];
                    if (i < 94 * 48 && sq >= 0 && sq < SEQ) { const bf16* pr = P + (size_t)(rb + sq) * D_IN + 256 + 8 * cp; va[jj] = *(const u32x4*)pr; vg[jj] = *(const u32x4*)(pr + CONVW); } }
#pragma unroll
                for (int jj = 0; jj < 3; ++jj) { const int i = tid + (j0 + jj) * NTHREADS, rr = i / 48, cp = i - rr * 48;
                    if (i < 94 * 48) { u32x4 o;
#pragma unroll
                        for (int d = 0; d < 4; ++d) o[d] = pk2(bflo(va[jj][d]) * fast_sigmoid(bflo(vg[jj][d])), bfhi(va[jj][d]) * fast_sigmoid(bfhi(vg[jj][d])));
                        *(LAS u32x4*)(gbuf + rr * GS + 8 * cp) = o; } }
            }
            __syncthreads();
            f32x2 o[3][8];
#pragma unroll
            for (int pg = 0; pg < 3; ++pg) {
                asm volatile("" ::: "memory");
                f32x2 w[31];
#pragma unroll
                for (int j = 0; j < 31; ++j) w[j] = __builtin_bit_cast(f32x2, __builtin_amdgcn_raw_buffer_load_b64(rsw, (unsigned)lane * 8u, (j * CONVW + 128 * pg) * 4, 0));
                const f32x2 bias = __builtin_bit_cast(f32x2, __builtin_amdgcn_raw_buffer_load_b64(rsb, (unsigned)lane * 8u, 128 * pg * 4, 0));
#pragma unroll
                for (int i = 0; i < 8; ++i) o[pg][i] = bias;
                const LAS unsigned* gp = (const LAS unsigned*)gbuf + (8 * wave) * (GS / 2) + 64 * pg + lane;
#pragma unroll
                for (int r = 0; r < 38; ++r) { const unsigned u = gp[r * (GS / 2)]; const f32x2 gl = {bflo(u), bfhi(u)};
#pragma unroll
                    for (int i = 0; i < 8; ++i) if (r - i >= 0 && r - i < 31) o[pg][i] = w[r - i] * gl + o[pg][i]; }
            }
#pragma unroll
            for (int i = 0; i < 8; ++i) { float sm = 0.f, q = 0.f;
#pragma unroll
                for (int pg = 0; pg < 3; ++pg) { sm += o[pg][i][0] + o[pg][i][1]; q += o[pg][i][0] * o[pg][i][0] + o[pg][i][1] * o[pg][i][1]; }
                sm = wave_sum(sm); q = wave_sum(q);
                const float mean = sm * (1.0f / CONVW), var = fmaxf(q * (1.0f / CONVW) - mean * mean, 0.f), rstd = 1.0f / sqrtf(var + EPS);
                unsigned* orow = (unsigned*)(MO + (size_t)(t0 + 64 * hf + 8 * wave + i) * D + 256);
#pragma unroll
                for (int pg = 0; pg < 3; ++pg) { const float o0 = silu_f((o[pg][i][0] - mean) * rstd * g6[2 * pg] + b6[2 * pg]), o1 = silu_f((o[pg][i][1] - mean) * rstd * g6[2 * pg + 1] + b6[2 * pg + 1]);
                    orow[64 * pg + lane] = pk2(o0, o1); } }
            __syncthreads();
        }
    }
    {
        constexpr int VS = 136;
        LAS bf16* vnT = (LAS bf16*)F.lds;
        float g6[6], b6[6];
#pragma unroll
        for (int k = 0; k < 3; ++k)
#pragma unroll
            for (int e = 0; e < 2; ++e) { g6[2 * k + e] = KIN(13)[l * CONVW + 128 * k + 2 * lane + e]; b6[2 * k + e] = KIN(14)[l * CONVW + 128 * k + 2 * lane + e]; }
        for (int rh = 0; rh < 2; ++rh) {
            unsigned raw[8][3];
#pragma unroll
            for (int r = 0; r < 8; ++r) { const unsigned* pv = (const unsigned*)(P + (size_t)(t0 + wave * 16 + rh * 8 + r) * D_IN + 1408);
#pragma unroll
                for (int k = 0; k < 3; ++k) raw[r][k] = pv[64 * k + lane]; }
#pragma unroll
            for (int r = 0; r < 8; ++r) { const int tk = wave * 16 + rh * 8 + r;
                float v[6]; float s = 0.f, q = 0.f;
#pragma unroll
                for (int k = 0; k < 3; ++k) { v[2 * k] = bflo(raw[r][k]); v[2 * k + 1] = bfhi(raw[r][k]); }
#pragma unroll
                for (int k = 0; k < 6; ++k) { s += v[k]; q += v[k] * v[k]; }
                s = wave_sum(s); q = wave_sum(q);
                const float mean = s * (1.0f / CONVW), var = fmaxf(q * (1.0f / CONVW) - mean * mean, 0.f), rstd = 1.0f / sqrtf(var + EPS);
#pragma unroll
                for (int k = 0; k < 3; ++k)
#pragma unroll
                    for (int e = 0; e < 2; ++e) vnT[(128 * k + 2 * lane + e) * VS + tk] = (bf16)f2bf((v[2 * k + e] - mean) * rstd * g6[2 * k + e] + b6[2 * k + e]);
            }
        }
        __syncthreads();
        const bf16* sw = (const bf16*)(KWS + WS_SGUW);
        const float* sb = KIN(16) + (size_t)l * NH * 128;
        for (int tile = wave; tile < 24; tile += 8) { const int hh = tile >> 2, pb = tile & 3;
            f32x16 acc0, acc1;
#pragma unroll
            for (int i = 0; i < 16; ++i) { acc0[i] = 0.f; acc1[i] = 0.f; }
            const bf16* Wh = sw + ((size_t)((l * NH + hh) * 128 + pb * 32 + (lane & 31))) * 128 + 8 * (lane >> 5);
            const LAS bf16* Vb = vnT + (hh * 64 + (lane & 31)) * VS + 8 * (lane >> 5);
            bf16x8 wf[8];
#pragma unroll
            for (int ks = 0; ks < 8; ++ks) wf[ks] = *(const bf16x8*)(Wh + ks * 16);
            const int p = pb * 32 + (lane & 31); const size_t row = (size_t)(t0 + p); const float bias = sb[hh * 128 + p];
            const bf16* up = P + row * D_IN + 1024 + hh * 64 + 4 * (lane >> 5);
            u32x2 uu[2][4];
#pragma unroll
            for (int dh = 0; dh < 2; ++dh)
#pragma unroll
                for (int a = 0; a < 4; ++a) uu[dh][a] = *(const u32x2*)(up + dh * 32 + 8 * a);
#pragma unroll
            for (int ks = 0; ks < 8; ++ks) { const bf16x8 v0 = *(const LAS bf16x8*)(Vb + ks * 16), v1 = *(const LAS bf16x8*)(Vb + 32 * VS + ks * 16);
                acc0 = __builtin_amdgcn_mfma_f32_32x32x16_bf16(v0, wf[ks], acc0, 0, 0, 0); acc1 = __builtin_amdgcn_mfma_f32_32x32x16_bf16(v1, wf[ks], acc1, 0, 0, 0); }
            bf16* op = MO + row * D + 640 + hh * 64 + 4 * (lane >> 5);
#pragma unroll
            for (int a = 0; a < 4; ++a) {
                { const unsigned u0 = uu[0][a].x, u1 = uu[0][a].y; u32x2 o; o.x = pk2(bflo(u0) * (acc0[4 * a + 0] + bias), bfhi(u0) * (acc0[4 * a + 1] + bias)); o.y = pk2(bflo(u1) * (acc0[4 * a + 2] + bias), bfhi(u1) * (acc0[4 * a + 3] + bias)); *(u32x2*)(op + 8 * a) = o; }
                { const unsigned u0 = uu[1][a].x, u1 = uu[1][a].y; u32x2 o; o.x = pk2(bflo(u0) * (acc1[4 * a + 0] + bias), bfhi(u0) * (acc1[4 * a + 1] + bias)); o.y = pk2(bflo(u1) * (acc1[4 * a + 2] + bias), bfhi(u1) * (acc1[4 * a + 3] + bias)); *(u32x2*)(op + 32 + 8 * a) = o; }
            }
        }
        __syncthreads();
    }
    {
        constexpr int AS = 264;
        constexpr int DS = 136;
        LAS bf16* abuf = (LAS bf16*)F.lds;
        LAS bf16* dbuf = (LAS bf16*)(F.lds + 144 * AS * 2);
        { u32x4 st[9];
#pragma unroll
          for (int j = 0; j < 9; ++j) { const int i = tid + j * NTHREADS, rr = i >> 5, cp = i & 31; const int sq = s0 - 8 + rr; st[j] = (u32x4){0u, 0u, 0u, 0u};
              if (sq >= 0 && sq < SEQ) st[j] = *(const u32x4*)(P + (size_t)(rb + sq) * D_IN + 8 * cp); }
#pragma unroll
          for (int j = 0; j < 9; ++j) { const int i = tid + j * NTHREADS, rr = i >> 5, cp = i & 31; *(LAS u32x4*)(abuf + rr * AS + 8 * cp) = st[j]; } }
        __syncthreads();
        const bf16* pwt = (const bf16*)(KWS + WS_POOLW) + (size_t)l * 4 * 64 * 64;
        for (int gp = 0; gp < 2; ++gp) {
            { const int cc = tid & 127, run = tid >> 7, g = 2 * gp + (cc >> 6), half = 1 << g, ch = g * 64 + (cc & 63);
              const int tk0 = run * 32; float sum = 0.f;
              for (int j = -half; j < half; ++j) sum += bf2f(abuf[(tk0 + j + 8) * AS + ch]);
              for (int k = 0; k < 32; ++k) { const int tk = tk0 + k, sq = s0 + tk; int lo = sq - half; lo = lo < 0 ? 0 : lo; int hi = sq + half; hi = hi > SEQ ? SEQ : hi;
                  const float a = bf2f(abuf[(tk + 8) * AS + ch]);
                  dbuf[tk * DS + cc] = (bf16)f2bf(sum / (float)(hi - lo) - a);
                  sum += bf2f(abuf[(tk + half + 8) * AS + ch]) - bf2f(abuf[(tk - half + 8) * AS + ch]); } }
            __syncthreads();
            { const int fr = lane & 15, fq = lane >> 4;
#pragma unroll
              for (int gg = 0; gg < 2; ++gg) { const int g = 2 * gp + gg;
                  bf16x8 af[2];
#pragma unroll
                  for (int ks = 0; ks < 2; ++ks) af[ks] = *(const LAS bf16x8*)(dbuf + (wave * 16 + fr) * DS + gg * 64 + ks * 32 + 8 * fq);
                  bf16* op = MO + (size_t)(t0 + wave * 16 + fr) * D + g * 64 + 4 * fq;
#pragma unroll
                  for (int nt = 0; nt < 4; ++nt) { f32x4 acc = {0.f, 0.f, 0.f, 0.f};
#pragma unroll
                      for (int ks = 0; ks < 2; ++ks) { const bf16x8 wfr = *(const bf16x8*)(pwt + ((size_t)(g * 64 + nt * 16 + fr)) * 64 + ks * 32 + 8 * fq);
                          acc = __builtin_amdgcn_mfma_f32_16x16x32_bf16(wfr, af[ks], acc, 0, 0, 0); }
                      u32x2 o; o.x = pk2(acc[0], acc[1]); o.y = pk2(acc[2], acc[3]); *(u32x2*)(op + nt * 16) = o; } } }
            __syncthreads();
        }
    }
}

__global__ void __launch_bounds__(NTHREADS, 2) fwd_kernel(Args args) {
    extern __shared__ __attribute__((aligned(16))) unsigned char lds_raw[];
    Frame F;
    F.lds = (LAS unsigned char*)lds_raw;
    F.tid = threadIdx.x; F.lane = F.tid & 63; F.wave = __builtin_amdgcn_readfirstlane(F.tid >> 6); F.G = gridDim.x; F.bid = blockIdx.x;
    F.ka = (kargp_t)__builtin_amdgcn_kernarg_segment_ptr(); (void)args;
    for (int u = F.tid; u < (LDS_BYTES - LC_OFF) / 4; u += NTHREADS) ((LAS unsigned*)(F.lds + LC_OFF))[u] = 0u;
    __syncthreads();
    XcdBarrier bar = xcd_barrier_post((unsigned*)(KWS + WS_CTL) + CW_BAR, (volatile LAS unsigned*)(F.lds + LC_MISC) + 8);
#define GRID_BAR() xcd_barrier(bar)
#ifndef PROBE_DUP
#define PROBE_DUP 0
#endif
#define PROBE_REP(bit) for (int rep_ = 0; rep_ < ((PROBE_DUP & (bit)) ? 2 : 1); ++rep_)
#define MODL(l) (KMOD + (size_t)(l) * BATCH * NMOD)

    PROBE_REP(2) { PHASE_ENTER(F); p0_prologue(F); GRID_BAR(); }

#define LAYER_MIX(l) \
    PROBE_REP(2) { PHASE_ENTER(F); if ((l) == 0) norm_phase<0, false>(F, KIN(0), KIN(4) + (l) * D, MODL(l) + 0 * D, MODL(l) + 1 * D, KH, nullptr); \
        else norm_phase<0, true>(F, KXB, KIN(4) + (l) * D, MODL(l) + 0 * D, MODL(l) + 1 * D, KH, nullptr); GRID_BAR(); } \
    PROBE_REP(8) { PHASE_ENTER(F); pg8::DenseOrder S; S.init(KH, (const bf16*)(KWS + WS_WIN) + (size_t)(l) * D_IN * D, M, D_IN, D, F.G, F.bid); \
        pg8::EpiBf16 E{KPROJ, D_IN, (PROBE_DUP & 256) ? rep_ : 0}; pg8::gemm_phase<pg8::EpiBf16, pg8::DenseOrder, false>(F.lds, D, S, E, nullptr, ((PROBE_DUP & 512) && rep_) ? 2 : 1); GRID_BAR(); } \
    PROBE_REP(1) { PHASE_ENTER(F); for (int u = F.bid; u < M / 128; u += F.G) mixer_unit(F, (l), u); GRID_BAR(); } \
    for (int rep_ = 0; rep_ < (((PROBE_DUP & 32) && (l) == 0) ? 2 : 1); ++rep_) { PHASE_ENTER(F); \
        pg8::DenseOrder S; S.init(KMIXED, (const bf16*)(KWS + WS_WOUT) + (size_t)(l) * D * D, M, D, D, F.G, F.bid); \
        if ((l) == 0) { pg8::EpiResidual<true> E{KIN(0), KXB, MODL(l) + 2 * D, 1.0f}; pg8::gemm_phase<pg8::EpiResidual<true>, pg8::DenseOrder, false>(F.lds, D, S, E); } \
        else { pg8::EpiResidual<false> E{KXB, KXB, MODL(l) + 2 * D, 1.0f}; pg8::gemm_phase<pg8::EpiResidual<false>, pg8::DenseOrder, false>(F.lds, D, S, E); } GRID_BAR(); }
#define MOE_PASS(p) \
    PROBE_REP(4) { PHASE_ENTER(F); build_group_table(F, (p), 2 * FFE / 256); \
        pg8::MoeOrder S; S.tab = (const LAS int*)(F.lds + LC_GT); S.A = KH; S.Bt = (const bf16*)(KWS + WS_MWGU); S.bstride = (size_t)2 * FFE * D; S.list = (const int*)(KWS + WS_LIST) + (p) * LISTN; \
        S.K = D / 2; S.nN = 2 * FFE / 256; S.G = F.G; S.c = F.bid; S.gather = true; \
        pg8::EpiSwigluF8 E{(unsigned char*)KACT, FFE}; pg8::gemm_phase<pg8::EpiSwigluF8, pg8::MoeOrder, true, true>(F.lds, D / 2, S, E, (LAS u32x4*)(F.lds + LC_GOFF)); GRID_BAR(); } \
    { PHASE_ENTER(F); build_group_table(F, (p), D / 256); \
        pg8::MoeOrder S; S.tab = (const LAS int*)(F.lds + LC_GT); S.A = KACT; S.Bt = (const bf16*)(KWS + WS_MWD); S.bstride = (size_t)D * FFE; S.list = nullptr; \
        S.K = FFE / 2; S.nN = D / 256; S.G = F.G; S.c = F.bid; S.gather = false; \
        pg8::EpiMoeDown E{KXB, (const int*)(KWS + WS_LIST) + (p) * LISTN, (const float*)(KWS + WS_WGT) + (p) * LISTN, MODL(1) + 5 * D, 1.0f / (SC_A * SC_W), (bf16*)(KWS + WS_DUMP)}; \
        pg8::gemm_phase<pg8::EpiMoeDown, pg8::MoeOrder, false, true>(F.lds, FFE / 2, S, E); GRID_BAR(); \
        if (PROBE_DUP & 128) { pg8::EpiMoeDown E0 = E; E0.ascale = 0.f; pg8::gemm_phase<pg8::EpiMoeDown, pg8::MoeOrder, false, true>(F.lds, FFE / 2, S, E0); GRID_BAR(); } }

    LAYER_MIX(0)
    PROBE_REP(2) { PHASE_ENTER(F); norm_phase<0, true>(F, KXB, KIN(5), MODL(0) + 3 * D, MODL(0) + 4 * D, KH, nullptr); GRID_BAR(); }
    PROBE_REP(16) { PHASE_ENTER(F); pg8::DenseOrder S; S.init(KH, (const bf16*)(KWS + WS_WGU), M, 2 * FF, D, F.G, F.bid);
        pg8::EpiSwiglu E{KACT, FF}; pg8::gemm_phase<pg8::EpiSwiglu, pg8::DenseOrder, false>(F.lds, D, S, E); GRID_BAR(); }
    { PHASE_ENTER(F); pg8::DenseOrder S; S.init(KACT, (const bf16*)(KWS + WS_WD), M, D, FF, F.G, F.bid);
        pg8::EpiResidual<false> E{KXB, KXB, MODL(0) + 5 * D, 1.0f}; pg8::gemm_phase<pg8::EpiResidual<false>, pg8::DenseOrder, false>(F.lds, FF, S, E); GRID_BAR(); }
    if (PROBE_DUP & 64) { PHASE_ENTER(F); pg8::DenseOrder S; S.init(KACT, (const bf16*)(KWS + WS_WD), M, D, FF, F.G, F.bid);
        pg8::EpiResidual<false> E{KXB, KXB, MODL(0) + 5 * D, 0.0f}; pg8::gemm_phase<pg8::EpiResidual<false>, pg8::DenseOrder, false>(F.lds, FF, S, E); GRID_BAR(); }
    LAYER_MIX(1)
    PROBE_REP(2) { PHASE_ENTER(F); norm_phase<1, true>(F, KXB, KIN(5) + D, MODL(1) + 3 * D, MODL(1) + 4 * D, KH, nullptr); GRID_BAR();
        PHASE_ENTER(F); route_phase(F); GRID_BAR(); }
    MOE_PASS(0)
    MOE_PASS(1)
    { PHASE_ENTER(F); norm_phase<2, true>(F, KXB, KIN(26), nullptr, nullptr, nullptr, KOUT); }
}

extern "C" void kernel_launch(void* const* d_in, const int* in_sizes, int n_in, void* d_out, int out_size, void* d_ws, size_t ws_size, hipStream_t stream) {
    static int grid = 0;
    if (grid == 0) {
        if (n_in != 27 || in_sizes[0] != M * D || out_size != M * D || ws_size < WS_END) { fprintf(stderr, "kernel_launch: unexpected shapes (n_in %d, in0 %d, out %d, ws %zu < %zu); nothing launched\n", n_in, n_in > 0 ? in_sizes[0] : -1, out_size, ws_size, (size_t)WS_END); grid = -1; return; }
        int dev = 0, cus = 0, per_cu = 0;
        if (hipGetDevice(&dev) != hipSuccess || hipDeviceGetAttribute(&cus, hipDeviceAttributeMultiprocessorCount, dev) != hipSuccess) { grid = -1; return; }
        if (hipFuncSetAttribute((const void*)fwd_kernel, hipFuncAttributeMaxDynamicSharedMemorySize, LDS_BYTES) != hipSuccess) { fprintf(stderr, "kernel_launch: hipFuncSetAttribute failed\n"); grid = -1; return; }
        if (hipOccupancyMaxActiveBlocksPerMultiprocessor(&per_cu, (const void*)fwd_kernel, NTHREADS, LDS_BYTES) != hipSuccess || per_cu < 1) { fprintf(stderr, "kernel_launch: occupancy query says %d blocks per CU\n", per_cu); }
        (void)hipGetLastError();
        grid = cus;
    }
    if (grid < 0) return;
    if (hipMemsetAsync((char*)d_ws + WS_CTL, 0, CTL_ZERO_BYTES, stream) != hipSuccess) return;
    Args a{};
    for (int i = 0; i < 27; ++i) a.in[i] = (const float*)d_in[i];
    a.out = (float*)d_out; a.ws = (unsigned char*)d_ws;
    hipLaunchKernelGGL(fwd_kernel, dim3(grid), dim3(NTHREADS), LDS_BYTES, stream, a);
}
```

```cpp
#include <hip/hip_runtime.h>
#include <cstdio>
#include <cstdint>

#define GAS __attribute__((address_space(1)))
#define LAS __attribute__((address_space(3)))
typedef unsigned short bf16;
typedef short bf16x8 __attribute__((ext_vector_type(8)));
typedef float f32x4 __attribute__((ext_vector_type(4)));
typedef float f32x16 __attribute__((ext_vector_type(16)));
typedef unsigned u32x4 __attribute__((ext_vector_type(4)));
typedef unsigned u32x2 __attribute__((ext_vector_type(2)));
typedef int i32x4 __attribute__((ext_vector_type(4)));
typedef int i32x8 __attribute__((ext_vector_type(8)));
constexpr float SC_W = 256.0f, SC_H = 16.0f, SC_A = 4.0f;

constexpr int NWAVES = 8, NTHREADS = 512;
constexpr int BATCH = 8, SEQ = 8192, D = 1024, M = BATCH * SEQ;
constexpr int D_IN = 1792, FF = 2816, FFE = 3584, NE = 8, NMOD = 6 * D;
constexpr int CONVW = 384, CKW = 31, NH = 6;
constexpr float EPS = 1e-6f;
constexpr int LISTN = M + NE * 256;

constexpr size_t MiB = 1u << 20;
constexpr size_t WS_CTL = 0, CTL_ZERO_BYTES = 1 * MiB;
constexpr size_t WS_MOD = 1 * MiB;
constexpr size_t WS_HIST = 2 * MiB;
constexpr size_t WS_TOT = 2 * MiB + 65536;
constexpr size_t WS_DUMP = 2 * MiB + 131072;
constexpr size_t WS_REC = 3 * MiB;
constexpr size_t WS_LIST = 4 * MiB;
constexpr size_t WS_WGT = 5 * MiB;
constexpr size_t WS_SGUW = 6 * MiB;
constexpr size_t WS_POOLW = 6 * MiB + 524288;
constexpr size_t WS_WIN = 8 * MiB;
constexpr size_t WS_WOUT = 15 * MiB;
constexpr size_t WS_WGU = 19 * MiB;
constexpr size_t WS_WD = 30 * MiB;
constexpr size_t WS_MWGU = 36 * MiB;
constexpr size_t WS_MWD = 148 * MiB;
constexpr size_t WS_H = 204 * MiB;
constexpr size_t WS_BIG = 332 * MiB;
constexpr size_t WS_MIXED = WS_BIG + (size_t)M * D_IN * 2;
constexpr size_t WS_ACT_END = WS_BIG + (size_t)LISTN * FFE * 2;
constexpr size_t WS_XB = (WS_ACT_END + 255) / 256 * 256;
constexpr size_t WS_END = WS_XB + (size_t)M * D * 2;
static_assert(WS_MIXED + (size_t)M * D * 2 <= WS_ACT_END && (size_t)M * FF * 2 <= (size_t)LISTN * FFE * 2, "ws map");
constexpr int CW_BAR = 4096;

constexpr int RING_BYTES = 131072;
constexpr int LC_OFF = RING_BYTES;
constexpr int LC_MISC = LC_OFF;
constexpr int LC_HIST = LC_OFF + 64;
constexpr int LC_TOT = LC_OFF + 128;
constexpr int LC_PRE = LC_OFF + 192;
constexpr int LC_TBASE = LC_OFF + 256;
constexpr int LC_WCNT = LC_OFF + 320;
constexpr int LC_GT = LC_OFF + 1024;
constexpr int LC_GOFF = LC_OFF + 4096;
constexpr int LDS_BYTES = RING_BYTES + 4096 + 8192;

__device__ __forceinline__ unsigned f2bf(float f) { unsigned u = __builtin_bit_cast(unsigned, f); return (u + 0x7fffu + ((u >> 16) & 1u)) >> 16; }
__device__ __forceinline__ unsigned pk2(float lo, float hi) { return f2bf(lo) | (f2bf(hi) << 16); }
__device__ __forceinline__ float bf2f(unsigned b) { return __builtin_bit_cast(float, b << 16); }
__device__ __forceinline__ float bflo(unsigned u) { return __builtin_bit_cast(float, u << 16); }
__device__ __forceinline__ float bfhi(unsigned u) { return __builtin_bit_cast(float, u & 0xffff0000u); }
__device__ __forceinline__ float fast_sigmoid(float x) { return __builtin_amdgcn_rcpf(1.0f + __builtin_amdgcn_exp2f(-1.44269504089f * x)); }
__device__ __forceinline__ float silu_f(float x) { return x * fast_sigmoid(x); }
#define WS_SWZ(v, o) ((v) + __int_as_float(__builtin_amdgcn_ds_swizzle(__float_as_int(v), 0x1f | ((o) << 10))))
__device__ __forceinline__ float wave_sum(float v) {
    v = WS_SWZ(v, 1); v = WS_SWZ(v, 2); v = WS_SWZ(v, 4); v = WS_SWZ(v, 8); v = WS_SWZ(v, 16);
    return __int_as_float(__builtin_amdgcn_readlane(__float_as_int(v), 0)) + __int_as_float(__builtin_amdgcn_readlane(__float_as_int(v), 32));
}
__device__ __forceinline__ unsigned pk4_fp8(float a, float b, float c, float d) {
    a = __builtin_fminf(__builtin_fmaxf(a, -448.f), 448.f); b = __builtin_fminf(__builtin_fmaxf(b, -448.f), 448.f); c = __builtin_fminf(__builtin_fmaxf(c, -448.f), 448.f); d = __builtin_fminf(__builtin_fmaxf(d, -448.f), 448.f);
    unsigned w = 0; w = __builtin_amdgcn_cvt_pk_fp8_f32(a, b, w, false); w = __builtin_amdgcn_cvt_pk_fp8_f32(c, d, w, true); return w; }
#define LDS_WAIT() asm volatile("s_waitcnt lgkmcnt(0)" ::: "memory")

#define XB_TMO      128
#define XB_XCNT(j)  (256  + 64 * (j))
#define XB_XSUB(j)  (1280 + 64 * (j))
#define XB_XGEN(j)  (2304 + 64 * (j))
#define XB_TOP      3328
#define XB_TOPGEN   3392
#define XCD_BAR_WORDS 3456
#define XB_SPIN_CAP (1u << 18)
__device__ __forceinline__ unsigned xb_ld(unsigned* p)              { return __hip_atomic_load(p, __ATOMIC_RELAXED, __HIP_MEMORY_SCOPE_AGENT); }
__device__ __forceinline__ unsigned xb_add(unsigned* p, unsigned v) { return __hip_atomic_fetch_add(p, v, __ATOMIC_RELAXED, __HIP_MEMORY_SCOPE_AGENT); }
__device__ __forceinline__ unsigned xb_xcc_id() { return (unsigned)__builtin_amdgcn_s_getreg((3 << 11) | 20) & 0xFu; }
#define XB_SPIN(cond, bar) do { unsigned _sp = 0; while (cond) { __builtin_amdgcn_s_sleep(1); \
    if ((++_sp & 255u) == 0u) { if (xb_ld(&(bar)[XB_TMO])) break; if (_sp > XB_SPIN_CAP) { atomicAdd(&(bar)[XB_TMO], 1u); break; } } } } while (0)
struct XcdBarrier { unsigned* bar; unsigned x; volatile LAS unsigned* st; };
__device__ __forceinline__ XcdBarrier xcd_barrier_post(unsigned* bar, volatile LAS unsigned* st) {
    XcdBarrier b; b.bar = bar; b.x = xb_xcc_id(); b.st = st;
    if (threadIdx.x == 0) (void)xb_add(&bar[XB_XCNT(b.x)], 1u);
    return b;
}
__device__ __forceinline__ void xcd_barrier_complete(unsigned* bar, unsigned x, unsigned& nloc, unsigned& nx) {
    const unsigned G = gridDim.x * gridDim.y * gridDim.z;
    unsigned sum, cnt, mine, sp = 0u;
    for (;;) {
        sum = 0u; cnt = 0u; mine = 0u;
#pragma unroll
        for (unsigned j = 0; j < 16; ++j) { const unsigned c = xb_ld(&bar[XB_XCNT(j)]); sum += c; cnt += (c > 0u) ? 1u : 0u; mine = (j == x) ? c : mine; }
        if (sum == G) break;
        __builtin_amdgcn_s_sleep(1);
        if ((++sp & 255u) == 0u) { if (xb_ld(&bar[XB_TMO])) break; if (sp > XB_SPIN_CAP) { atomicAdd(&bar[XB_TMO], 1u); break; } }
    }
    nloc = mine > 0u ? mine : 1u; nx = cnt > 0u ? cnt : 1u;
}
__device__ __forceinline__ void xcd_barrier(const XcdBarrier& b) {
    asm volatile("s_waitcnt vmcnt(0)" ::: "memory");
    __syncthreads();
    if (threadIdx.x == 0) {
        unsigned* bar = b.bar;
        __builtin_amdgcn_s_waitcnt(0);
        unsigned nloc = b.st[0], nx = b.st[1];
        if (nloc == 0u) { xcd_barrier_complete(bar, b.x, nloc, nx); b.st[0] = nloc; b.st[1] = nx; }
        const unsigned old = xb_add(&bar[XB_XSUB(b.x)], 1u);
        const unsigned gen = old / nloc;
        if (old + 1u == (gen + 1u) * nloc) {
            __builtin_amdgcn_fence(__ATOMIC_RELEASE, "agent");
            asm volatile("s_waitcnt vmcnt(0)" ::: "memory");
            const unsigned og = xb_add(&bar[XB_TOP], 1u);
            const unsigned tg = og / nx;
            if (og + 1u == (tg + 1u) * nx) xb_add(&bar[XB_TOPGEN], 1u);
            else XB_SPIN(xb_ld(&bar[XB_TOPGEN]) == tg, bar);
            __builtin_amdgcn_fence(__ATOMIC_ACQUIRE, "agent");
            xb_add(&bar[XB_XGEN(b.x)], 1u);
            asm volatile("s_waitcnt vmcnt(0)" ::: "memory");
        } else {
            XB_SPIN(xb_ld(&bar[XB_XGEN(b.x)]) == gen, bar);
            __builtin_amdgcn_fence(__ATOMIC_ACQUIRE, "agent");
            asm volatile("s_waitcnt vmcnt(0)" ::: "memory");
        }
    }
    __syncthreads();
}

namespace pg8 {
constexpr int BM = 256, BK = 64, HALF = 128, HTB = HALF * BK * 2, STAGE_BYTES = 8 * HTB, NXCD = 8, WGM = 8;
__device__ __forceinline__ int lds_byte(int r, int c) { const int st = (r >> 4) * 2 + (c >> 5), rr = r & 15, cc = c & 31, ob = rr * 64 + cc * 2; return st * 1024 + (ob ^ (((ob >> 9) & 1) << 5)); }
__device__ __forceinline__ void stage_rc(int b, int& R, int& C) { const int st = b / 1024, sb = b % 1024, swz = sb ^ (((sb >> 9) & 1) << 5); R = (st >> 1) * 16 + swz / 64; C = (st & 1) * 32 + (swz % 64) / 2; }
__device__ __forceinline__ int perm32(int rho) { const int n = rho >> 4, i = rho & 15; return 8 * (i >> 2) + 4 * n + (i & 3); }
__device__ __forceinline__ unsigned cvt_pk_bf16(float lo, float hi) { unsigned r; asm volatile("v_cvt_pk_bf16_f32 %0, %1, %2" : "=v"(r) : "v"(lo), "v"(hi)); return r; }

struct Unit { int pm, pn, ex; };

__device__ __forceinline__ int xcd_remap(int wgid, int nwg) { const int q = nwg / NXCD, r = nwg % NXCD, xcd = wgid % NXCD, off = wgid / NXCD; return (xcd < r ? xcd * (q + 1) : r * (q + 1) + (xcd - r) * q) + off; }

struct DenseOrder {
    const bf16* A; const bf16* Bt; int K, nM, nN, nwg, G, c;
    __device__ __forceinline__ void init(const bf16* A_, const bf16* Bt_, int Mr, int N, int K_, int G_, int c_) { A = A_; Bt = Bt_; K = K_; nM = Mr / BM; nN = N / BM; nwg = nM * nN; G = G_; c = c_; }
    __device__ __forceinline__ bool next(int i, Unit& u) const {
        const long L = (long)i * G + c; if (L >= nwg) return false;
        const int wgid = xcd_remap((int)L, nwg);
        const int nig = WGM * nN, gid = wgid / nig, fm = gid * WGM, gsz = (nM - fm) < WGM ? (nM - fm) : WGM;
        u.pm = fm + ((wgid % nig) % gsz); u.pn = (wgid % nig) / gsz; u.ex = 0; return true;
    }
    __device__ __forceinline__ const char* a_ptr(const Unit& u) const { return (const char*)A + (size_t)u.pm * ((size_t)BM * K * 2); }
    __device__ __forceinline__ const char* b_ptr(const Unit& u) const { return (const char*)Bt + (size_t)u.pn * ((size_t)BM * K * 2); }
    __device__ __forceinline__ void rows_raw(const Unit&, int, unsigned (&)[2][2]) const {}
};
struct MoeOrder {
    const LAS int* tab; const bf16* A; const bf16* Bt; size_t bstride; const int* list; int K, nN, G, c; bool gather;
    __device__ __forceinline__ bool next(int i, Unit& u) const {
        const int U = __builtin_amdgcn_readfirstlane(tab[1]), ng = __builtin_amdgcn_readfirstlane(tab[0]);
        const long L = (long)i * G + c; if (L >= U) return false;
        const int wgid = xcd_remap((int)L, U);
        int g = 0, hi = ng;
        while (hi - g > 1) { const int mid = (g + hi) >> 1; const int v = __builtin_amdgcn_readfirstlane(tab[64 + mid]); if (v <= wgid) g = mid; else hi = mid; }
        const int g0 = __builtin_amdgcn_readfirstlane(tab[64 + g]), t0 = __builtin_amdgcn_readfirstlane(tab[128 + g]), gsz = __builtin_amdgcn_readfirstlane(tab[192 + g]), ex = __builtin_amdgcn_readfirstlane(tab[256 + g]);
        const int local = wgid - g0;
        u.pm = t0 + local % gsz; u.pn = local / gsz; u.ex = ex; return true;
    }
    __device__ __forceinline__ const char* a_ptr(const Unit& u) const { return gather ? (const char*)A : (const char*)A + (size_t)u.pm * ((size_t)BM * K * 2); }
    __device__ __forceinline__ const char* b_ptr(const Unit& u) const { return (const char*)Bt + (size_t)u.ex * bstride + (size_t)u.pn * ((size_t)BM * K * 2); }
    __device__ __forceinline__ void rows_raw(const Unit& u, int tid, unsigned (&raw)[2][2]) const {
        asm volatile("" : "+v"(tid));
        const __amdgpu_buffer_rsrc_t rs = __builtin_amdgcn_make_buffer_rsrc((void*)(list + (size_t)u.pm * BM), (short)0, BM * 4, 0x00020000);
#pragma unroll
        for (int i = 0; i < 2; ++i) { int R, C; stage_rc(tid * 16 + i * 8192, R, C);
#pragma unroll
            for (int h = 0; h < 2; ++h) raw[h][i] = (unsigned)__builtin_amdgcn_raw_buffer_load_b32(rs, (unsigned)(h * HALF + R) * 4u, 0, 0); }
    }
};

struct EpiBf16 {
    static constexpr bool PERM = true;
    bf16* O; int ldc; int skip;
    __device__ __forceinline__ void operator()(const f32x4 (&acc)[2][2][4][2], const Unit& u, int wr, int wc, int fr, int fq) const {
        const int row0 = u.pm * BM + wr * 64 + fr, col0 = u.pn * BM + wc * 32 + 8 * fq;
        if (skip) { if (acc[0][0][0][0][0] == 12345.678f) O[0] = 1; return; }
#pragma unroll
        for (int ai = 0; ai < 2; ++ai)
#pragma unroll
            for (int m = 0; m < 4; ++m) { bf16* rowp = O + (size_t)(row0 + ai * HALF + m * 16) * ldc + col0;
#pragma unroll
                for (int bj = 0; bj < 2; ++bj) { const f32x4 v0 = acc[ai][bj][m][0], v1 = acc[ai][bj][m][1];
                    u32x4 w; w.x = cvt_pk_bf16(v0[0], v0[1]); w.y = cvt_pk_bf16(v0[2], v0[3]); w.z = cvt_pk_bf16(v1[0], v1[1]); w.w = cvt_pk_bf16(v1[2], v1[3]);
                    *(u32x4*)(rowp + bj * HALF) = w; } }
    }
};
struct EpiSwiglu {
    static constexpr bool PERM = true;
    bf16* O; int ldc;
    __device__ __forceinline__ void operator()(const f32x4 (&acc)[2][2][4][2], const Unit& u, int wr, int wc, int fr, int fq) const {
        const int row0 = u.pm * BM + wr * 64 + fr, col0 = u.pn * HALF + wc * 32 + 8 * fq;
        typedef float f32x2 __attribute__((ext_vector_type(2)));
        bf16* base = O + (size_t)row0 * ldc + col0;
#pragma unroll
        for (int ai = 0; ai < 2; ++ai)
#pragma unroll
            for (int m = 0; m < 4; ++m) { bf16* rowp = base + (size_t)(ai * HALF + m * 16) * ldc;
                float o[8];
#pragma unroll
                for (int n = 0; n < 2; ++n)
#pragma unroll
                    for (int j = 0; j < 4; j += 2) { const f32x2 g = {acc[ai][0][m][n][j], acc[ai][0][m][n][j + 1]}, up = {acc[ai][1][m][n][j], acc[ai][1][m][n][j + 1]};
                        const f32x2 t = g * -1.44269504089f; f32x2 r; r.x = __builtin_amdgcn_rcpf(1.0f + __builtin_amdgcn_exp2f(t.x)); r.y = __builtin_amdgcn_rcpf(1.0f + __builtin_amdgcn_exp2f(t.y));
                        const f32x2 v = (g * r) * up; o[n * 4 + j] = v.x; o[n * 4 + j + 1] = v.y; }
                u32x4 w; w.x = cvt_pk_bf16(o[0], o[1]); w.y = cvt_pk_bf16(o[2], o[3]); w.z = cvt_pk_bf16(o[4], o[5]); w.w = cvt_pk_bf16(o[6], o[7]);
                *(u32x4*)rowp = w; }
    }
};
struct EpiSwigluF8 {
    static constexpr bool PERM = true;
    unsigned char* O; int ldc; int skip;
    __device__ __forceinline__ void operator()(const f32x4 (&acc)[2][2][4][2], const Unit& u, int wr, int wc, int fr, int fq) const {
        const int row0 = u.pm * BM + wr * 64 + fr, col0 = u.pn * HALF + wc * 32 + 8 * fq;
        if (skip) { if (acc[0][0][0][0][0] == 12345.678f) O[0] = 1; return; }
        constexpr float si = 1.0f / (SC_H * SC_W), k1 = -1.44269504089f * si, k2 = si * si * SC_A;
        typedef float f32x2 __attribute__((ext_vector_type(2)));
        unsigned char* base = O + (size_t)row0 * ldc + col0;
#pragma unroll
        for (int ai = 0; ai < 2; ++ai)
#pragma unroll
            for (int m = 0; m < 4; ++m) { unsigned char* rowp = base + (size_t)(ai * HALF + m * 16) * ldc;
                float o[8];
#pragma unroll
                for (int n = 0; n < 2; ++n)
#pragma unroll
                    for (int j = 0; j < 4; j += 2) { const f32x2 g = {acc[ai][0][m][n][j], acc[ai][0][m][n][j + 1]}, up = {acc[ai][1][m][n][j], acc[ai][1][m][n][j + 1]};
                        const f32x2 t = g * k1; f32x2 r; r.x = __builtin_amdgcn_rcpf(1.0f + __builtin_amdgcn_exp2f(t.x)); r.y = __builtin_amdgcn_rcpf(1.0f + __builtin_amdgcn_exp2f(t.y));
                        const f32x2 v = (g * r) * (up * k2);
                        o[n * 4 + j] = __builtin_amdgcn_fmed3f(v.x, -448.f, 448.f); o[n * 4 + j + 1] = __builtin_amdgcn_fmed3f(v.y, -448.f, 448.f); }
                u32x2 w; unsigned t0 = 0, t1 = 0;
                t0 = __builtin_amdgcn_cvt_pk_fp8_f32(o[0], o[1], t0, false); t0 = __builtin_amdgcn_cvt_pk_fp8_f32(o[2], o[3], t0, true);
                t1 = __builtin_amdgcn_cvt_pk_fp8_f32(o[4], o[5], t1, false); t1 = __builtin_amdgcn_cvt_pk_fp8_f32(o[6], o[7], t1, true);
                w.x = t0; w.y = t1; *(u32x2*)rowp = w; }
    }
};
template <bool XF32> struct EpiResidual {
    static constexpr bool PERM = true;
    const void* xin; bf16* out; const float* gate; float gs;
    __device__ __forceinline__ void operator()(const f32x4 (&acc)[2][2][4][2], const Unit& u, int wr, int wc, int fr, int fq) const {
        const int row0 = u.pm * BM + wr * 64 + fr, col0 = u.pn * BM + wc * 32 + 8 * fq, b = u.pm >> 5;
        f32x4 gv[2][2];
#pragma unroll
        for (int bj = 0; bj < 2; ++bj)
#pragma unroll
            for (int n = 0; n < 2; ++n) gv[bj][n] = *(const f32x4*)(gate + (size_t)b * NMOD + col0 + bj * HALF + n * 4) * gs;
#pragma unroll
        for (int ai = 0; ai < 2; ++ai)
#pragma unroll
            for (int m = 0; m < 4; ++m) { const size_t off = (size_t)(row0 + ai * HALF + m * 16) * D + col0;
#pragma unroll
                for (int bj = 0; bj < 2; ++bj) { f32x4 x0, x1;
                    if (XF32) { x0 = *(const f32x4*)((const float*)xin + off + bj * HALF); x1 = *(const f32x4*)((const float*)xin + off + bj * HALF + 4); }
                    else { const u32x4 xr = *(const u32x4*)((const bf16*)xin + off + bj * HALF); x0 = (f32x4){bflo(xr.x), bfhi(xr.x), bflo(xr.y), bfhi(xr.y)}; x1 = (f32x4){bflo(xr.z), bfhi(xr.z), bflo(xr.w), bfhi(xr.w)}; }
                    const f32x4 r0 = x0 + gv[bj][0] * acc[ai][bj][m][0], r1 = x1 + gv[bj][1] * acc[ai][bj][m][1];
                    u32x4 w; w.x = cvt_pk_bf16(r0[0], r0[1]); w.y = cvt_pk_bf16(r0[2], r0[3]); w.z = cvt_pk_bf16(r1[0], r1[1]); w.w = cvt_pk_bf16(r1[2], r1[3]);
                    *(u32x4*)(out + off + bj * HALF) = w; }
                asm volatile("" ::: "memory"); }
    }
};
struct EpiMoeDown {
    static constexpr bool PERM = true;
    bf16* out; const int* list; const float* wgt; const float* gate; float ascale; bf16* dump;
    __device__ __forceinline__ void operator()(const f32x4 (&acc)[2][2][4][2], const Unit& u, int wr, int wc, int fr, int fq) const {
        const int pos0 = u.pm * BM + wr * 64 + fr, col0 = u.pn * BM + wc * 32 + 8 * fq;
#pragma unroll
        for (int ai = 0; ai < 2; ++ai)
#pragma unroll
            for (int m = 0; m < 4; ++m) { const int pos = pos0 + ai * HALF + m * 16; const int tk = list[pos]; const float w = wgt[pos] * ascale;
                bf16* orow = (tk >= 0 ? out + (size_t)tk * D : dump) + col0; const float* gp = gate + (size_t)(tk >= 0 ? (tk >> 13) : 0) * NMOD + col0;
#pragma unroll
                for (int bj = 0; bj < 2; ++bj) { const f32x4 g0 = *(const f32x4*)(gp + bj * HALF), g1 = *(const f32x4*)(gp + bj * HALF + 4);
                    const u32x4 xr = *(const u32x4*)(orow + bj * HALF);
                    const f32x4 x0 = {bflo(xr.x), bfhi(xr.x), bflo(xr.y), bfhi(xr.y)}, x1 = {bflo(xr.z), bfhi(xr.z), bflo(xr.w), bfhi(xr.w)};
                    const f32x4 r0 = x0 + (g0 * w) * acc[ai][bj][m][0], r1 = x1 + (g1 * w) * acc[ai][bj][m][1];
                    u32x4 o; o.x = cvt_pk_bf16(r0[0], r0[1]); o.y = cvt_pk_bf16(r0[2], r0[3]); o.z = cvt_pk_bf16(r1[0], r1[1]); o.w = cvt_pk_bf16(r1[2], r1[3]);
                    *(u32x4*)(orow + bj * HALF) = o; }
                asm volatile("" ::: "memory"); }
    }
};

template <class Epi, class Sched, bool GATHER, bool FP8 = false>
__device__ __forceinline__ void gemm_phase(LAS unsigned char* lds, const int K, const Sched& S, const Epi& E, LAS u32x4* goff = nullptr, int ntdiv = 1) {
    int tid_ = threadIdx.x; asm volatile("" : "+v"(tid_));
    const int tid = tid_, wid = __builtin_amdgcn_readfirstlane(tid >> 6), lane = tid & 63, wr = wid >> 2, wc = wid & 3, fr = lane & 15, fq = lane >> 4;
    int nt = K / BK / ntdiv; asm volatile("" : "+s"(nt));
    unsigned voffB[2], ao[2][2], no[2][2];
    const size_t kstep = (size_t)(BK * 2);
    const size_t hstep = (size_t)HALF * K * 2;
#pragma unroll
    for (int i = 0; i < 2; ++i) { int R, C; stage_rc(tid * 16 + i * 8192, R, C); const int Rb = Epi::PERM ? ((R & ~31) + perm32(R & 31)) : R;
        voffB[i] = (unsigned)(Rb * K + C) * 2u;
        ao[0][i] = (unsigned)(R * K + C) * 2u; ao[1][i] = ao[0][i] + (unsigned)hstep; no[0][i] = ao[0][i]; no[1][i] = ao[1][i]; }
    const unsigned ldsw = (unsigned)wid * 1024u;
    const int aoff = lds_byte(wr * 64 + fr, fq * 8), boff = lds_byte(wc * 32 + fr, fq * 8);
#define PG8_CB(i) ([&]() { int t_ = tid; asm volatile("" : "+v"(t_)); int R_, C_; stage_rc(t_ * 16 + (i) * 8192, R_, C_); return (unsigned)C_ * 2u; }())
#define PG8_SA(b, h) (((b) * 2 + (h)) * HTB)
#define PG8_SB(b, h) ((4 + (b) * 2 + (h)) * HTB)
#define PG8_STAGEB(bufoff, gbase) do { _Pragma("unroll") for (int _i = 0; _i < 2; ++_i) \
        __builtin_amdgcn_global_load_lds((const unsigned*)((const char*)(gbase) + voffB[_i]), (LAS unsigned*)(lds + (bufoff) + ldsw + _i * 8192), 16, 0, 0); } while (0)
#define PG8_STAGEA(bufoff, gbase, offs, h) do { _Pragma("unroll") for (int _i = 0; _i < 2; ++_i) \
        __builtin_amdgcn_global_load_lds((const unsigned*)((const char*)(gbase) + (offs)[h][_i]), (LAS unsigned*)(lds + (bufoff) + ldsw + _i * 8192), 16, 0, 0); } while (0)
#define PG8_LD32(p) __builtin_shufflevector(*(const LAS i32x4*)(p), *(const LAS i32x4*)((p) + 1024), 0, 1, 2, 3, 4, 5, 6, 7)
#define PG8_LDA(dst, b, h) do { _Pragma("unroll") for (int m = 0; m < 4; ++m) { if constexpr (FP8) dst##8[m] = PG8_LD32(lds + PG8_SA(b, h) + aoff + m * 2048); \
        else { _Pragma("unroll") for (int k = 0; k < 2; ++k) dst[m][k] = *(const LAS bf16x8*)(lds + PG8_SA(b, h) + aoff + m * 2048 + k * 1024); } } } while (0)
#define PG8_LDB(dst, b, h) do { _Pragma("unroll") for (int n = 0; n < 2; ++n) { if constexpr (FP8) dst##8[n] = PG8_LD32(lds + PG8_SB(b, h) + boff + n * 2048); \
        else { _Pragma("unroll") for (int k = 0; k < 2; ++k) dst[n][k] = *(const LAS bf16x8*)(lds + PG8_SB(b, h) + boff + n * 2048 + k * 1024); } } } while (0)
#define PG8_MMA(ai, bj, At, Bt) do { __builtin_amdgcn_s_setprio(1); _Pragma("unroll") for (int m = 0; m < 4; ++m) _Pragma("unroll") for (int n = 0; n < 2; ++n) { \
        if constexpr (FP8) asm volatile("v_mfma_scale_f32_16x16x128_f8f6f4 %0, %1, %2, %0, %3, %3 op_sel_hi:[0,0,0]" : "+v"(acc[ai][bj][m][n]) : "v"(Bt##8[n]), "v"(At##8[m]), "v"(sc1));     \
        else { _Pragma("unroll") for (int k = 0; k < 2; ++k) acc[ai][bj][m][n] = __builtin_amdgcn_mfma_f32_16x16x32_bf16(Bt[n][k], At[m][k], acc[ai][bj][m][n], 0, 0, 0); } } \
        __builtin_amdgcn_s_setprio(0); } while (0)
#define PG8_WAIT_V(n) asm volatile("s_waitcnt vmcnt(" #n ")" ::: "memory")
#define PG8_WAIT_L(n) asm volatile("s_waitcnt lgkmcnt(" #n ")" ::: "memory")
#define PG8_BAR __builtin_amdgcn_s_barrier()
#define PG8_SCHED __builtin_amdgcn_sched_barrier(0)
    Unit cur, nxt, nn; int ui = 0;
    if (!S.next(0, cur)) return;
    bool has_next = S.next(1, nxt);
    if constexpr (GATHER) {
        unsigned raw[2][2]; S.rows_raw(cur, tid, raw);
#pragma unroll
        for (int h = 0; h < 2; ++h)
#pragma unroll
            for (int i = 0; i < 2; ++i) ao[h][i] = (raw[h][i] & 0xffffffu) * (unsigned)(K * 2) + PG8_CB(i);
        if (has_next) { S.rows_raw(nxt, tid, raw);
#pragma unroll
            for (int h = 0; h < 2; ++h)
#pragma unroll
                for (int i = 0; i < 2; ++i) no[h][i] = (raw[h][i] & 0xffffffu) * (unsigned)(K * 2) + PG8_CB(i); }
        else {
#pragma unroll
            for (int h = 0; h < 2; ++h)
#pragma unroll
                for (int i = 0; i < 2; ++i) no[h][i] = ao[h][i]; }
        goff[tid] = (u32x4){no[0][0], no[0][1], no[1][0], no[1][1]};
    }
    f32x4 acc[2][2][4][2];
#pragma unroll
    for (int a = 0; a < 2; ++a)
#pragma unroll
        for (int b = 0; b < 2; ++b)
#pragma unroll
            for (int m = 0; m < 4; ++m)
#pragma unroll
                for (int n = 0; n < 2; ++n) acc[a][b][m][n] = (f32x4){0.f, 0.f, 0.f, 0.f};
    const int sc1 = 0x7f7f7f7f;
    bf16x8 At[4][2], B0[2][2], B1[2][2];
    i32x8 At8[4], B08[2], B18[2];
    const char* cA = S.a_ptr(cur); const char* cB = S.b_ptr(cur);
    PG8_STAGEB(PG8_SB(0, 0), cB); PG8_STAGEB(PG8_SB(0, 1), cB + hstep); PG8_STAGEA(PG8_SA(0, 0), cA, ao, 0); PG8_STAGEA(PG8_SA(0, 1), cA, ao, 1);
    if (wr == 1) PG8_BAR;
    PG8_WAIT_V(2); PG8_BAR;
    PG8_STAGEB(PG8_SB(1, 0), cB + kstep); PG8_STAGEA(PG8_SA(1, 0), cA + kstep, ao, 0); PG8_STAGEB(PG8_SB(1, 1), cB + hstep + kstep);
    PG8_WAIT_V(6); PG8_BAR;
    for (;;) {
        const char* nA = has_next ? S.a_ptr(nxt) : cA; const char* nB = has_next ? S.b_ptr(nxt) : cB;
#pragma clang loop unroll(disable)
        for (int t = 0; t < nt; t += 2) {
            const bool last = (t == nt - 2);
            const char* a1 = cA + (size_t)(t + 1) * kstep;
            const char* a2 = last ? nA : cA + (size_t)(t + 2) * kstep; const char* b2 = last ? nB : cB + (size_t)(t + 2) * kstep;
            const char* a3 = a2 + kstep; const char* b3 = b2 + kstep;
            asm volatile("" : "+v"(voffB[0]), "+v"(voffB[1]), "+v"(ao[0][0]), "+v"(ao[0][1]), "+v"(ao[1][0]), "+v"(ao[1][1]));
            PG8_LDB(B0, 0, 0); PG8_LDB(B1, 0, 1); PG8_SCHED; PG8_LDA(At, 0, 0); PG8_STAGEA(PG8_SA(1, 1), a1, ao, 1);
            if constexpr (GATHER) { if (last) { const u32x4 q = goff[tid]; ao[0][0] = q[0]; ao[0][1] = q[1]; ao[1][0] = q[2]; ao[1][1] = q[3]; } }
            PG8_WAIT_V(8); PG8_WAIT_L(0); PG8_BAR; PG8_MMA(0, 0, At, B0); PG8_MMA(0, 1, At, B1); PG8_BAR; PG8_SCHED;
            PG8_LDA(At, 0, 1); PG8_STAGEB(PG8_SB(0, 0), b2); PG8_STAGEB(PG8_SB(0, 1), b2 + hstep); PG8_STAGEA(PG8_SA(0, 0), a2, ao, 0);
            PG8_WAIT_V(8); PG8_WAIT_L(0); PG8_BAR; PG8_MMA(1, 0, At, B0); PG8_MMA(1, 1, At, B1); PG8_BAR; PG8_SCHED;
            PG8_LDB(B0, 1, 0); PG8_LDB(B1, 1, 1); PG8_SCHED; PG8_LDA(At, 1, 0); PG8_STAGEA(PG8_SA(0, 1), a2, ao, 1);
            PG8_WAIT_V(8); PG8_WAIT_L(0); PG8_BAR; PG8_MMA(0, 0, At, B0); PG8_MMA(0, 1, At, B1); PG8_BAR; PG8_SCHED;
            PG8_LDA(At, 1, 1); PG8_STAGEB(PG8_SB(1, 0), b3); PG8_STAGEB(PG8_SB(1, 1), b3 + hstep); PG8_STAGEA(PG8_SA(1, 0), a3, ao, 0);
            PG8_WAIT_V(8); PG8_WAIT_L(0); PG8_BAR; PG8_MMA(1, 0, At, B0); PG8_MMA(1, 1, At, B1); PG8_BAR; PG8_SCHED;
        }
        if (wr == 0) PG8_BAR;
        if constexpr (FP8) asm volatile("s_nop 15\n\ts_nop 15\n\ts_nop 7" ::: "memory");
        bool has_nn = false; unsigned raw[2][2];
        if (has_next) has_nn = S.next(ui + 2, nn);
        if constexpr (GATHER) { if (has_nn) S.rows_raw(nn, tid, raw); }
        E(acc, cur, wr, wc, fr, fq);
        if (!has_next) break;
#pragma unroll
        for (int a = 0; a < 2; ++a)
#pragma unroll
            for (int b = 0; b < 2; ++b)
#pragma unroll
                for (int m = 0; m < 4; ++m)
#pragma unroll
                    for (int n = 0; n < 2; ++n) acc[a][b][m][n] = (f32x4){0.f, 0.f, 0.f, 0.f};
        if constexpr (GATHER) {
            if (has_nn) { u32x4 q;
#pragma unroll
                for (int h = 0; h < 2; ++h)
#pragma unroll
                    for (int i = 0; i < 2; ++i) q[h * 2 + i] = (raw[h][i] & 0xffffffu) * (unsigned)(K * 2) + PG8_CB(i);
                goff[tid] = q; }
        }
        cur = nxt; cA = nA; cB = nB; nxt = nn; has_next = has_nn; ++ui;
        if (wr == 1) PG8_BAR;
    }
    PG8_WAIT_V(0);
    PG8_BAR;
#undef PG8_SA
#undef PG8_CB
#undef PG8_SB
#undef PG8_STAGEA
#undef PG8_STAGEB
#undef PG8_LDA
#undef PG8_LDB
#undef PG8_MMA
#undef PG8_LD32
#undef PG8_WAIT_V
#undef PG8_WAIT_L
#undef PG8_BAR
#undef PG8_SCHED
}
}

struct Args { const float* in[27]; float* out; unsigned char* ws; };
typedef const float* cfp_t;
typedef __attribute__((address_space(4))) const cfp_t* kargp_t;
struct Frame {
    LAS unsigned char* lds;
    int tid, lane, wave, G, bid;
    kargp_t ka;
};
#define PHASE_ENTER(F) do { kargp_t _p = (F).ka; asm volatile("" : "+s"(_p)); (F).ka = _p; \
    int _t = threadIdx.x; asm volatile("" : "+v"(_t)); (F).tid = _t; (F).lane = _t & 63; (F).wave = __builtin_amdgcn_readfirstlane(_t >> 6); \
    int _g = gridDim.x; asm volatile("" : "+s"(_g)); (F).G = _g; int _b = blockIdx.x; asm volatile("" : "+s"(_b)); (F).bid = _b; } while (0)
#define KIN(k) ((F).ka[k])
#define KOUT ((float*)(F).ka[27])
#define KWS ((unsigned char*)(F).ka[28])
#define KMOD ((float*)(KWS + WS_MOD))
#define KH ((bf16*)(KWS + WS_H))
#define KPROJ ((bf16*)(KWS + WS_BIG))
#define KMIXED ((bf16*)(KWS + WS_MIXED))
#define KACT ((bf16*)(KWS + WS_BIG))
#define KXB ((bf16*)(KWS + WS_XB))

__device__ __forceinline__ void p0_transpose_item(const float* W, int K, int N, bf16* WT, int dst_row0, LAS float* scr, int kb, int nb, int lane) {
    const int k0 = 64 * kb, n0 = 32 * nb;
    { f32x4 t[8];
#pragma unroll
      for (int i = 0; i < 8; ++i) t[i] = *(const f32x4*)(W + (size_t)(k0 + 8 * i + (lane >> 3)) * N + n0 + 4 * (lane & 7));
#pragma unroll
      for (int i = 0; i < 8; ++i) { LAS float* d = scr + (8 * i + (lane >> 3)) * 33 + 4 * (lane & 7); d[0] = t[i][0]; d[1] = t[i][1]; d[2] = t[i][2]; d[3] = t[i][3]; } }
    LDS_WAIT(); asm volatile("" ::: "memory");
    const int c = lane & 7;
#pragma unroll
    for (int j = 0; j < 4; ++j) { const int n = (lane >> 3) + 8 * j; const LAS float* s = scr + (8 * c) * 33 + n;
        u32x4 o; o.x = pk2(s[0 * 33], s[1 * 33]); o.y = pk2(s[2 * 33], s[3 * 33]); o.z = pk2(s[4 * 33], s[5 * 33]); o.w = pk2(s[6 * 33], s[7 * 33]);
        *(u32x4*)(WT + (size_t)(dst_row0 + n) * K + k0 + 8 * c) = o; }
    LDS_WAIT(); asm volatile("" ::: "memory");
}
__device__ __forceinline__ void p0_transpose_item_f8(const float* W, int K, int N, unsigned char* WT, int dst_row0, LAS float* scr, int kb, int nb, int lane) {
    const int k0 = 64 * kb, n0 = 32 * nb;
    { f32x4 t[8];
#pragma unroll
      for (int i = 0; i < 8; ++i) t[i] = *(const f32x4*)(W + (size_t)(k0 + 8 * i + (lane >> 3)) * N + n0 + 4 * (lane & 7));
#pragma unroll
      for (int i = 0; i < 8; ++i) { LAS float* d = scr + (8 * i + (lane >> 3)) * 33 + 4 * (lane & 7); d[0] = t[i][0]; d[1] = t[i][1]; d[2] = t[i][2]; d[3] = t[i][3]; } }
    LDS_WAIT(); asm volatile("" ::: "memory");
    const int n = lane >> 1, kh = (lane & 1) * 32; const LAS float* sp = scr + kh * 33 + n;
#pragma unroll
    for (int q = 0; q < 2; ++q) { u32x4 o;
#pragma unroll
        for (int d = 0; d < 4; ++d) { const int kk = q * 16 + d * 4; o[d] = pk4_fp8(sp[(kk + 0) * 33] * SC_W, sp[(kk + 1) * 33] * SC_W, sp[(kk + 2) * 33] * SC_W, sp[(kk + 3) * 33] * SC_W); }
        *(u32x4*)(WT + (size_t)(dst_row0 + n) * K + k0 + kh + q * 16) = o; }
    LDS_WAIT(); asm volatile("" ::: "memory");
}
__device__ __forceinline__ int gu_row(int n) { return (n >> 7) * 256 + (n & 127); }

__device__ __forceinline__ void p0_prologue(Frame& F) {
    if (F.bid < 192) {
        LAS float* cond = (LAS float*)F.lds;
        LAS float* red = (LAS float*)(F.lds + 32768);
        const float* cin = KIN(1);
        for (int i = F.tid; i < BATCH * D; i += NTHREADS) cond[i] = silu_f(cin[i]);
        __syncthreads();
        for (int item = F.bid; item < 192; item += F.G) {
            const int l = item / 96, colbase = (item % 96) * 64, col = colbase + F.lane;
            const float* W = KIN(2) + (size_t)l * D * NMOD;
            float a[8];
#pragma unroll
            for (int b = 0; b < 8; ++b) a[b] = 0.f;
            for (int k0 = F.wave * 128; k0 < F.wave * 128 + 128; k0 += 16) { float w[16];
#pragma unroll
                for (int i = 0; i < 16; ++i) w[i] = W[(size_t)(k0 + i) * NMOD + col];
#pragma unroll
                for (int i = 0; i < 16; ++i)
#pragma unroll
                    for (int b = 0; b < 8; ++b) a[b] = fmaf(cond[b * D + k0 + i], w[i], a[b]); }
#pragma unroll
            for (int b = 0; b < 8; ++b) red[(F.wave * 8 + b) * 64 + F.lane] = a[b];
            __syncthreads();
            { const int b = F.tid >> 6, cl = F.tid & 63; float s = 0.f;
#pragma unroll
              for (int w = 0; w < 8; ++w) s += red[(w * 8 + b) * 64 + cl];
              KMOD[((size_t)l * BATCH + b) * NMOD + colbase + cl] = s + KIN(3)[(size_t)l * NMOD + colbase + cl]; }
            __syncthreads();
        }
    }
    LAS float* scr = (LAS float*)(F.lds + F.wave * 16384);
    const int gw = F.bid * NWAVES + F.wave, NGW = F.G * NWAVES;
    constexpr int I_IN = 16 * 56, I_OUT = 16 * 32, I_FG = 16 * 88, I_FD = 44 * 32, I_MG = 16 * 112, I_MD = 56 * 32;
    constexpr int NITEMS = 2 * I_IN + 2 * I_OUT + 2 * I_FG + I_FD + 16 * I_MG + 8 * I_MD;
    bf16* ws_b = (bf16*)KWS;
    for (int it = gw; it < NITEMS; it += NGW) {
        int r = it;
        if (r < 2 * I_IN) { const int l = r / I_IN; r -= l * I_IN; const int kb = r / 56, nb = r % 56;
            p0_transpose_item(KIN(6) + (size_t)l * D * D_IN, D, D_IN, (bf16*)(KWS + WS_WIN) + (size_t)l * D_IN * D, 32 * nb, scr, kb, nb, F.lane); continue; } r -= 2 * I_IN;
        if (r < 2 * I_OUT) { const int l = r / I_OUT; r -= l * I_OUT; const int kb = r / 32, nb = r % 32;
            p0_transpose_item(KIN(17) + (size_t)l * D * D, D, D, (bf16*)(KWS + WS_WOUT) + (size_t)l * D * D, 32 * nb, scr, kb, nb, F.lane); continue; } r -= 2 * I_OUT;
        if (r < 2 * I_FG) { const int up = r / I_FG; r -= up * I_FG; const int kb = r / 88, nb = r % 88;
            p0_transpose_item(up ? KIN(19) : KIN(18), D, FF, (bf16*)(KWS + WS_WGU), gu_row(32 * nb) + 128 * up, scr, kb, nb, F.lane); continue; } r -= 2 * I_FG;
        if (r < I_FD) { const int kb = r / 32, nb = r % 32;
            p0_transpose_item(KIN(20), FF, D, (bf16*)(KWS + WS_WD), 32 * nb, scr, kb, nb, F.lane); continue; } r -= I_FD;
        if (r < 16 * I_MG) { const int q = r / I_MG; r -= q * I_MG; const int up = q >> 3, e = q & 7; const int kb = r / 112, nb = r % 112;
            p0_transpose_item_f8((up ? KIN(24) : KIN(23)) + (size_t)e * D * FFE, D, FFE, (unsigned char*)(KWS + WS_MWGU) + (size_t)e * 2 * FFE * D, gu_row(32 * nb) + 128 * up, scr, kb, nb, F.lane); continue; } r -= 16 * I_MG;
        { const int e = r / I_MD; r -= e * I_MD; const int kb = r / 32, nb = r % 32;
            p0_transpose_item_f8(KIN(25) + (size_t)e * FFE * D, FFE, D, (unsigned char*)(KWS + WS_MWD) + (size_t)e * D * FFE, 32 * nb, scr, kb, nb, F.lane); }
    }
    (void)ws_b;
    if (F.bid == 0) for (int i = F.tid; i < D; i += NTHREADS) ((float*)(KWS + WS_DUMP))[i] = 0.f;
    { bf16* pw = (bf16*)(KWS + WS_POOLW);
      for (int i = F.bid * NTHREADS + F.tid; i < 2 * 4 * 64 * 64; i += F.G * NTHREADS) { const int c = i & 63, d = (i >> 6) & 63, lg = i >> 12;
          pw[i] = (bf16)f2bf(KIN(7)[((size_t)lg * 64 + c) * 64 + d] * KIN(8)[lg * 64 + d]); } }
    { const float* sw = KIN(15); bf16* so = (bf16*)(KWS + WS_SGUW);
      for (int i = (F.bid * NTHREADS + F.tid) * 4; i < 2 * NH * 128 * 128; i += F.G * NTHREADS * 4) { const f32x4 v = *(const f32x4*)(sw + i); u32x2 o; o.x = pk2(v[0], v[1]); o.y = pk2(v[2], v[3]); *(u32x2*)(so + i) = o; } }
}

template <int MODE, bool SRCB>
__device__ __forceinline__ void norm_phase(Frame& F, const void* xsrc, const float* g, const float* shiftp, const float* scalep, bf16* hdst, float* fdst) {
    LAS int* lhist = (LAS int*)(F.lds + LC_HIST);
    for (int tb = F.bid; tb < M / 256; tb += F.G) {
        const int row0 = tb * 256 + F.wave * 32, b = row0 >> 13;
        f32x4 gm[4], sh[4];
#pragma unroll
        for (int j = 0; j < 4; ++j) { const int col = 4 * F.lane + 256 * j; const f32x4 gg = *(const f32x4*)(g + col);
            if (MODE == 2) { gm[j] = gg; sh[j] = (f32x4){0.f, 0.f, 0.f, 0.f}; }
            else { const f32x4 sc = *(const f32x4*)(scalep + (size_t)b * NMOD + col); gm[j] = gg * (1.0f + sc); sh[j] = *(const f32x4*)(shiftp + (size_t)b * NMOD + col); } }
        float rbias[8];
        LAS float* rwl = (LAS float*)F.lds;
        if (MODE == 1) {
            for (int i = F.tid; i < D * NE; i += NTHREADS) rwl[(i & 7) * D + (i >> 3)] = KIN(21)[i];
#pragma unroll
            for (int e = 0; e < 8; ++e) rbias[e] = KIN(22)[e];
            if (F.tid < 16) lhist[F.tid] = 0;
            __syncthreads();
        }
        for (int rq = 0; rq < 32; rq += 4) {
            f32x4 vv[4][4];
#pragma unroll
            for (int rr = 0; rr < 4; ++rr) { const int row = row0 + rq + rr;
                if (SRCB) { const u32x2* xr = (const u32x2*)((const bf16*)xsrc + (size_t)row * D) + F.lane;
#pragma unroll
                    for (int j = 0; j < 4; ++j) { const u32x2 t = xr[64 * j]; vv[rr][j] = (f32x4){bflo(t.x), bfhi(t.x), bflo(t.y), bfhi(t.y)}; } }
                else { const f32x4* xr = (const f32x4*)((const float*)xsrc + (size_t)row * D) + F.lane;
#pragma unroll
                    for (int j = 0; j < 4; ++j) vv[rr][j] = xr[64 * j]; } }
#pragma unroll
            for (int rr = 0; rr < 4; ++rr) {
            const int row = row0 + rq + rr;
            f32x4 v[4]; float ss = 0.f;
#pragma unroll
            for (int j = 0; j < 4; ++j) v[j] = vv[rr][j];
#pragma unroll
            for (int j = 0; j < 4; ++j) { ss += (v[j][0] * v[j][0] + v[j][1] * v[j][1]) + (v[j][2] * v[j][2] + v[j][3] * v[j][3]); }
            const float rstd = 1.0f / sqrtf(wave_sum(ss) * (1.0f / D) + EPS);
#pragma unroll
            for (int j = 0; j < 4; ++j) v[j] = (v[j] * rstd) * gm[j] + sh[j];
            if (MODE == 2) { f32x4* o = (f32x4*)(fdst + (size_t)row * D) + F.lane;
#pragma unroll
                for (int j = 0; j < 4; ++j) o[64 * j] = v[j]; }
            else if (MODE == 1) { unsigned* o = (unsigned*)((unsigned char*)hdst + (size_t)row * D) + F.lane;
#pragma unroll
                for (int j = 0; j < 4; ++j) o[64 * j] = pk4_fp8(v[j][0] * SC_H, v[j][1] * SC_H, v[j][2] * SC_H, v[j][3] * SC_H); }
            else { u32x2* o = (u32x2*)(hdst + (size_t)row * D) + F.lane;
#pragma unroll
                for (int j = 0; j < 4; ++j) { u32x2 w; w.x = pk2(v[j][0], v[j][1]); w.y = pk2(v[j][2], v[j][3]); o[64 * j] = w; } }
            if (MODE == 1) {
                float lg[8];
#pragma unroll
                for (int e = 0; e < 8; ++e) lg[e] = 0.f;
#pragma unroll
                for (int e = 0; e < 8; ++e)
#pragma unroll
                    for (int j = 0; j < 4; ++j) { const f32x4 wv = *(const LAS f32x4*)(rwl + e * D + 4 * F.lane + 256 * j);
                        lg[e] = fmaf(v[j][0], wv[0], lg[e]); lg[e] = fmaf(v[j][1], wv[1], lg[e]); lg[e] = fmaf(v[j][2], wv[2], lg[e]); lg[e] = fmaf(v[j][3], wv[3], lg[e]); }
#pragma unroll
                for (int e = 0; e < 8; ++e) lg[e] = wave_sum(lg[e]) + rbias[e];
                int i1 = 0; float v1 = lg[0];
#pragma unroll
                for (int e = 1; e < 8; ++e) if (lg[e] > v1) { v1 = lg[e]; i1 = e; }
                int i2 = -1; float v2 = -3.0e38f;
#pragma unroll
                for (int e = 0; e < 8; ++e) if (e != i1 && lg[e] > v2) { v2 = lg[e]; i2 = e; }
                const float ex = __expf(v2 - v1), w1 = 1.0f / (1.0f + ex), w2 = ex * w1;
                if (F.lane == 0) { u32x4 rec; rec.x = (unsigned)i1; rec.y = (unsigned)i2; rec.z = __float_as_uint(w1); rec.w = __float_as_uint(w2);
                    *(u32x4*)(KWS + WS_REC + (size_t)row * 16) = rec; __hip_atomic_fetch_add(&lhist[i1], 1, __ATOMIC_RELAXED, __HIP_MEMORY_SCOPE_WORKGROUP); __hip_atomic_fetch_add(&lhist[8 + i2], 1, __ATOMIC_RELAXED, __HIP_MEMORY_SCOPE_WORKGROUP); }
            }
        }
        }
        if (MODE == 1) { __syncthreads(); if (F.tid < 16) ((int*)(KWS + WS_HIST))[tb * 16 + F.tid] = lhist[F.tid]; __syncthreads(); }
    }
}

__device__ __forceinline__ void route_phase(Frame& F) {
    LAS int* ltot = (LAS int*)(F.lds + LC_TOT); LAS int* lpre = (LAS int*)(F.lds + LC_PRE); LAS int* ltb = (LAS int*)(F.lds + LC_TBASE); LAS int* lwc = (LAS int*)(F.lds + LC_WCNT);
    const int* hist = (const int*)(KWS + WS_HIST);
    int* list = (int*)(KWS + WS_LIST); float* wgt = (float*)(KWS + WS_WGT);
    for (int tb = F.bid; tb < M / 256; tb += F.G) {
        if (F.tid < 16) { ltot[F.tid] = 0; lpre[F.tid] = 0; }
        __syncthreads();
        { const int pe = F.tid & 15, part = F.tid >> 4; int sa = 0, sp = 0;
#pragma unroll
          for (int k = 0; k < 8; ++k) { const int t = part * 8 + k; const int v = hist[t * 16 + pe]; sa += v; sp += (t < tb) ? v : 0; }
          __hip_atomic_fetch_add(&ltot[pe], sa, __ATOMIC_RELAXED, __HIP_MEMORY_SCOPE_WORKGROUP); __hip_atomic_fetch_add(&lpre[pe], sp, __ATOMIC_RELAXED, __HIP_MEMORY_SCOPE_WORKGROUP); }
        __syncthreads();
        if (F.tid < 2) { int base = 0; for (int e = 0; e < 8; ++e) { ltb[F.tid * 8 + e] = base; base += (ltot[F.tid * 8 + e] + 255) >> 8; } }
        __syncthreads();
        unsigned e01[2] = {0u, 0u}; float w01[2] = {0.f, 0.f}; int rk[2] = {0, 0};
        if (F.tid < 256) {
            const u32x4 rec = *(const u32x4*)(KWS + WS_REC + (size_t)(tb * 256 + F.tid) * 16);
            e01[0] = rec.x; e01[1] = rec.y; w01[0] = __uint_as_float(rec.z); w01[1] = __uint_as_float(rec.w);
#pragma unroll
            for (int p = 0; p < 2; ++p)
#pragma unroll
                for (int ee = 0; ee < 8; ++ee) { const unsigned long long mk = __ballot(e01[p] == (unsigned)ee);
                    if (e01[p] == (unsigned)ee) rk[p] = __builtin_popcountll(mk & ((1ull << F.lane) - 1ull));
                    if (F.lane == 0) lwc[(p * 4 + F.wave) * 8 + ee] = __builtin_popcountll(mk); }
        }
        __syncthreads();
        if (F.tid < 256) {
#pragma unroll
            for (int p = 0; p < 2; ++p) { const int e = (int)e01[p]; int off = 0;
                for (int w = 0; w < F.wave; ++w) off += lwc[(p * 4 + w) * 8 + e];
                const int pos = ltb[p * 8 + e] * 256 + lpre[p * 8 + e] + off + rk[p];
                list[p * LISTN + pos] = tb * 256 + F.tid; wgt[p * LISTN + pos] = w01[p]; }
        }
        if (tb < 16) { const int p = tb >> 3, e = tb & 7; const int lo = ltb[tb] * 256 + ltot[tb], hi = (ltb[tb] + ((ltot[tb] + 255) >> 8)) * 256;
            for (int i = lo + F.tid; i < hi; i += NTHREADS) { list[p * LISTN + i] = (int)0x80000000u; wgt[p * LISTN + i] = 0.f; } (void)e; }
        if (tb == 0 && F.tid < 16) ((int*)(KWS + WS_TOT))[F.tid] = ltot[F.tid];
        __syncthreads();
    }
}
__device__ __forceinline__ void build_group_table(Frame& F, int p, int nN) {
    LAS int* tab = (LAS int*)(F.lds + LC_GT);
    __syncthreads();
    if (F.tid == 0) { const int* tot = (const int*)(KWS + WS_TOT) + p * 8; int ng = 0, ustart = 0, tile = 0;
        for (int e = 0; e < 8; ++e) { int tl = (tot[e] + 255) >> 8;
            while (tl > 0) { const int gsz = tl < 8 ? tl : 8; tab[64 + ng] = ustart; tab[128 + ng] = tile; tab[192 + ng] = gsz; tab[256 + ng] = e; ustart += gsz * nN; tile += gsz; tl -= gsz; ++ng; } }
        tab[0] = ng; tab[1] = ustart; }
    __syncthreads();
}

__device__ __forceinline__ void mixer_unit(Frame& F, const int l, const int unit) {
    const bf16* P = KPROJ; bf16* MO = KMIXED;
    const int t0 = unit * 128, s0 = t0 & (SEQ - 1), rb = t0 - s0;
    const int lane = F.lane, wave = F.wave, tid = F.tid;
    {
        typedef float f32x2 __attribute__((ext_vector_type(2)));
        constexpr int GS = 392;
        LAS bf16* gbuf = (LAS bf16*)F.lds;
        const __amdgpu_buffer_rsrc_t rsw = __builtin_amdgcn_make_buffer_rsrc((void*)(KIN(9) + (size_t)l * CKW * CONVW), (short)0, CKW * CONVW * 4, 0x00020000);
        const __amdgpu_buffer_rsrc_t rsb = __builtin_amdgcn_make_buffer_rsrc((void*)(KIN(10) + (size_t)l * CONVW), (short)0, CONVW * 4, 0x00020000);
        float g6[6], b6[6];
#pragma unroll
        for (int k = 0; k < 3; ++k)
#pragma unroll
            for (int e = 0; e < 2; ++e) { g6[2 * k + e] = KIN(11)[l * CONVW + 128 * k + 2 * lane + e]; b6[2 * k + e] = KIN(12)[l * CONVW + 128 * k + 2 * lane + e]; }
        for (int hf = 0; hf < 2; ++hf) {
            const int sbase = s0 + 64 * hf - 15;
            for (int j0 = 0; j0 < 9; j0 += 3) {
                u32x4 va[3], vg[3];
#pragma unroll
                for (int jj = 0; jj < 3; ++jj) { const int i = tid + (j0 + jj) * NTHREADS, rr = i / 48, cp = i - rr * 48, sq = sbase + rr;
                    va[jj] = (u32x4){0u, 0u, 0u, 0u}; vg[jj] = va[jj];
                    if (i < 94 * 48 && sq >= 0 && sq < SEQ) { const bf16* pr = P + (size_t)(rb + sq) * D_IN + 256 + 8 * cp; va[jj] = *(const u32x4*)pr; vg[jj] = *(const u32x4*)(pr + CONVW); } }
#pragma unroll
                for (int jj = 0; jj < 3; ++jj) { const int i = tid + (j0 + jj) * NTHREADS, rr = i / 48, cp = i - rr * 48;
                    if (i < 94 * 48) { u32x4 o;
#pragma unroll
                        for (int d = 0; d < 4; ++d) o[d] = pk2(bflo(va[jj][d]) * fast_sigmoid(bflo(vg[jj][d])), bfhi(va[jj][d]) * fast_sigmoid(bfhi(vg[jj][d])));
                        *(LAS u32x4*)(gbuf + rr * GS + 8 * cp) = o; } }
            }
            __syncthreads();
            f32x2 o[3][8];
#pragma unroll
            for (int pg = 0; pg < 3; ++pg) {
                asm volatile("" ::: "memory");
                f32x2 w[31];
#pragma unroll
                for (int j = 0; j < 31; ++j) w[j] = __builtin_bit_cast(f32x2, __builtin_amdgcn_raw_buffer_load_b64(rsw, (unsigned)lane * 8u, (j * CONVW + 128 * pg) * 4, 0));
                const f32x2 bias = __builtin_bit_cast(f32x2, __builtin_amdgcn_raw_buffer_load_b64(rsb, (unsigned)lane * 8u, 128 * pg * 4, 0));
#pragma unroll
                for (int i = 0; i < 8; ++i) o[pg][i] = bias;
                const LAS unsigned* gp = (const LAS unsigned*)gbuf + (8 * wave) * (GS / 2) + 64 * pg + lane;
#pragma unroll
                for (int r = 0; r < 38; ++r) { const unsigned u = gp[r * (GS / 2)]; const f32x2 gl = {bflo(u), bfhi(u)};
#pragma unroll
                    for (int i = 0; i < 8; ++i) if (r - i >= 0 && r - i < 31) o[pg][i] = w[r - i] * gl + o[pg][i]; }
            }
#pragma unroll
            for (int i = 0; i < 8; ++i) { float sm = 0.f, q = 0.f;
#pragma unroll
                for (int pg = 0; pg < 3; ++pg) { sm += o[pg][i][0] + o[pg][i][1]; q += o[pg][i][0] * o[pg][i][0] + o[pg][i][1] * o[pg][i][1]; }
                sm = wave_sum(sm); q = wave_sum(q);
                const float mean = sm * (1.0f / CONVW), var = fmaxf(q * (1.0f / CONVW) - mean * mean, 0.f), rstd = 1.0f / sqrtf(var + EPS);
                unsigned* orow = (unsigned*)(MO + (size_t)(t0 + 64 * hf + 8 * wave + i) * D + 256);
#pragma unroll
                for (int pg = 0; pg < 3; ++pg) { const float o0 = silu_f((o[pg][i][0] - mean) * rstd * g6[2 * pg] + b6[2 * pg]), o1 = silu_f((o[pg][i][1] - mean) * rstd * g6[2 * pg + 1] + b6[2 * pg + 1]);
                    orow[64 * pg + lane] = pk2(o0, o1); } }
            __syncthreads();
        }
    }
    {
        constexpr int VS = 136;
        LAS bf16* vnT = (LAS bf16*)F.lds;
        float g6[6], b6[6];
#pragma unroll
        for (int k = 0; k < 3; ++k)
#pragma unroll
            for (int e = 0; e < 2; ++e) { g6[2 * k + e] = KIN(13)[l * CONVW + 128 * k + 2 * lane + e]; b6[2 * k + e] = KIN(14)[l * CONVW + 128 * k + 2 * lane + e]; }
        for (int rh = 0; rh < 2; ++rh) {
            unsigned raw[8][3];
#pragma unroll
            for (int r = 0; r < 8; ++r) { const unsigned* pv = (const unsigned*)(P + (size_t)(t0 + wave * 16 + rh * 8 + r) * D_IN + 1408);
#pragma unroll
                for (int k = 0; k < 3; ++k) raw[r][k] = pv[64 * k + lane]; }
#pragma unroll
            for (int r = 0; r < 8; ++r) { const int tk = wave * 16 + rh * 8 + r;
                float v[6]; float s = 0.f, q = 0.f;
#pragma unroll
                for (int k = 0; k < 3; ++k) { v[2 * k] = bflo(raw[r][k]); v[2 * k + 1] = bfhi(raw[r][k]); }
#pragma unroll
                for (int k = 0; k < 6; ++k) { s += v[k]; q += v[k] * v[k]; }
                s = wave_sum(s); q = wave_sum(q);
                const float mean = s * (1.0f / CONVW), var = fmaxf(q * (1.0f / CONVW) - mean * mean, 0.f), rstd = 1.0f / sqrtf(var + EPS);
#pragma unroll
                for (int k = 0; k < 3; ++k)
#pragma unroll
                    for (int e = 0; e < 2; ++e) vnT[(128 * k + 2 * lane + e) * VS + tk] = (bf16)f2bf((v[2 * k + e] - mean) * rstd * g6[2 * k + e] + b6[2 * k + e]);
            }
        }
        __syncthreads();
        const bf16* sw = (const bf16*)(KWS + WS_SGUW);
        const float* sb = KIN(16) + (size_t)l * NH * 128;
        for (int tile = wave; tile < 24; tile += 8) { const int hh = tile >> 2, pb = tile & 3;
            f32x16 acc0, acc1;
#pragma unroll
            for (int i = 0; i < 16; ++i) { acc0[i] = 0.f; acc1[i] = 0.f; }
            const bf16* Wh = sw + ((size_t)((l * NH + hh) * 128 + pb * 32 + (lane & 31))) * 128 + 8 * (lane >> 5);
            const LAS bf16* Vb = vnT + (hh * 64 + (lane & 31)) * VS + 8 * (lane >> 5);
            bf16x8 wf[8];
#pragma unroll
            for (int ks = 0; ks < 8; ++ks) wf[ks] = *(const bf16x8*)(Wh + ks * 16);
            const int p = pb * 32 + (lane & 31); const size_t row = (size_t)(t0 + p); const float bias = sb[hh * 128 + p];
            const bf16* up = P + row * D_IN + 1024 + hh * 64 + 4 * (lane >> 5);
            u32x2 uu[2][4];
#pragma unroll
            for (int dh = 0; dh < 2; ++dh)
#pragma unroll
                for (int a = 0; a < 4; ++a) uu[dh][a] = *(const u32x2*)(up + dh * 32 + 8 * a);
#pragma unroll
            for (int ks = 0; ks < 8; ++ks) { const bf16x8 v0 = *(const LAS bf16x8*)(Vb + ks * 16), v1 = *(const LAS bf16x8*)(Vb + 32 * VS + ks * 16);
                acc0 = __builtin_amdgcn_mfma_f32_32x32x16_bf16(v0, wf[ks], acc0, 0, 0, 0); acc1 = __builtin_amdgcn_mfma_f32_32x32x16_bf16(v1, wf[ks], acc1, 0, 0, 0); }
            bf16* op = MO + row * D + 640 + hh * 64 + 4 * (lane >> 5);
#pragma unroll
            for (int a = 0; a < 4; ++a) {
                { const unsigned u0 = uu[0][a].x, u1 = uu[0][a].y; u32x2 o; o.x = pk2(bflo(u0) * (acc0[4 * a + 0] + bias), bfhi(u0) * (acc0[4 * a + 1] + bias)); o.y = pk2(bflo(u1) * (acc0[4 * a + 2] + bias), bfhi(u1) * (acc0[4 * a + 3] + bias)); *(u32x2*)(op + 8 * a) = o; }
                { const unsigned u0 = uu[1][a].x, u1 = uu[1][a].y; u32x2 o; o.x = pk2(bflo(u0) * (acc1[4 * a + 0] + bias), bfhi(u0) * (acc1[4 * a + 1] + bias)); o.y = pk2(bflo(u1) * (acc1[4 * a + 2] + bias), bfhi(u1) * (acc1[4 * a + 3] + bias)); *(u32x2*)(op + 32 + 8 * a) = o; }
            }
        }
        __syncthreads();
    }
    {
        constexpr int AS = 264;
        constexpr int DS = 136;
        LAS bf16* abuf = (LAS bf16*)F.lds;
        LAS bf16* dbuf = (LAS bf16*)(F.lds + 144 * AS * 2);
        { u32x4 st[9];
#pragma unroll
          for (int j = 0; j < 9; ++j) { const int i = tid + j * NTHREADS, rr = i >> 5, cp = i & 31; const int sq = s0 - 8 + rr; st[j] = (u32x4){0u, 0u, 0u, 0u};
              if (sq >= 0 && sq < SEQ) st[j] = *(const u32x4*)(P + (size_t)(rb + sq) * D_IN + 8 * cp); }
#pragma unroll
          for (int j = 0; j < 9; ++j) { const int i = tid + j * NTHREADS, rr = i >> 5, cp = i & 31; *(LAS u32x4*)(abuf + rr * AS + 8 * cp) = st[j]; } }
        __syncthreads();
        const bf16* pwt = (const bf16*)(KWS + WS_POOLW) + (size_t)l * 4 * 64 * 64;
        for (int gp = 0; gp < 2; ++gp) {
            { const int cc = tid & 127, run = tid >> 7, g = 2 * gp + (cc >> 6), half = 1 << g, ch = g * 64 + (cc & 63);
              const int tk0 = run * 32; float sum = 0.f;
              for (int j = -half; j < half; ++j) sum += bf2f(abuf[(tk0 + j + 8) * AS + ch]);
              for (int k = 0; k < 32; ++k) { const int tk = tk0 + k, sq = s0 + tk; int lo = sq - half; lo = lo < 0 ? 0 : lo; int hi = sq + half; hi = hi > SEQ ? SEQ : hi;
                  const float a = bf2f(abuf[(tk + 8) * AS + ch]);
                  dbuf[tk * DS + cc] = (bf16)f2bf(sum / (float)(hi - lo) - a);
                  sum += bf2f(abuf[(tk + half + 8) * AS + ch]) - bf2f(abuf[(tk - half + 8) * AS + ch]); } }
            __syncthreads();
            { const int fr = lane & 15, fq = lane >> 4;
#pragma unroll
              for (int gg = 0; gg < 2; ++gg) { const int g = 2 * gp + gg;
                  bf16x8 af[2];
#pragma unroll
                  for (int ks = 0; ks < 2; ++ks) af[ks] = *(const LAS bf16x8*)(dbuf + (wave * 16 + fr) * DS + gg * 64 + ks * 32 + 8 * fq);
                  bf16* op = MO + (size_t)(t0 + wave * 16 + fr) * D + g * 64 + 4 * fq;
#pragma unroll
                  for (int nt = 0; nt < 4; ++nt) { f32x4 acc = {0.f, 0.f, 0.f, 0.f};
#pragma unroll
                      for (int ks = 0; ks < 2; ++ks) { const bf16x8 wfr = *(const bf16x8*)(pwt + ((size_t)(g * 64 + nt * 16 + fr)) * 64 + ks * 32 + 8 * fq);
                          acc = __builtin_amdgcn_mfma_f32_16x16x32_bf16(wfr, af[ks], acc, 0, 0, 0); }
                      u32x2 o; o.x = pk2(acc[0], acc[1]); o.y = pk2(acc[2], acc[3]); *(u32x2*)(op + nt * 16) = o; } } }
            __syncthreads();
        }
    }
}

__global__ void __launch_bounds__(NTHREADS, 2) fwd_kernel(Args args) {
    extern __shared__ __attribute__((aligned(16))) unsigned char lds_raw[];
    Frame F;
    F.lds = (LAS unsigned char*)lds_raw;
    F.tid = threadIdx.x; F.lane = F.tid & 63; F.wave = __builtin_amdgcn_readfirstlane(F.tid >> 6); F.G = gridDim.x; F.bid = blockIdx.x;
    F.ka = (kargp_t)__builtin_amdgcn_kernarg_segment_ptr(); (void)args;
    for (int u = F.tid; u < (LDS_BYTES - LC_OFF) / 4; u += NTHREADS) ((LAS unsigned*)(F.lds + LC_OFF))[u] = 0u;
    __syncthreads();
    XcdBarrier bar = xcd_barrier_post((unsigned*)(KWS + WS_CTL) + CW_BAR, (volatile LAS unsigned*)(F.lds + LC_MISC) + 8);
#define GRID_BAR() xcd_barrier(bar)
#ifndef PROBE_DUP
#define PROBE_DUP 0
#endif
#define PROBE_REP(bit) for (int rep_ = 0; rep_ < ((PROBE_DUP & (bit)) ? 2 : 1); ++rep_)
#define MODL(l) (KMOD + (size_t)(l) * BATCH * NMOD)

    PROBE_REP(2 | 1024) { PHASE_ENTER(F); p0_prologue(F); GRID_BAR(); }

#define LAYER_MIX(l) \
    PROBE_REP(2) { PHASE_ENTER(F); if ((l) == 0) norm_phase<0, false>(F, KIN(0), KIN(4) + (l) * D, MODL(l) + 0 * D, MODL(l) + 1 * D, KH, nullptr); \
        else norm_phase<0, true>(F, KXB, KIN(4) + (l) * D, MODL(l) + 0 * D, MODL(l) + 1 * D, KH, nullptr); GRID_BAR(); } \
    PROBE_REP(8) { PHASE_ENTER(F); pg8::DenseOrder S; S.init(KH, (const bf16*)(KWS + WS_WIN) + (size_t)(l) * D_IN * D, M, D_IN, D, F.G, F.bid); \
        pg8::EpiBf16 E{KPROJ, D_IN, (PROBE_DUP & 256) ? rep_ : 0}; pg8::gemm_phase<pg8::EpiBf16, pg8::DenseOrder, false>(F.lds, D, S, E, nullptr, ((PROBE_DUP & 512) && rep_) ? 2 : 1); GRID_BAR(); } \
    PROBE_REP(1) { PHASE_ENTER(F); for (int u = F.bid; u < M / 128; u += F.G) mixer_unit(F, (l), u); GRID_BAR(); } \
    for (int rep_ = 0; rep_ < (((PROBE_DUP & 32) && (l) == 0) ? 2 : 1); ++rep_) { PHASE_ENTER(F); \
        pg8::DenseOrder S; S.init(KMIXED, (const bf16*)(KWS + WS_WOUT) + (size_t)(l) * D * D, M, D, D, F.G, F.bid); \
        if ((l) == 0) { pg8::EpiResidual<true> E{KIN(0), KXB, MODL(l) + 2 * D, 1.0f}; pg8::gemm_phase<pg8::EpiResidual<true>, pg8::DenseOrder, false>(F.lds, D, S, E); } \
        else { pg8::EpiResidual<false> E{KXB, KXB, MODL(l) + 2 * D, 1.0f}; pg8::gemm_phase<pg8::EpiResidual<false>, pg8::DenseOrder, false>(F.lds, D, S, E); } GRID_BAR(); }
#define MOE_PASS(p) \
    PROBE_REP(4 | 2048) { PHASE_ENTER(F); build_group_table(F, (p), 2 * FFE / 256); \
        pg8::MoeOrder S; S.tab = (const LAS int*)(F.lds + LC_GT); S.A = KH; S.Bt = (const bf16*)(KWS + WS_MWGU); S.bstride = (size_t)2 * FFE * D; S.list = (const int*)(KWS + WS_LIST) + (p) * LISTN; \
        S.K = D / 2; S.nN = 2 * FFE / 256; S.G = F.G; S.c = F.bid; S.gather = true; \
        pg8::EpiSwigluF8 E{(unsigned char*)KACT, FFE, (PROBE_DUP & 2048) ? rep_ : 0}; pg8::gemm_phase<pg8::EpiSwigluF8, pg8::MoeOrder, true, true>(F.lds, D / 2, S, E, (LAS u32x4*)(F.lds + LC_GOFF)); GRID_BAR(); } \
    { PHASE_ENTER(F); build_group_table(F, (p), D / 256); \
        pg8::MoeOrder S; S.tab = (const LAS int*)(F.lds + LC_GT); S.A = KACT; S.Bt = (const bf16*)(KWS + WS_MWD); S.bstride = (size_t)D * FFE; S.list = nullptr; \
        S.K = FFE / 2; S.nN = D / 256; S.G = F.G; S.c = F.bid; S.gather = false; \
        pg8::EpiMoeDown E{KXB, (const int*)(KWS + WS_LIST) + (p) * LISTN, (const float*)(KWS + WS_WGT) + (p) * LISTN, MODL(1) + 5 * D, 1.0f / (SC_A * SC_W), (bf16*)(KWS + WS_DUMP)}; \
        pg8::gemm_phase<pg8::EpiMoeDown, pg8::MoeOrder, false, true>(F.lds, FFE / 2, S, E); GRID_BAR(); \
        if (PROBE_DUP & 128) { pg8::EpiMoeDown E0 = E; E0.ascale = 0.f; pg8::gemm_phase<pg8::EpiMoeDown, pg8::MoeOrder, false, true>(F.lds, FFE / 2, S, E0); GRID_BAR(); } }

    LAYER_MIX(0)
    PROBE_REP(2) { PHASE_ENTER(F); norm_phase<0, true>(F, KXB, KIN(5), MODL(0) + 3 * D, MODL(0) + 4 * D, KH, nullptr); GRID_BAR(); }
    PROBE_REP(16) { PHASE_ENTER(F); pg8::DenseOrder S; S.init(KH, (const bf16*)(KWS + WS_WGU), M, 2 * FF, D, F.G, F.bid);
        pg8::EpiSwiglu E{KACT, FF}; pg8::gemm_phase<pg8::EpiSwiglu, pg8::DenseOrder, false>(F.lds, D, S, E); GRID_BAR(); }
    { PHASE_ENTER(F); pg8::DenseOrder S; S.init(KACT, (const bf16*)(KWS + WS_WD), M, D, FF, F.G, F.bid);
        pg8::EpiResidual<false> E{KXB, KXB, MODL(0) + 5 * D, 1.0f}; pg8::gemm_phase<pg8::EpiResidual<false>, pg8::DenseOrder, false>(F.lds, FF, S, E); GRID_BAR(); }
    if (PROBE_DUP & 64) { PHASE_ENTER(F); pg8::DenseOrder S; S.init(KACT, (const bf16*)(KWS + WS_WD), M, D, FF, F.G, F.bid);
        pg8::EpiResidual<false> E{KXB, KXB, MODL(0) + 5 * D, 0.0f}; pg8::gemm_phase<pg8::EpiResidual<false>, pg8::DenseOrder, false>(F.lds, FF, S, E); GRID_BAR(); }
    LAYER_MIX(1)
    PROBE_REP(2) { PHASE_ENTER(F); norm_phase<1, true>(F, KXB, KIN(5) + D, MODL(1) + 3 * D, MODL(1) + 4 * D, KH, nullptr); GRID_BAR();
        PHASE_ENTER(F); route_phase(F); GRID_BAR(); }
    MOE_PASS(0)
    MOE_PASS(1)
    { PHASE_ENTER(F); norm_phase<2, true>(F, KXB, KIN(26), nullptr, nullptr, nullptr, KOUT); }
}

extern "C" void kernel_launch(void* const* d_in, const int* in_sizes, int n_in, void* d_out, int out_size, void* d_ws, size_t ws_size, hipStream_t stream) {
    static int grid = 0;
    if (grid == 0) {
        if (n_in != 27 || in_sizes[0] != M * D || out_size != M * D || ws_size < WS_END) { fprintf(stderr, "kernel_launch: unexpected shapes (n_in %d, in0 %d, out %d, ws %zu < %zu); nothing launched\n", n_in, n_in > 0 ? in_sizes[0] : -1, out_size, ws_size, (size_t)WS_END); grid = -1; return; }
        int dev = 0, cus = 0, per_cu = 0;
        if (hipGetDevice(&dev) != hipSuccess || hipDeviceGetAttribute(&cus, hipDeviceAttributeMultiprocessorCount, dev) != hipSuccess) { grid = -1; return; }
        if (hipFuncSetAttribute((const void*)fwd_kernel, hipFuncAttributeMaxDynamicSharedMemorySize, LDS_BYTES) != hipSuccess) { fprintf(stderr, "kernel_launch: hipFuncSetAttribute failed\n"); grid = -1; return; }
        if (hipOccupancyMaxActiveBlocksPerMultiprocessor(&per_cu, (const void*)fwd_kernel, NTHREADS, LDS_BYTES) != hipSuccess || per_cu < 1) { fprintf(stderr, "kernel_launch: occupancy query says %d blocks per CU\n", per_cu); }
        (void)hipGetLastError();
        grid = cus;
    }
    if (grid < 0) return;
    if (hipMemsetAsync((char*)d_ws + WS_CTL, 0, CTL_ZERO_BYTES, stream) != hipSuccess) return;
    Args a{};
    for (int i = 0; i < 27; ++i) a.in[i] = (const float*)d_in[i];
    a.out = (float*)d_out; a.ws = (unsigned char*)d_ws;
    hipLaunchKernelGGL(fwd_kernel, dim3(grid), dim3(NTHREADS), LDS_BYTES, stream, a);
}
```

```cpp
#include <hip/hip_runtime.h>
#include <cstdio>
#include <cstdint>

#define GAS __attribute__((address_space(1)))
#define LAS __attribute__((address_space(3)))
typedef unsigned short bf16;
typedef short bf16x8 __attribute__((ext_vector_type(8)));
typedef float f32x4 __attribute__((ext_vector_type(4)));
typedef float f32x16 __attribute__((ext_vector_type(16)));
typedef unsigned u32x4 __attribute__((ext_vector_type(4)));
typedef unsigned u32x2 __attribute__((ext_vector_type(2)));
typedef int i32x4 __attribute__((ext_vector_type(4)));
typedef int i32x8 __attribute__((ext_vector_type(8)));
constexpr float SC_W = 256.0f, SC_H = 16.0f, SC_A = 4.0f;

constexpr int NWAVES = 8, NTHREADS = 512;
constexpr int BATCH = 8, SEQ = 8192, D = 1024, M = BATCH * SEQ;
constexpr int D_IN = 1792, FF = 2816, FFE = 3584, NE = 8, NMOD = 6 * D;
constexpr int CONVW = 384, CKW = 31, NH = 6;
constexpr float EPS = 1e-6f;
constexpr int LISTN = M + NE * 256;

constexpr size_t MiB = 1u << 20;
constexpr size_t WS_CTL = 0, CTL_ZERO_BYTES = 1 * MiB;
constexpr size_t WS_MOD = 1 * MiB;
constexpr size_t WS_HIST = 2 * MiB;
constexpr size_t WS_TOT = 2 * MiB + 65536;
constexpr size_t WS_DUMP = 2 * MiB + 131072;
constexpr size_t WS_REC = 3 * MiB;
constexpr size_t WS_LIST = 4 * MiB;
constexpr size_t WS_WGT = 5 * MiB;
constexpr size_t WS_SGUW = 6 * MiB;
constexpr size_t WS_POOLW = 6 * MiB + 524288;
constexpr size_t WS_WIN = 8 * MiB;
constexpr size_t WS_WOUT = 15 * MiB;
constexpr size_t WS_WGU = 19 * MiB;
constexpr size_t WS_WD = 30 * MiB;
constexpr size_t WS_MWGU = 36 * MiB;
constexpr size_t WS_MWD = 148 * MiB;
constexpr size_t WS_H = 204 * MiB;
constexpr size_t WS_BIG = 332 * MiB;
constexpr size_t WS_MIXED = WS_BIG + (size_t)M * D_IN * 2;
constexpr size_t WS_ACT_END = WS_BIG + (size_t)LISTN * FFE * 2;
constexpr size_t WS_XB = (WS_ACT_END + 255) / 256 * 256;
constexpr size_t WS_END = WS_XB + (size_t)M * D * 2;
static_assert(WS_MIXED + (size_t)M * D * 2 <= WS_ACT_END && (size_t)M * FF * 2 <= (size_t)LISTN * FFE * 2, "ws map");
constexpr int CW_BAR = 4096;

constexpr int RING_BYTES = 131072;
constexpr int LC_OFF = RING_BYTES;
constexpr int LC_MISC = LC_OFF;
constexpr int LC_HIST = LC_OFF + 64;
constexpr int LC_TOT = LC_OFF + 128;
constexpr int LC_PRE = LC_OFF + 192;
constexpr int LC_TBASE = LC_OFF + 256;
constexpr int LC_WCNT = LC_OFF + 320;
constexpr int LC_GT = LC_OFF + 1024;
constexpr int LC_GOFF = LC_OFF + 4096;
constexpr int LDS_BYTES = RING_BYTES + 4096 + 8192;

__device__ __forceinline__ unsigned f2bf(float f) { unsigned u = __builtin_bit_cast(unsigned, f); return (u + 0x7fffu + ((u >> 16) & 1u)) >> 16; }
__device__ __forceinline__ unsigned pk2(float lo, float hi) { return f2bf(lo) | (f2bf(hi) << 16); }
__device__ __forceinline__ float bf2f(unsigned b) { return __builtin_bit_cast(float, b << 16); }
__device__ __forceinline__ float bflo(unsigned u) { return __builtin_bit_cast(float, u << 16); }
__device__ __forceinline__ float bfhi(unsigned u) { return __builtin_bit_cast(float, u & 0xffff0000u); }
__device__ __forceinline__ float fast_sigmoid(float x) { return __builtin_amdgcn_rcpf(1.0f + __builtin_amdgcn_exp2f(-1.44269504089f * x)); }
__device__ __forceinline__ float silu_f(float x) { return x * fast_sigmoid(x); }
#define WS_SWZ(v, o) ((v) + __int_as_float(__builtin_amdgcn_ds_swizzle(__float_as_int(v), 0x1f | ((o) << 10))))
__device__ __forceinline__ float wave_sum(float v) {
    v = WS_SWZ(v, 1); v = WS_SWZ(v, 2); v = WS_SWZ(v, 4); v = WS_SWZ(v, 8); v = WS_SWZ(v, 16);
    return __int_as_float(__builtin_amdgcn_readlane(__float_as_int(v), 0)) + __int_as_float(__builtin_amdgcn_readlane(__float_as_int(v), 32));
}
__device__ __forceinline__ unsigned pk4_fp8(float a, float b, float c, float d) {
    a = __builtin_fminf(__builtin_fmaxf(a, -448.f), 448.f); b = __builtin_fminf(__builtin_fmaxf(b, -448.f), 448.f); c = __builtin_fminf(__builtin_fmaxf(c, -448.f), 448.f); d = __builtin_fminf(__builtin_fmaxf(d, -448.f), 448.f);
    unsigned w = 0; w = __builtin_amdgcn_cvt_pk_fp8_f32(a, b, w, false); w = __builtin_amdgcn_cvt_pk_fp8_f32(c, d, w, true); return w; }
#define LDS_WAIT() asm volatile("s_waitcnt lgkmcnt(0)" ::: "memory")

#define XB_TMO      128
#define XB_XCNT(j)  (256  + 64 * (j))
#define XB_XSUB(j)  (1280 + 64 * (j))
#define XB_XGEN(j)  (2304 + 64 * (j))
#define XB_TOP      3328
#define XB_TOPGEN   3392
#define XCD_BAR_WORDS 3456
#define XB_SPIN_CAP (1u << 18)
__device__ __forceinline__ unsigned xb_ld(unsigned* p)              { return __hip_atomic_load(p, __ATOMIC_RELAXED, __HIP_MEMORY_SCOPE_AGENT); }
__device__ __forceinline__ unsigned xb_add(unsigned* p, unsigned v) { return __hip_atomic_fetch_add(p, v, __ATOMIC_RELAXED, __HIP_MEMORY_SCOPE_AGENT); }
__device__ __forceinline__ unsigned xb_xcc_id() { return (unsigned)__builtin_amdgcn_s_getreg((3 << 11) | 20) & 0xFu; }
#define XB_SPIN(cond, bar) do { unsigned _sp = 0; while (cond) { __builtin_amdgcn_s_sleep(1); \
    if ((++_sp & 255u) == 0u) { if (xb_ld(&(bar)[XB_TMO])) break; if (_sp > XB_SPIN_CAP) { atomicAdd(&(bar)[XB_TMO], 1u); break; } } } } while (0)
struct XcdBarrier { unsigned* bar; unsigned x; volatile LAS unsigned* st; };
__device__ __forceinline__ XcdBarrier xcd_barrier_post(unsigned* bar, volatile LAS unsigned* st) {
    XcdBarrier b; b.bar = bar; b.x = xb_xcc_id(); b.st = st;
    if (threadIdx.x == 0) (void)xb_add(&bar[XB_XCNT(b.x)], 1u);
    return b;
}
__device__ __forceinline__ void xcd_barrier_complete(unsigned* bar, unsigned x, unsigned& nloc, unsigned& nx) {
    const unsigned G = gridDim.x * gridDim.y * gridDim.z;
    unsigned sum, cnt, mine, sp = 0u;
    for (;;) {
        sum = 0u; cnt = 0u; mine = 0u;
#pragma unroll
        for (unsigned j = 0; j < 16; ++j) { const unsigned c = xb_ld(&bar[XB_XCNT(j)]); sum += c; cnt += (c > 0u) ? 1u : 0u; mine = (j == x) ? c : mine; }
        if (sum == G) break;
        __builtin_amdgcn_s_sleep(1);
        if ((++sp & 255u) == 0u) { if (xb_ld(&bar[XB_TMO])) break; if (sp > XB_SPIN_CAP) { atomicAdd(&bar[XB_TMO], 1u); break; } }
    }
    nloc = mine > 0u ? mine : 1u; nx = cnt > 0u ? cnt : 1u;
}
__device__ __forceinline__ void xcd_barrier(const XcdBarrier& b) {
    asm volatile("s_waitcnt vmcnt(0)" ::: "memory");
    __syncthreads();
    if (threadIdx.x == 0) {
        unsigned* bar = b.bar;
        __builtin_amdgcn_s_waitcnt(0);
        unsigned nloc = b.st[0], nx = b.st[1];
        if (nloc == 0u) { xcd_barrier_complete(bar, b.x, nloc, nx); b.st[0] = nloc; b.st[1] = nx; }
        const unsigned old = xb_add(&bar[XB_XSUB(b.x)], 1u);
        const unsigned gen = old / nloc;
        if (old + 1u == (gen + 1u) * nloc) {
            __builtin_amdgcn_fence(__ATOMIC_RELEASE, "agent");
            asm volatile("s_waitcnt vmcnt(0)" ::: "memory");
            const unsigned og = xb_add(&bar[XB_TOP], 1u);
            const unsigned tg = og / nx;
            if (og + 1u == (tg + 1u) * nx) xb_add(&bar[XB_TOPGEN], 1u);
            else XB_SPIN(xb_ld(&bar[XB_TOPGEN]) == tg, bar);
            __builtin_amdgcn_fence(__ATOMIC_ACQUIRE, "agent");
            xb_add(&bar[XB_XGEN(b.x)], 1u);
            asm volatile("s_waitcnt vmcnt(0)" ::: "memory");
        } else {
            XB_SPIN(xb_ld(&bar[XB_XGEN(b.x)]) == gen, bar);
            __builtin_amdgcn_fence(__ATOMIC_ACQUIRE, "agent");
            asm volatile("s_waitcnt vmcnt(0)" ::: "memory");
        }
    }
    __syncthreads();
}

namespace pg8 {
constexpr int BM = 256, BK = 64, HALF = 128, HTB = HALF * BK * 2, STAGE_BYTES = 8 * HTB, NXCD = 8, WGM = 8;
__device__ __forceinline__ int lds_byte(int r, int c) { const int st = (r >> 4) * 2 + (c >> 5), rr = r & 15, cc = c & 31, ob = rr * 64 + cc * 2; return st * 1024 + (ob ^ (((ob >> 9) & 1) << 5)); }
__device__ __forceinline__ void stage_rc(int b, int& R, int& C) { const int st = b / 1024, sb = b % 1024, swz = sb ^ (((sb >> 9) & 1) << 5); R = (st >> 1) * 16 + swz / 64; C = (st & 1) * 32 + (swz % 64) / 2; }
__device__ __forceinline__ int perm32(int rho) { const int n = rho >> 4, i = rho & 15; return 8 * (i >> 2) + 4 * n + (i & 3); }
__device__ __forceinline__ unsigned cvt_pk_bf16(float lo, float hi) { unsigned r; asm volatile("v_cvt_pk_bf16_f32 %0, %1, %2" : "=v"(r) : "v"(lo), "v"(hi)); return r; }

struct Unit { int pm, pn, ex; };

__device__ __forceinline__ int xcd_remap(int wgid, int nwg) { const int q = nwg / NXCD, r = nwg % NXCD, xcd = wgid % NXCD, off = wgid / NXCD; return (xcd < r ? xcd * (q + 1) : r * (q + 1) + (xcd - r) * q) + off; }

struct DenseOrder {
    const bf16* A; const bf16* Bt; int K, nM, nN, nwg, G, c;
    __device__ __forceinline__ void init(const bf16* A_, const bf16* Bt_, int Mr, int N, int K_, int G_, int c_) { A = A_; Bt = Bt_; K = K_; nM = Mr / BM; nN = N / BM; nwg = nM * nN; G = G_; c = c_; }
    __device__ __forceinline__ bool next(int i, Unit& u) const {
        const long L = (long)i * G + c; if (L >= nwg) return false;
        const int wgid = xcd_remap((int)L, nwg);
        const int nig = WGM * nN, gid = wgid / nig, fm = gid * WGM, gsz = (nM - fm) < WGM ? (nM - fm) : WGM;
        u.pm = fm + ((wgid % nig) % gsz); u.pn = (wgid % nig) / gsz; u.ex = 0; return true;
    }
    __device__ __forceinline__ const char* a_ptr(const Unit& u) const { return (const char*)A + (size_t)u.pm * ((size_t)BM * K * 2); }
    __device__ __forceinline__ const char* b_ptr(const Unit& u) const { return (const char*)Bt + (size_t)u.pn * ((size_t)BM * K * 2); }
    __device__ __forceinline__ void rows_raw(const Unit&, int, unsigned (&)[2][2]) const {}
};
struct MoeOrder {
    const LAS int* tab; const bf16* A; const bf16* Bt; size_t bstride; const int* list; int K, nN, G, c; bool gather;
    int n5, adv;
    __device__ __forceinline__ bool next(int i, Unit& u) const {
        const int U = __builtin_amdgcn_readfirstlane(tab[1]), ng = __builtin_amdgcn_readfirstlane(tab[0]);
        long L;
        { const int head = adv * (G - n5);
          if (c >= n5) L = (i < adv) ? (long)i * (G - n5) + (c - n5) : (long)head + (long)(i - adv) * G + c;
          else L = (long)head + (long)i * G + c; }
        if (L >= U) return false;
        const int wgid = xcd_remap((int)L, U);
        int g = 0, hi = ng;
        while (hi - g > 1) { const int mid = (g + hi) >> 1; const int v = __builtin_amdgcn_readfirstlane(tab[64 + mid]); if (v <= wgid) g = mid; else hi = mid; }
        const int g0 = __builtin_amdgcn_readfirstlane(tab[64 + g]), t0 = __builtin_amdgcn_readfirstlane(tab[128 + g]), gsz = __builtin_amdgcn_readfirstlane(tab[192 + g]), ex = __builtin_amdgcn_readfirstlane(tab[256 + g]);
        const int local = wgid - g0;
        u.pm = t0 + local % gsz; u.pn = local / gsz; u.ex = ex; return true;
    }
    __device__ __forceinline__ const char* a_ptr(const Unit& u) const { return gather ? (const char*)A : (const char*)A + (size_t)u.pm * ((size_t)BM * K * 2); }
    __device__ __forceinline__ const char* b_ptr(const Unit& u) const { return (const char*)Bt + (size_t)u.ex * bstride + (size_t)u.pn * ((size_t)BM * K * 2); }
    __device__ __forceinline__ void rows_raw(const Unit& u, int tid, unsigned (&raw)[2][2]) const {
        asm volatile("" : "+v"(tid));
        const __amdgpu_buffer_rsrc_t rs = __builtin_amdgcn_make_buffer_rsrc((void*)(list + (size_t)u.pm * BM), (short)0, BM * 4, 0x00020000);
#pragma unroll
        for (int i = 0; i < 2; ++i) { int R, C; stage_rc(tid * 16 + i * 8192, R, C);
#pragma unroll
            for (int h = 0; h < 2; ++h) raw[h][i] = (unsigned)__builtin_amdgcn_raw_buffer_load_b32(rs, (unsigned)(h * HALF + R) * 4u, 0, 0); }
    }
};

struct EpiBf16 {
    static constexpr bool PERM = true;
    bf16* O; int ldc; int skip;
    __device__ __forceinline__ void operator()(const f32x4 (&acc)[2][2][4][2], const Unit& u, int wr, int wc, int fr, int fq) const {
        const int row0 = u.pm * BM + wr * 64 + fr, col0 = u.pn * BM + wc * 32 + 8 * fq;
        if (skip) { if (acc[0][0][0][0][0] == 12345.678f) O[0] = 1; return; }
#pragma unroll
        for (int ai = 0; ai < 2; ++ai)
#pragma unroll
            for (int m = 0; m < 4; ++m) { bf16* rowp = O + (size_t)(row0 + ai * HALF + m * 16) * ldc + col0;
#pragma unroll
                for (int bj = 0; bj < 2; ++bj) { const f32x4 v0 = acc[ai][bj][m][0], v1 = acc[ai][bj][m][1];
                    u32x4 w; w.x = cvt_pk_bf16(v0[0], v0[1]); w.y = cvt_pk_bf16(v0[2], v0[3]); w.z = cvt_pk_bf16(v1[0], v1[1]); w.w = cvt_pk_bf16(v1[2], v1[3]);
                    *(u32x4*)(rowp + bj * HALF) = w; } }
    }
};
struct EpiSwiglu {
    static constexpr bool PERM = true;
    bf16* O; int ldc;
    __device__ __forceinline__ void operator()(const f32x4 (&acc)[2][2][4][2], const Unit& u, int wr, int wc, int fr, int fq) const {
        const int row0 = u.pm * BM + wr * 64 + fr, col0 = u.pn * HALF + wc * 32 + 8 * fq;
        typedef float f32x2 __attribute__((ext_vector_type(2)));
        bf16* base = O + (size_t)row0 * ldc + col0;
#pragma unroll
        for (int ai = 0; ai < 2; ++ai)
#pragma unroll
            for (int m = 0; m < 4; ++m) { bf16* rowp = base + (size_t)(ai * HALF + m * 16) * ldc;
                float o[8];
#pragma unroll
                for (int n = 0; n < 2; ++n)
#pragma unroll
                    for (int j = 0; j < 4; j += 2) { const f32x2 g = {acc[ai][0][m][n][j], acc[ai][0][m][n][j + 1]}, up = {acc[ai][1][m][n][j], acc[ai][1][m][n][j + 1]};
                        const f32x2 t = g * -1.44269504089f; f32x2 r; r.x = __builtin_amdgcn_rcpf(1.0f + __builtin_amdgcn_exp2f(t.x)); r.y = __builtin_amdgcn_rcpf(1.0f + __builtin_amdgcn_exp2f(t.y));
                        const f32x2 v = (g * r) * up; o[n * 4 + j] = v.x; o[n * 4 + j + 1] = v.y; }
                u32x4 w; w.x = cvt_pk_bf16(o[0], o[1]); w.y = cvt_pk_bf16(o[2], o[3]); w.z = cvt_pk_bf16(o[4], o[5]); w.w = cvt_pk_bf16(o[6], o[7]);
                *(u32x4*)rowp = w; }
    }
};
struct EpiSwigluF8 {
    static constexpr bool PERM = true;
    unsigned char* O; int ldc; int skip;
    __device__ __forceinline__ void operator()(const f32x4 (&acc)[2][2][4][2], const Unit& u, int wr, int wc, int fr, int fq) const {
        const int row0 = u.pm * BM + wr * 64 + fr, col0 = u.pn * HALF + wc * 32 + 8 * fq;
        if (skip) { if (acc[0][0][0][0][0] == 12345.678f) O[0] = 1; return; }
        constexpr float si = 1.0f / (SC_H * SC_W), k1 = -1.44269504089f * si, k2 = si * si * SC_A;
        typedef float f32x2 __attribute__((ext_vector_type(2)));
        unsigned char* base = O + (size_t)row0 * ldc + col0;
#pragma unroll
        for (int ai = 0; ai < 2; ++ai)
#pragma unroll
            for (int m = 0; m < 4; ++m) { unsigned char* rowp = base + (size_t)(ai * HALF + m * 16) * ldc;
                float o[8];
#pragma unroll
                for (int n = 0; n < 2; ++n)
#pragma unroll
                    for (int j = 0; j < 4; j += 2) { const f32x2 g = {acc[ai][0][m][n][j], acc[ai][0][m][n][j + 1]}, up = {acc[ai][1][m][n][j], acc[ai][1][m][n][j + 1]};
                        const f32x2 t = g * k1; f32x2 r; r.x = __builtin_amdgcn_rcpf(1.0f + __builtin_amdgcn_exp2f(t.x)); r.y = __builtin_amdgcn_rcpf(1.0f + __builtin_amdgcn_exp2f(t.y));
                        const f32x2 v = (g * r) * (up * k2);
                        o[n * 4 + j] = __builtin_amdgcn_fmed3f(v.x, -448.f, 448.f); o[n * 4 + j + 1] = __builtin_amdgcn_fmed3f(v.y, -448.f, 448.f); }
                u32x2 w; unsigned t0 = 0, t1 = 0;
                t0 = __builtin_amdgcn_cvt_pk_fp8_f32(o[0], o[1], t0, false); t0 = __builtin_amdgcn_cvt_pk_fp8_f32(o[2], o[3], t0, true);
                t1 = __builtin_amdgcn_cvt_pk_fp8_f32(o[4], o[5], t1, false); t1 = __builtin_amdgcn_cvt_pk_fp8_f32(o[6], o[7], t1, true);
                w.x = t0; w.y = t1; *(u32x2*)rowp = w; }
    }
};
template <bool XF32> struct EpiResidual {
    static constexpr bool PERM = true;
    const void* xin; bf16* out; const float* gate; float gs;
    __device__ __forceinline__ void operator()(const f32x4 (&acc)[2][2][4][2], const Unit& u, int wr, int wc, int fr, int fq) const {
        const int row0 = u.pm * BM + wr * 64 + fr, col0 = u.pn * BM + wc * 32 + 8 * fq, b = u.pm >> 5;
        f32x4 gv[2][2];
#pragma unroll
        for (int bj = 0; bj < 2; ++bj)
#pragma unroll
            for (int n = 0; n < 2; ++n) gv[bj][n] = *(const f32x4*)(gate + (size_t)b * NMOD + col0 + bj * HALF + n * 4) * gs;
#pragma unroll
        for (int ai = 0; ai < 2; ++ai) {
            if (XF32) { f32x4 xs[4][2][2];
#pragma unroll
                for (int m = 0; m < 4; ++m)
#pragma unroll
                    for (int bj = 0; bj < 2; ++bj) { const float* p = (const float*)xin + (size_t)(row0 + ai * HALF + m * 16) * D + col0 + bj * HALF; xs[m][bj][0] = *(const f32x4*)p; xs[m][bj][1] = *(const f32x4*)(p + 4); }
#pragma unroll
                for (int m = 0; m < 4; ++m)
#pragma unroll
                    for (int bj = 0; bj < 2; ++bj) { const f32x4 r0 = xs[m][bj][0] + gv[bj][0] * acc[ai][bj][m][0], r1 = xs[m][bj][1] + gv[bj][1] * acc[ai][bj][m][1];
                        u32x4 w; w.x = cvt_pk_bf16(r0[0], r0[1]); w.y = cvt_pk_bf16(r0[2], r0[3]); w.z = cvt_pk_bf16(r1[0], r1[1]); w.w = cvt_pk_bf16(r1[2], r1[3]);
                        *(u32x4*)(out + (size_t)(row0 + ai * HALF + m * 16) * D + col0 + bj * HALF) = w; }
            } else { u32x4 xr[4][2];
#pragma unroll
                for (int m = 0; m < 4; ++m)
#pragma unroll
                    for (int bj = 0; bj < 2; ++bj) xr[m][bj] = *(const u32x4*)((const bf16*)xin + (size_t)(row0 + ai * HALF + m * 16) * D + col0 + bj * HALF);
#pragma unroll
                for (int m = 0; m < 4; ++m)
#pragma unroll
                    for (int bj = 0; bj < 2; ++bj) { const u32x4 t = xr[m][bj];
                        const f32x4 x0 = {bflo(t.x), bfhi(t.x), bflo(t.y), bfhi(t.y)}, x1 = {bflo(t.z), bfhi(t.z), bflo(t.w), bfhi(t.w)};
                        const f32x4 r0 = x0 + gv[bj][0] * acc[ai][bj][m][0], r1 = x1 + gv[bj][1] * acc[ai][bj][m][1];
                        u32x4 w; w.x = cvt_pk_bf16(r0[0], r0[1]); w.y = cvt_pk_bf16(r0[2], r0[3]); w.z = cvt_pk_bf16(r1[0], r1[1]); w.w = cvt_pk_bf16(r1[2], r1[3]);
                        *(u32x4*)(out + (size_t)(row0 + ai * HALF + m * 16) * D + col0 + bj * HALF) = w; }
            }
            asm volatile("" ::: "memory");
        }
    }
};
struct EpiMoeDown {
    static constexpr bool PERM = true;
    bf16* out; const int* list; const float* wgt; const float* gate; float ascale; bf16* dump;
    __device__ __forceinline__ void operator()(const f32x4 (&acc)[2][2][4][2], const Unit& u, int wr, int wc, int fr, int fq) const {
        const int pos0 = u.pm * BM + wr * 64 + fr, col0 = u.pn * BM + wc * 32 + 8 * fq;
        int tk[2][4]; float w[2][4];
#pragma unroll
        for (int ai = 0; ai < 2; ++ai)
#pragma unroll
            for (int m = 0; m < 4; ++m) { const int pos = pos0 + ai * HALF + m * 16; tk[ai][m] = list[pos]; w[ai][m] = wgt[pos] * ascale; }
#pragma unroll
        for (int aq = 0; aq < 4; ++aq) {
            const int ai = aq >> 1, mb = (aq & 1) * 2;
            u32x4 xr[2][2]; f32x4 gq[2][2][2]; bf16* orow[2];
#pragma unroll
            for (int mm = 0; mm < 2; ++mm) { const int t = tk[ai][mb + mm]; orow[mm] = (t >= 0 ? out + (size_t)t * D : dump) + col0; const float* gp = gate + (size_t)(t >= 0 ? (t >> 13) : 0) * NMOD + col0;
#pragma unroll
                for (int bj = 0; bj < 2; ++bj) { xr[mm][bj] = *(const u32x4*)(orow[mm] + bj * HALF); gq[mm][bj][0] = *(const f32x4*)(gp + bj * HALF); gq[mm][bj][1] = *(const f32x4*)(gp + bj * HALF + 4); } }
#pragma unroll
            for (int mm = 0; mm < 2; ++mm)
#pragma unroll
                for (int bj = 0; bj < 2; ++bj) { const u32x4 t = xr[mm][bj]; const float ww = w[ai][mb + mm];
                    const f32x4 x0 = {bflo(t.x), bfhi(t.x), bflo(t.y), bfhi(t.y)}, x1 = {bflo(t.z), bfhi(t.z), bflo(t.w), bfhi(t.w)};
                    const f32x4 r0 = x0 + (gq[mm][bj][0] * ww) * acc[ai][bj][mb + mm][0], r1 = x1 + (gq[mm][bj][1] * ww) * acc[ai][bj][mb + mm][1];
                    u32x4 o; o.x = cvt_pk_bf16(r0[0], r0[1]); o.y = cvt_pk_bf16(r0[2], r0[3]); o.z = cvt_pk_bf16(r1[0], r1[1]); o.w = cvt_pk_bf16(r1[2], r1[3]);
                    *(u32x4*)(orow[mm] + bj * HALF) = o; }
            asm volatile("" ::: "memory");
        }
    }
};

template <class Epi, class Sched, bool GATHER, bool FP8 = false>
__device__ __forceinline__ void gemm_phase(LAS unsigned char* lds, const int K, const Sched& S, const Epi& E, LAS u32x4* goff = nullptr, int ntdiv = 1) {
    int tid_ = threadIdx.x; asm volatile("" : "+v"(tid_));
    const int tid = tid_, wid = __builtin_amdgcn_readfirstlane(tid >> 6), lane = tid & 63, wr = wid >> 2, wc = wid & 3, fr = lane & 15, fq = lane >> 4;
    int nt = K / BK / ntdiv; asm volatile("" : "+s"(nt));
    unsigned voffB[2], ao[2][2], no[2][2];
    const size_t kstep = (size_t)(BK * 2);
    const size_t hstep = (size_t)HALF * K * 2;
#pragma unroll
    for (int i = 0; i < 2; ++i) { int R, C; stage_rc(tid * 16 + i * 8192, R, C); const int Rb = Epi::PERM ? ((R & ~31) + perm32(R & 31)) : R;
        voffB[i] = (unsigned)(Rb * K + C) * 2u;
        ao[0][i] = (unsigned)(R * K + C) * 2u; ao[1][i] = ao[0][i] + (unsigned)hstep; no[0][i] = ao[0][i]; no[1][i] = ao[1][i]; }
    const unsigned ldsw = (unsigned)wid * 1024u;
    const int aoff = lds_byte(wr * 64 + fr, fq * 8), boff = lds_byte(wc * 32 + fr, fq * 8);
#define PG8_CB(i) ([&]() { int t_ = tid; asm volatile("" : "+v"(t_)); int R_, C_; stage_rc(t_ * 16 + (i) * 8192, R_, C_); return (unsigned)C_ * 2u; }())
#define PG8_SA(b, h) (((b) * 2 + (h)) * HTB)
#define PG8_SB(b, h) ((4 + (b) * 2 + (h)) * HTB)
#define PG8_STAGEB(bufoff, gbase) do { _Pragma("unroll") for (int _i = 0; _i < 2; ++_i) \
        __builtin_amdgcn_global_load_lds((const unsigned*)((const char*)(gbase) + voffB[_i]), (LAS unsigned*)(lds + (bufoff) + ldsw + _i * 8192), 16, 0, 0); } while (0)
#define PG8_STAGEA(bufoff, gbase, offs, h) do { _Pragma("unroll") for (int _i = 0; _i < 2; ++_i) \
        __builtin_amdgcn_global_load_lds((const unsigned*)((const char*)(gbase) + (offs)[h][_i]), (LAS unsigned*)(lds + (bufoff) + ldsw + _i * 8192), 16, 0, 0); } while (0)
#define PG8_LD32(p) __builtin_shufflevector(*(const LAS i32x4*)(p), *(const LAS i32x4*)((p) + 1024), 0, 1, 2, 3, 4, 5, 6, 7)
#define PG8_LDA(dst, b, h) do { _Pragma("unroll") for (int m = 0; m < 4; ++m) { if constexpr (FP8) dst##8[m] = PG8_LD32(lds + PG8_SA(b, h) + aoff + m * 2048); \
        else { _Pragma("unroll") for (int k = 0; k < 2; ++k) dst[m][k] = *(const LAS bf16x8*)(lds + PG8_SA(b, h) + aoff + m * 2048 + k * 1024); } } } while (0)
#define PG8_LDB(dst, b, h) do { _Pragma("unroll") for (int n = 0; n < 2; ++n) { if constexpr (FP8) dst##8[n] = PG8_LD32(lds + PG8_SB(b, h) + boff + n * 2048); \
        else { _Pragma("unroll") for (int k = 0; k < 2; ++k) dst[n][k] = *(const LAS bf16x8*)(lds + PG8_SB(b, h) + boff + n * 2048 + k * 1024); } } } while (0)
#define PG8_MMA(ai, bj, At, Bt) do { __builtin_amdgcn_s_setprio(1); _Pragma("unroll") for (int m = 0; m < 4; ++m) _Pragma("unroll") for (int n = 0; n < 2; ++n) { \
        if constexpr (FP8) asm volatile("v_mfma_scale_f32_16x16x128_f8f6f4 %0, %1, %2, %0, %3, %3 op_sel_hi:[0,0,0]" : "+v"(acc[ai][bj][m][n]) : "v"(Bt##8[n]), "v"(At##8[m]), "v"(sc1));     \
        else { _Pragma("unroll") for (int k = 0; k < 2; ++k) acc[ai][bj][m][n] = __builtin_amdgcn_mfma_f32_16x16x32_bf16(Bt[n][k], At[m][k], acc[ai][bj][m][n], 0, 0, 0); } } \
        __builtin_amdgcn_s_setprio(0); } while (0)
#define PG8_WAIT_V(n) asm volatile("s_waitcnt vmcnt(" #n ")" ::: "memory")
#define PG8_WAIT_L(n) asm volatile("s_waitcnt lgkmcnt(" #n ")" ::: "memory")
#define PG8_BAR __builtin_amdgcn_s_barrier()
#define PG8_SCHED __builtin_amdgcn_sched_barrier(0)
    Unit cur, nxt, nn; int ui = 0;
    if (!S.next(0, cur)) return;
    bool has_next = S.next(1, nxt);
    if constexpr (GATHER) {
        unsigned raw[2][2]; S.rows_raw(cur, tid, raw);
#pragma unroll
        for (int h = 0; h < 2; ++h)
#pragma unroll
            for (int i = 0; i < 2; ++i) ao[h][i] = (raw[h][i] & 0xffffffu) * (unsigned)(K * 2) + PG8_CB(i);
        if (has_next) { S.rows_raw(nxt, tid, raw);
#pragma unroll
            for (int h = 0; h < 2; ++h)
#pragma unroll
                for (int i = 0; i < 2; ++i) no[h][i] = (raw[h][i] & 0xffffffu) * (unsigned)(K * 2) + PG8_CB(i); }
        else {
#pragma unroll
            for (int h = 0; h < 2; ++h)
#pragma unroll
                for (int i = 0; i < 2; ++i) no[h][i] = ao[h][i]; }
        goff[tid] = (u32x4){no[0][0], no[0][1], no[1][0], no[1][1]};
    }
    f32x4 acc[2][2][4][2];
#pragma unroll
    for (int a = 0; a < 2; ++a)
#pragma unroll
        for (int b = 0; b < 2; ++b)
#pragma unroll
            for (int m = 0; m < 4; ++m)
#pragma unroll
                for (int n = 0; n < 2; ++n) acc[a][b][m][n] = (f32x4){0.f, 0.f, 0.f, 0.f};
    const int sc1 = 0x7f7f7f7f;
    bf16x8 At[4][2], B0[2][2], B1[2][2];
    i32x8 At8[4], B08[2], B18[2];
    const char* cA = S.a_ptr(cur); const char* cB = S.b_ptr(cur);
    PG8_STAGEB(PG8_SB(0, 0), cB); PG8_STAGEB(PG8_SB(0, 1), cB + hstep); PG8_STAGEA(PG8_SA(0, 0), cA, ao, 0); PG8_STAGEA(PG8_SA(0, 1), cA, ao, 1);
    if (wr == 1) PG8_BAR;
    PG8_WAIT_V(2); PG8_BAR;
    PG8_STAGEB(PG8_SB(1, 0), cB + kstep); PG8_STAGEA(PG8_SA(1, 0), cA + kstep, ao, 0); PG8_STAGEB(PG8_SB(1, 1), cB + hstep + kstep);
    PG8_WAIT_V(6); PG8_BAR;
    for (;;) {
        const char* nA = has_next ? S.a_ptr(nxt) : cA; const char* nB = has_next ? S.b_ptr(nxt) : cB;
#pragma clang loop unroll(disable)
        for (int t = 0; t < nt; t += 2) {
            const bool last = (t == nt - 2);
            const char* a1 = cA + (size_t)(t + 1) * kstep;
            const char* a2 = last ? nA : cA + (size_t)(t + 2) * kstep; const char* b2 = last ? nB : cB + (size_t)(t + 2) * kstep;
            const char* a3 = a2 + kstep; const char* b3 = b2 + kstep;
            asm volatile("" : "+v"(voffB[0]), "+v"(voffB[1]), "+v"(ao[0][0]), "+v"(ao[0][1]), "+v"(ao[1][0]), "+v"(ao[1][1]));
            PG8_LDB(B0, 0, 0); PG8_LDB(B1, 0, 1); PG8_SCHED; PG8_LDA(At, 0, 0); PG8_STAGEA(PG8_SA(1, 1), a1, ao, 1);
            if constexpr (GATHER) { if (last) { const u32x4 q = goff[tid]; ao[0][0] = q[0]; ao[0][1] = q[1]; ao[1][0] = q[2]; ao[1][1] = q[3]; } }
            PG8_WAIT_V(8); PG8_WAIT_L(0); PG8_BAR; PG8_MMA(0, 0, At, B0); PG8_MMA(0, 1, At, B1); PG8_BAR; PG8_SCHED;
            PG8_LDA(At, 0, 1); PG8_STAGEB(PG8_SB(0, 0), b2); PG8_STAGEB(PG8_SB(0, 1), b2 + hstep); PG8_STAGEA(PG8_SA(0, 0), a2, ao, 0);
            PG8_WAIT_V(8); PG8_WAIT_L(0); PG8_BAR; PG8_MMA(1, 0, At, B0); PG8_MMA(1, 1, At, B1); PG8_BAR; PG8_SCHED;
            PG8_LDB(B0, 1, 0); PG8_LDB(B1, 1, 1); PG8_SCHED; PG8_LDA(At, 1, 0); PG8_STAGEA(PG8_SA(0, 1), a2, ao, 1);
            PG8_WAIT_V(8); PG8_WAIT_L(0); PG8_BAR; PG8_MMA(0, 0, At, B0); PG8_MMA(0, 1, At, B1); PG8_BAR; PG8_SCHED;
            PG8_LDA(At, 1, 1); PG8_STAGEB(PG8_SB(1, 0), b3); PG8_STAGEB(PG8_SB(1, 1), b3 + hstep); PG8_STAGEA(PG8_SA(1, 0), a3, ao, 0);
            PG8_WAIT_V(8); PG8_WAIT_L(0); PG8_BAR; PG8_MMA(1, 0, At, B0); PG8_MMA(1, 1, At, B1); PG8_BAR; PG8_SCHED;
        }
        if (wr == 0) PG8_BAR;
        if constexpr (FP8) asm volatile("s_nop 15\n\ts_nop 15\n\ts_nop 7" ::: "memory");
        bool has_nn = false; unsigned raw[2][2];
        if (has_next) has_nn = S.next(ui + 2, nn);
        if constexpr (GATHER) { if (has_nn) S.rows_raw(nn, tid, raw); }
        E(acc, cur, wr, wc, fr, fq);
        if (!has_next) break;
#pragma unroll
        for (int a = 0; a < 2; ++a)
#pragma unroll
            for (int b = 0; b < 2; ++b)
#pragma unroll
                for (int m = 0; m < 4; ++m)
#pragma unroll
                    for (int n = 0; n < 2; ++n) acc[a][b][m][n] = (f32x4){0.f, 0.f, 0.f, 0.f};
        if constexpr (GATHER) {
            if (has_nn) { u32x4 q;
#pragma unroll
                for (int h = 0; h < 2; ++h)
#pragma unroll
                    for (int i = 0; i < 2; ++i) q[h * 2 + i] = (raw[h][i] & 0xffffffu) * (unsigned)(K * 2) + PG8_CB(i);
                goff[tid] = q; }
        }
        cur = nxt; cA = nA; cB = nB; nxt = nn; has_next = has_nn; ++ui;
        if (wr == 1) PG8_BAR;
    }
    PG8_WAIT_V(0);
    PG8_BAR;
#undef PG8_SA
#undef PG8_CB
#undef PG8_SB
#undef PG8_STAGEA
#undef PG8_STAGEB
#undef PG8_LDA
#undef PG8_LDB
#undef PG8_MMA
#undef PG8_LD32
#undef PG8_WAIT_V
#undef PG8_WAIT_L
#undef PG8_BAR
#undef PG8_SCHED
}
}

struct Args { const float* in[27]; float* out; unsigned char* ws; };
typedef const float* cfp_t;
typedef __attribute__((address_space(4))) const cfp_t* kargp_t;
struct Frame {
    LAS unsigned char* lds;
    int tid, lane, wave, G, bid;
    kargp_t ka;
};
#define PHASE_ENTER(F) do { kargp_t _p = (F).ka; asm volatile("" : "+s"(_p)); (F).ka = _p; \
    int _t = threadIdx.x; asm volatile("" : "+v"(_t)); (F).tid = _t; (F).lane = _t & 63; (F).wave = __builtin_amdgcn_readfirstlane(_t >> 6); \
    int _g = gridDim.x; asm volatile("" : "+s"(_g)); (F).G = _g; int _b = blockIdx.x; asm volatile("" : "+s"(_b)); (F).bid = _b; } while (0)
#define KIN(k) ((F).ka[k])
#define KOUT ((float*)(F).ka[27])
#define KWS ((unsigned char*)(F).ka[28])
#define KMOD ((float*)(KWS + WS_MOD))
#define KH ((bf16*)(KWS + WS_H))
#define KPROJ ((bf16*)(KWS + WS_BIG))
#define KMIXED ((bf16*)(KWS + WS_MIXED))
#define KACT ((bf16*)(KWS + WS_BIG))
#define KXB ((bf16*)(KWS + WS_XB))

__device__ __forceinline__ void p0_transpose_item(const float* W, int K, int N, bf16* WT, int dst_row0, LAS float* scr, int kb, int nb, int lane) {
    const int k0 = 64 * kb, n0 = 32 * nb;
    { f32x4 t[8];
#pragma unroll
      for (int i = 0; i < 8; ++i) t[i] = __builtin_nontemporal_load((const f32x4*)(W + (size_t)(k0 + 8 * i + (lane >> 3)) * N + n0 + 4 * (lane & 7)));
#pragma unroll
      for (int i = 0; i < 8; ++i) { LAS float* d = scr + (8 * i + (lane >> 3)) * 33 + 4 * (lane & 7); d[0] = t[i][0]; d[1] = t[i][1]; d[2] = t[i][2]; d[3] = t[i][3]; } }
    LDS_WAIT(); asm volatile("" ::: "memory");
    const int c = lane & 7;
#pragma unroll
    for (int j = 0; j < 4; ++j) { const int n = (lane >> 3) + 8 * j; const LAS float* s = scr + (8 * c) * 33 + n;
        u32x4 o; o.x = pk2(s[0 * 33], s[1 * 33]); o.y = pk2(s[2 * 33], s[3 * 33]); o.z = pk2(s[4 * 33], s[5 * 33]); o.w = pk2(s[6 * 33], s[7 * 33]);
        *(u32x4*)(WT + (size_t)(dst_row0 + n) * K + k0 + 8 * c) = o; }
    LDS_WAIT(); asm volatile("" ::: "memory");
}
__device__ __forceinline__ void p0_transpose_item_f8(const float* W, int K, int N, unsigned char* WT, int dst_row0, LAS float* scr, int kb, int nb, int lane) {
    const int k0 = 64 * kb, n0 = 32 * nb;
    { f32x4 t[8];
#pragma unroll
      for (int i = 0; i < 8; ++i) t[i] = __builtin_nontemporal_load((const f32x4*)(W + (size_t)(k0 + 8 * i + (lane >> 3)) * N + n0 + 4 * (lane & 7)));
#pragma unroll
      for (int i = 0; i < 8; ++i) { LAS float* d = scr + (8 * i + (lane >> 3)) * 33 + 4 * (lane & 7); d[0] = t[i][0]; d[1] = t[i][1]; d[2] = t[i][2]; d[3] = t[i][3]; } }
    LDS_WAIT(); asm volatile("" ::: "memory");
    const int n = lane >> 1, kh = (lane & 1) * 32; const LAS float* sp = scr + kh * 33 + n;
#pragma unroll
    for (int q = 0; q < 2; ++q) { u32x4 o;
#pragma unroll
        for (int d = 0; d < 4; ++d) { const int kk = q * 16 + d * 4; o[d] = pk4_fp8(sp[(kk + 0) * 33] * SC_W, sp[(kk + 1) * 33] * SC_W, sp[(kk + 2) * 33] * SC_W, sp[(kk + 3) * 33] * SC_W); }
        *(u32x4*)(WT + (size_t)(dst_row0 + n) * K + k0 + kh + q * 16) = o; }
    LDS_WAIT(); asm volatile("" ::: "memory");
}
__device__ __forceinline__ int gu_row(int n) { return (n >> 7) * 256 + (n & 127); }

__device__ __forceinline__ void p0_prologue(Frame& F) {
    if (F.bid < 192) {
        LAS float* cond = (LAS float*)F.lds;
        LAS float* red = (LAS float*)(F.lds + 32768);
        const float* cin = KIN(1);
        for (int i = F.tid; i < BATCH * D; i += NTHREADS) cond[i] = silu_f(cin[i]);
        __syncthreads();
        for (int item = F.bid; item < 192; item += F.G) {
            const int l = item / 96, colbase = (item % 96) * 64, col = colbase + F.lane;
            const float* W = KIN(2) + (size_t)l * D * NMOD;
            float a[8];
#pragma unroll
            for (int b = 0; b < 8; ++b) a[b] = 0.f;
            for (int k0 = F.wave * 128; k0 < F.wave * 128 + 128; k0 += 16) { float w[16];
#pragma unroll
                for (int i = 0; i < 16; ++i) w[i] = W[(size_t)(k0 + i) * NMOD + col];
#pragma unroll
                for (int i = 0; i < 16; ++i)
#pragma unroll
                    for (int b = 0; b < 8; ++b) a[b] = fmaf(cond[b * D + k0 + i], w[i], a[b]); }
#pragma unroll
            for (int b = 0; b < 8; ++b) red[(F.wave * 8 + b) * 64 + F.lane] = a[b];
            __syncthreads();
            { const int b = F.tid >> 6, cl = F.tid & 63; float s = 0.f;
#pragma unroll
              for (int w = 0; w < 8; ++w) s += red[(w * 8 + b) * 64 + cl];
              KMOD[((size_t)l * BATCH + b) * NMOD + colbase + cl] = s + KIN(3)[(size_t)l * NMOD + colbase + cl]; }
            __syncthreads();
        }
    }
    LAS float* scr = (LAS float*)(F.lds + F.wave * 16384);
    const int gw = F.bid * NWAVES + F.wave, NGW = F.G * NWAVES;
    constexpr int I_IN = 16 * 56, I_OUT = 16 * 32, I_FG = 16 * 88, I_FD = 44 * 32, I_MG = 16 * 112, I_MD = 56 * 32;
    constexpr int NITEMS = 2 * I_IN + 2 * I_OUT + 2 * I_FG + I_FD + 16 * I_MG + 8 * I_MD;
    bf16* ws_b = (bf16*)KWS;
    for (int it = gw; it < NITEMS; it += NGW) {
        int r = it;
        if (r < 2 * I_IN) { const int l = r / I_IN; r -= l * I_IN; const int kb = r / 56, nb = r % 56;
            p0_transpose_item(KIN(6) + (size_t)l * D * D_IN, D, D_IN, (bf16*)(KWS + WS_WIN) + (size_t)l * D_IN * D, 32 * nb, scr, kb, nb, F.lane); continue; } r -= 2 * I_IN;
        if (r < 2 * I_OUT) { const int l = r / I_OUT; r -= l * I_OUT; const int kb = r / 32, nb = r % 32;
            p0_transpose_item(KIN(17) + (size_t)l * D * D, D, D, (bf16*)(KWS + WS_WOUT) + (size_t)l * D * D, 32 * nb, scr, kb, nb, F.lane); continue; } r -= 2 * I_OUT;
        if (r < 2 * I_FG) { const int up = r / I_FG; r -= up * I_FG; const int kb = r / 88, nb = r % 88;
            p0_transpose_item(up ? KIN(19) : KIN(18), D, FF, (bf16*)(KWS + WS_WGU), gu_row(32 * nb) + 128 * up, scr, kb, nb, F.lane); continue; } r -= 2 * I_FG;
        if (r < I_FD) { const int kb = r / 32, nb = r % 32;
            p0_transpose_item(KIN(20), FF, D, (bf16*)(KWS + WS_WD), 32 * nb, scr, kb, nb, F.lane); continue; } r -= I_FD;
        if (r < 16 * I_MG) { const int q = r / I_MG; r -= q * I_MG; const int up = q >> 3, e = q & 7; const int kb = r / 112, nb = r % 112;
            p0_transpose_item_f8((up ? KIN(24) : KIN(23)) + (size_t)e * D * FFE, D, FFE, (unsigned char*)(KWS + WS_MWGU) + (size_t)e * 2 * FFE * D, gu_row(32 * nb) + 128 * up, scr, kb, nb, F.lane); continue; } r -= 16 * I_MG;
        { const int e = r / I_MD; r -= e * I_MD; const int kb = r / 32, nb = r % 32;
            p0_transpose_item_f8(KIN(25) + (size_t)e * FFE * D, FFE, D, (unsigned char*)(KWS + WS_MWD) + (size_t)e * D * FFE, 32 * nb, scr, kb, nb, F.lane); }
    }
    (void)ws_b;
    if (F.bid == 0) for (int i = F.tid; i < D; i += NTHREADS) ((float*)(KWS + WS_DUMP))[i] = 0.f;
    { bf16* pw = (bf16*)(KWS + WS_POOLW);
      for (int i = F.bid * NTHREADS + F.tid; i < 2 * 4 * 64 * 64; i += F.G * NTHREADS) { const int c = i & 63, d = (i >> 6) & 63, lg = i >> 12;
          pw[i] = (bf16)f2bf(KIN(7)[((size_t)lg * 64 + c) * 64 + d] * KIN(8)[lg * 64 + d]); } }
    { const float* sw = KIN(15); bf16* so = (bf16*)(KWS + WS_SGUW);
      for (int i = (F.bid * NTHREADS + F.tid) * 4; i < 2 * NH * 128 * 128; i += F.G * NTHREADS * 4) { const f32x4 v = *(const f32x4*)(sw + i); u32x2 o; o.x = pk2(v[0], v[1]); o.y = pk2(v[2], v[3]); *(u32x2*)(so + i) = o; } }
}

template <int MODE, bool SRCB>
__device__ __forceinline__ void norm_phase(Frame& F, const void* xsrc, const float* g, const float* shiftp, const float* scalep, bf16* hdst, float* fdst) {
    LAS int* lhist = (LAS int*)(F.lds + LC_HIST);
    for (int tb = F.bid; tb < M / 256; tb += F.G) {
        const int row0 = tb * 256 + F.wave * 32, b = row0 >> 13;
        f32x4 gm[4], sh[4];
#pragma unroll
        for (int j = 0; j < 4; ++j) { const int col = 4 * F.lane + 256 * j; const f32x4 gg = *(const f32x4*)(g + col);
            if (MODE == 2) { gm[j] = gg; sh[j] = (f32x4){0.f, 0.f, 0.f, 0.f}; }
            else { const f32x4 sc = *(const f32x4*)(scalep + (size_t)b * NMOD + col); gm[j] = gg * (1.0f + sc); sh[j] = *(const f32x4*)(shiftp + (size_t)b * NMOD + col); } }
        float rbias[8];
        LAS float* rwl = (LAS float*)F.lds;
        if (MODE == 1) {
            for (int i = F.tid; i < D * NE; i += NTHREADS) rwl[(i & 7) * D + (i >> 3)] = KIN(21)[i];
#pragma unroll
            for (int e = 0; e < 8; ++e) rbias[e] = KIN(22)[e];
            if (F.tid < 16) lhist[F.tid] = 0;
            __syncthreads();
        }
        for (int rq = 0; rq < 32; rq += 4) {
            f32x4 vv[4][4];
#pragma unroll
            for (int rr = 0; rr < 4; ++rr) { const int row = row0 + rq + rr;
                if (SRCB) { const u32x2* xr = (const u32x2*)((const bf16*)xsrc + (size_t)row * D) + F.lane;
#pragma unroll
                    for (int j = 0; j < 4; ++j) { const u32x2 t = xr[64 * j]; vv[rr][j] = (f32x4){bflo(t.x), bfhi(t.x), bflo(t.y), bfhi(t.y)}; } }
                else { const f32x4* xr = (const f32x4*)((const float*)xsrc + (size_t)row * D) + F.lane;
#pragma unroll
                    for (int j = 0; j < 4; ++j) vv[rr][j] = xr[64 * j]; } }
#pragma unroll
            for (int rr = 0; rr < 4; ++rr) {
            const int row = row0 + rq + rr;
            f32x4 v[4]; float ss = 0.f;
#pragma unroll
            for (int j = 0; j < 4; ++j) v[j] = vv[rr][j];
#pragma unroll
            for (int j = 0; j < 4; ++j) { ss += (v[j][0] * v[j][0] + v[j][1] * v[j][1]) + (v[j][2] * v[j][2] + v[j][3] * v[j][3]); }
            const float rstd = 1.0f / sqrtf(wave_sum(ss) * (1.0f / D) + EPS);
#pragma unroll
            for (int j = 0; j < 4; ++j) v[j] = (v[j] * rstd) * gm[j] + sh[j];
            if (MODE == 2) { f32x4* o = (f32x4*)(fdst + (size_t)row * D) + F.lane;
#pragma unroll
                for (int j = 0; j < 4; ++j) o[64 * j] = v[j]; }
            else if (MODE == 1) { unsigned* o = (unsigned*)((unsigned char*)hdst + (size_t)row * D) + F.lane;
#pragma unroll
                for (int j = 0; j < 4; ++j) o[64 * j] = pk4_fp8(v[j][0] * SC_H, v[j][1] * SC_H, v[j][2] * SC_H, v[j][3] * SC_H); }
            else { u32x2* o = (u32x2*)(hdst + (size_t)row * D) + F.lane;
#pragma unroll
                for (int j = 0; j < 4; ++j) { u32x2 w; w.x = pk2(v[j][0], v[j][1]); w.y = pk2(v[j][2], v[j][3]); o[64 * j] = w; } }
            if (MODE == 1) {
                float lg[8];
#pragma unroll
                for (int e = 0; e < 8; ++e) lg[e] = 0.f;
#pragma unroll
                for (int e = 0; e < 8; ++e)
#pragma unroll
                    for (int j = 0; j < 4; ++j) { const f32x4 wv = *(const LAS f32x4*)(rwl + e * D + 4 * F.lane + 256 * j);
                        lg[e] = fmaf(v[j][0], wv[0], lg[e]); lg[e] = fmaf(v[j][1], wv[1], lg[e]); lg[e] = fmaf(v[j][2], wv[2], lg[e]); lg[e] = fmaf(v[j][3], wv[3], lg[e]); }
#pragma unroll
                for (int e = 0; e < 8; ++e) lg[e] = wave_sum(lg[e]) + rbias[e];
                int i1 = 0; float v1 = lg[0];
#pragma unroll
                for (int e = 1; e < 8; ++e) if (lg[e] > v1) { v1 = lg[e]; i1 = e; }
                int i2 = -1; float v2 = -3.0e38f;
#pragma unroll
                for (int e = 0; e < 8; ++e) if (e != i1 && lg[e] > v2) { v2 = lg[e]; i2 = e; }
                const float ex = __expf(v2 - v1), w1 = 1.0f / (1.0f + ex), w2 = ex * w1;
                if (F.lane == 0) { u32x4 rec; rec.x = (unsigned)i1; rec.y = (unsigned)i2; rec.z = __float_as_uint(w1); rec.w = __float_as_uint(w2);
                    *(u32x4*)(KWS + WS_REC + (size_t)row * 16) = rec; __hip_atomic_fetch_add(&lhist[i1], 1, __ATOMIC_RELAXED, __HIP_MEMORY_SCOPE_WORKGROUP); __hip_atomic_fetch_add(&lhist[8 + i2], 1, __ATOMIC_RELAXED, __HIP_MEMORY_SCOPE_WORKGROUP); }
            }
        }
        }
        if (MODE == 1) { __syncthreads(); if (F.tid < 16) ((int*)(KWS + WS_HIST))[tb * 16 + F.tid] = lhist[F.tid]; __syncthreads(); }
    }
}

__device__ __forceinline__ void route_phase(Frame& F) {
    LAS int* ltot = (LAS int*)(F.lds + LC_TOT); LAS int* lpre = (LAS int*)(F.lds + LC_PRE); LAS int* ltb = (LAS int*)(F.lds + LC_TBASE); LAS int* lwc = (LAS int*)(F.lds + LC_WCNT);
    const int* hist = (const int*)(KWS + WS_HIST);
    int* list = (int*)(KWS + WS_LIST); float* wgt = (float*)(KWS + WS_WGT);
    for (int tb = F.bid; tb < M / 256; tb += F.G) {
        if (F.tid < 16) { ltot[F.tid] = 0; lpre[F.tid] = 0; }
        __syncthreads();
        { const int pe = F.tid & 15, part = F.tid >> 4; int sa = 0, sp = 0;
#pragma unroll
          for (int k = 0; k < 8; ++k) { const int t = part * 8 + k; const int v = hist[t * 16 + pe]; sa += v; sp += (t < tb) ? v : 0; }
          __hip_atomic_fetch_add(&ltot[pe], sa, __ATOMIC_RELAXED, __HIP_MEMORY_SCOPE_WORKGROUP); __hip_atomic_fetch_add(&lpre[pe], sp, __ATOMIC_RELAXED, __HIP_MEMORY_SCOPE_WORKGROUP); }
        __syncthreads();
        if (F.tid < 2) { int base = 0; for (int e = 0; e < 8; ++e) { ltb[F.tid * 8 + e] = base; base += (ltot[F.tid * 8 + e] + 255) >> 8; } }
        __syncthreads();
        unsigned e01[2] = {0u, 0u}; float w01[2] = {0.f, 0.f}; int rk[2] = {0, 0};
        if (F.tid < 256) {
            const u32x4 rec = *(const u32x4*)(KWS + WS_REC + (size_t)(tb * 256 + F.tid) * 16);
            e01[0] = rec.x; e01[1] = rec.y; w01[0] = __uint_as_float(rec.z); w01[1] = __uint_as_float(rec.w);
#pragma unroll
            for (int p = 0; p < 2; ++p)
#pragma unroll
                for (int ee = 0; ee < 8; ++ee) { const unsigned long long mk = __ballot(e01[p] == (unsigned)ee);
                    if (e01[p] == (unsigned)ee) rk[p] = __builtin_popcountll(mk & ((1ull << F.lane) - 1ull));
                    if (F.lane == 0) lwc[(p * 4 + F.wave) * 8 + ee] = __builtin_popcountll(mk); }
        }
        __syncthreads();
        if (F.tid < 256) {
#pragma unroll
            for (int p = 0; p < 2; ++p) { const int e = (int)e01[p]; int off = 0;
                for (int w = 0; w < F.wave; ++w) off += lwc[(p * 4 + w) * 8 + e];
                const int pos = ltb[p * 8 + e] * 256 + lpre[p * 8 + e] + off + rk[p];
                list[p * LISTN + pos] = tb * 256 + F.tid; wgt[p * LISTN + pos] = w01[p]; }
        }
        if (tb < 16) { const int p = tb >> 3, e = tb & 7; const int lo = ltb[tb] * 256 + ltot[tb], hi = (ltb[tb] + ((ltot[tb] + 255) >> 8)) * 256;
            for (int i = lo + F.tid; i < hi; i += NTHREADS) { list[p * LISTN + i] = (int)0x80000000u; wgt[p * LISTN + i] = 0.f; } (void)e; }
        if (tb == 0 && F.tid < 16) ((int*)(KWS + WS_TOT))[F.tid] = ltot[F.tid];
        __syncthreads();
    }
}
__device__ __forceinline__ void build_group_table(Frame& F, int p, int nN) {
    LAS int* tab = (LAS int*)(F.lds + LC_GT);
    __syncthreads();
    if (F.tid == 0) { const int* tot = (const int*)(KWS + WS_TOT) + p * 8; int ng = 0, ustart = 0, tile = 0;
        for (int e = 0; e < 8; ++e) { int tl = (tot[e] + 255) >> 8;
            while (tl > 0) { const int gsz = tl < 8 ? tl : 8; tab[64 + ng] = ustart; tab[128 + ng] = tile; tab[192 + ng] = gsz; tab[256 + ng] = e; ustart += gsz * nN; tile += gsz; tl -= gsz; ++ng; } }
        tab[0] = ng; tab[1] = ustart; }
    __syncthreads();
}

__device__ __forceinline__ void mixer_unit(Frame& F, const int l, const int unit, const int parts = 7) {
    const bf16* P = KPROJ; bf16* MO = KMIXED;
    const int t0 = unit * 128, s0 = t0 & (SEQ - 1), rb = t0 - s0;
    const int lane = F.lane, wave = F.wave, tid = F.tid;
    if (parts & 1) {
        typedef float f32x2 __attribute__((ext_vector_type(2)));
        constexpr int GS = 392;
        LAS bf16* gbuf = (LAS bf16*)F.lds;
        const __amdgpu_buffer_rsrc_t rsw = __builtin_amdgcn_make_buffer_rsrc((void*)(KIN(9) + (size_t)l * CKW * CONVW), (short)0, CKW * CONVW * 4, 0x00020000);
        const __amdgpu_buffer_rsrc_t rsb = __builtin_amdgcn_make_buffer_rsrc((void*)(KIN(10) + (size_t)l * CONVW), (short)0, CONVW * 4, 0x00020000);
        float g6[6], b6[6];
#pragma unroll
        for (int k = 0; k < 3; ++k)
#pragma unroll
            for (int e = 0; e < 2; ++e) { g6[2 * k + e] = KIN(11)[l * CONVW + 128 * k + 2 * lane + e]; b6[2 * k + e] = KIN(12)[l * CONVW + 128 * k + 2 * lane + e]; }
        for (int hf = 0; hf < 2; ++hf) {
            const int sbase = s0 + 64 * hf - 15;
            for (int j0 = 0; j0 < 9; j0 += 3) {
                u32x4 va[3], vg[3];
#pragma unroll
                for (int jj = 0; jj < 3; ++jj) { const int i = tid + (j0 + jj) * NTHREADS, rr = i / 48, cp = i - rr * 48, sq = sbase + rr;
                    va[jj] = (u32x4){0u, 0u, 0u, 0u}; vg[jj] = va[jj];
                    if (i < 94 * 48 && sq >= 0 && sq < SEQ) { const bf16* pr = P + (size_t)(rb + sq) * D_IN + 256 + 8 * cp; va[jj] = *(const u32x4*)pr; vg[jj] = *(const u32x4*)(pr + CONVW); } }
#pragma unroll
                for (int jj = 0; jj < 3; ++jj) { const int i = tid + (j0 + jj) * NTHREADS, rr = i / 48, cp = i - rr * 48;
                    if (i < 94 * 48) { u32x4 o;
#pragma unroll
                        for (int d = 0; d < 4; ++d) o[d] = pk2(bflo(va[jj][d]) * fast_sigmoid(bflo(vg[jj][d])), bfhi(va[jj][d]) * fast_sigmoid(bfhi(vg[jj][d])));
                        *(LAS u32x4*)(gbuf + rr * GS + 8 * cp) = o; } }
            }
            __syncthreads();
            f32x2 o[3][8];
#pragma unroll
            for (int pg = 0; pg < 3; ++pg) {
                asm volatile("" ::: "memory");
                f32x2 w[31];
#pragma unroll
                for (int j = 0; j < 31; ++j) w[j] = __builtin_bit_cast(f32x2, __builtin_amdgcn_raw_buffer_load_b64(rsw, (unsigned)lane * 8u, (j * CONVW + 128 * pg) * 4, 0));
                const f32x2 bias = __builtin_bit_cast(f32x2, __builtin_amdgcn_raw_buffer_load_b64(rsb, (unsigned)lane * 8u, 128 * pg * 4, 0));
#pragma unroll
                for (int i = 0; i < 8; ++i) o[pg][i] = bias;
                const LAS unsigned* gp = (const LAS unsigned*)gbuf + (8 * wave) * (GS / 2) + 64 * pg + lane;
#pragma unroll
                for (int r = 0; r < 38; ++r) { const unsigned u = gp[r * (GS / 2)]; const f32x2 gl = {bflo(u), bfhi(u)};
#pragma unroll
                    for (int i = 0; i < 8; ++i) if (r - i >= 0 && r - i < 31) o[pg][i] = w[r - i] * gl + o[pg][i]; }
            }
#pragma unroll
            for (int i = 0; i < 8; ++i) { float sm = 0.f, q = 0.f;
#pragma unroll
                for (int pg = 0; pg < 3; ++pg) { sm += o[pg][i][0] + o[pg][i][1]; q += o[pg][i][0] * o[pg][i][0] + o[pg][i][1] * o[pg][i][1]; }
                sm = wave_sum(sm); q = wave_sum(q);
                const float mean = sm * (1.0f / CONVW), var = fmaxf(q * (1.0f / CONVW) - mean * mean, 0.f), rstd = 1.0f / sqrtf(var + EPS);
                unsigned* orow = (unsigned*)(MO + (size_t)(t0 + 64 * hf + 8 * wave + i) * D + 256);
#pragma unroll
                for (int pg = 0; pg < 3; ++pg) { const float o0 = silu_f((o[pg][i][0] - mean) * rstd * g6[2 * pg] + b6[2 * pg]), o1 = silu_f((o[pg][i][1] - mean) * rstd * g6[2 * pg + 1] + b6[2 * pg + 1]);
                    orow[64 * pg + lane] = pk2(o0, o1); } }
            __syncthreads();
        }
    }
    if (parts & 2) {
        constexpr int VS = 136;
        LAS bf16* vnT = (LAS bf16*)F.lds;
        float g6[6], b6[6];
#pragma unroll
        for (int k = 0; k < 3; ++k)
#pragma unroll
            for (int e = 0; e < 2; ++e) { g6[2 * k + e] = KIN(13)[l * CONVW + 128 * k + 2 * lane + e]; b6[2 * k + e] = KIN(14)[l * CONVW + 128 * k + 2 * lane + e]; }
        for (int rh = 0; rh < 2; ++rh) {
            unsigned raw[8][3];
#pragma unroll
            for (int r = 0; r < 8; ++r) { const unsigned* pv = (const unsigned*)(P + (size_t)(t0 + wave * 16 + rh * 8 + r) * D_IN + 1408);
#pragma unroll
                for (int k = 0; k < 3; ++k) raw[r][k] = pv[64 * k + lane]; }
#pragma unroll
            for (int r = 0; r < 8; ++r) { const int tk = wave * 16 + rh * 8 + r;
                float v[6]; float s = 0.f, q = 0.f;
#pragma unroll
                for (int k = 0; k < 3; ++k) { v[2 * k] = bflo(raw[r][k]); v[2 * k + 1] = bfhi(raw[r][k]); }
#pragma unroll
                for (int k = 0; k < 6; ++k) { s += v[k]; q += v[k] * v[k]; }
                s = wave_sum(s); q = wave_sum(q);
                const float mean = s * (1.0f / CONVW), var = fmaxf(q * (1.0f / CONVW) - mean * mean, 0.f), rstd = 1.0f / sqrtf(var + EPS);
#pragma unroll
                for (int k = 0; k < 3; ++k)
#pragma unroll
                    for (int e = 0; e < 2; ++e) vnT[(128 * k + 2 * lane + e) * VS + tk] = (bf16)f2bf((v[2 * k + e] - mean) * rstd * g6[2 * k + e] + b6[2 * k + e]);
            }
        }
        __syncthreads();
        const bf16* sw = (const bf16*)(KWS + WS_SGUW);
        const float* sb = KIN(16) + (size_t)l * NH * 128;
        for (int tile = wave; tile < 24; tile += 8) { const int hh = tile >> 2, pb = tile & 3;
            f32x16 acc0, acc1;
#pragma unroll
            for (int i = 0; i < 16; ++i) { acc0[i] = 0.f; acc1[i] = 0.f; }
            const bf16* Wh = sw + ((size_t)((l * NH + hh) * 128 + pb * 32 + (lane & 31))) * 128 + 8 * (lane >> 5);
            const LAS bf16* Vb = vnT + (hh * 64 + (lane & 31)) * VS + 8 * (lane >> 5);
            bf16x8 wf[8];
#pragma unroll
            for (int ks = 0; ks < 8; ++ks) wf[ks] = *(const bf16x8*)(Wh + ks * 16);
            const int p = pb * 32 + (lane & 31); const size_t row = (size_t)(t0 + p); const float bias = sb[hh * 128 + p];
            const bf16* up = P + row * D_IN + 1024 + hh * 64 + 4 * (lane >> 5);
            u32x2 uu[2][4];
#pragma unroll
            for (int dh = 0; dh < 2; ++dh)
#pragma unroll
                for (int a = 0; a < 4; ++a) uu[dh][a] = *(const u32x2*)(up + dh * 32 + 8 * a);
#pragma unroll
            for (int ks = 0; ks < 8; ++ks) { const bf16x8 v0 = *(const LAS bf16x8*)(Vb + ks * 16), v1 = *(const LAS bf16x8*)(Vb + 32 * VS + ks * 16);
                acc0 = __builtin_amdgcn_mfma_f32_32x32x16_bf16(v0, wf[ks], acc0, 0, 0, 0); acc1 = __builtin_amdgcn_mfma_f32_32x32x16_bf16(v1, wf[ks], acc1, 0, 0, 0); }
            bf16* op = MO + row * D + 640 + hh * 64 + 4 * (lane >> 5);
#pragma unroll
            for (int a = 0; a < 4; ++a) {
                { const unsigned u0 = uu[0][a].x, u1 = uu[0][a].y; u32x2 o; o.x = pk2(bflo(u0) * (acc0[4 * a + 0] + bias), bfhi(u0) * (acc0[4 * a + 1] + bias)); o.y = pk2(bflo(u1) * (acc0[4 * a + 2] + bias), bfhi(u1) * (acc0[4 * a + 3] + bias)); *(u32x2*)(op + 8 * a) = o; }
                { const unsigned u0 = uu[1][a].x, u1 = uu[1][a].y; u32x2 o; o.x = pk2(bflo(u0) * (acc1[4 * a + 0] + bias), bfhi(u0) * (acc1[4 * a + 1] + bias)); o.y = pk2(bflo(u1) * (acc1[4 * a + 2] + bias), bfhi(u1) * (acc1[4 * a + 3] + bias)); *(u32x2*)(op + 32 + 8 * a) = o; }
            }
        }
        __syncthreads();
    }
    if (parts & 4) {
        constexpr int AS = 264;
        constexpr int DS = 136;
        LAS bf16* abuf = (LAS bf16*)F.lds;
        LAS bf16* dbuf = (LAS bf16*)(F.lds + 144 * AS * 2);
        { u32x4 st[9];
#pragma unroll
          for (int j = 0; j < 9; ++j) { const int i = tid + j * NTHREADS, rr = i >> 5, cp = i & 31; const int sq = s0 - 8 + rr; st[j] = (u32x4){0u, 0u, 0u, 0u};
              if (sq >= 0 && sq < SEQ) st[j] = *(const u32x4*)(P + (size_t)(rb + sq) * D_IN + 8 * cp); }
#pragma unroll
          for (int j = 0; j < 9; ++j) { const int i = tid + j * NTHREADS, rr = i >> 5, cp = i & 31; *(LAS u32x4*)(abuf + rr * AS + 8 * cp) = st[j]; } }
        __syncthreads();
        const bf16* pwt = (const bf16*)(KWS + WS_POOLW) + (size_t)l * 4 * 64 * 64;
        for (int gp = 0; gp < 2; ++gp) {
            { const int cc = tid & 127, run = tid >> 7, g = 2 * gp + (cc >> 6), half = 1 << g, ch = g * 64 + (cc & 63);
              const int tk0 = run * 32; float sum = 0.f;
              for (int j = -half; j < half; ++j) sum += bf2f(abuf[(tk0 + j + 8) * AS + ch]);
              for (int k = 0; k < 32; ++k) { const int tk = tk0 + k, sq = s0 + tk; int lo = sq - half; lo = lo < 0 ? 0 : lo; int hi = sq + half; hi = hi > SEQ ? SEQ : hi;
                  const float a = bf2f(abuf[(tk + 8) * AS + ch]);
                  dbuf[tk * DS + cc] = (bf16)f2bf(sum / (float)(hi - lo) - a);
                  sum += bf2f(abuf[(tk + half + 8) * AS + ch]) - bf2f(abuf[(tk - half + 8) * AS + ch]); } }
            __syncthreads();
            { const int fr = lane & 15, fq = lane >> 4;
#pragma unroll
              for (int gg = 0; gg < 2; ++gg) { const int g = 2 * gp + gg;
                  bf16x8 af[2];
#pragma unroll
                  for (int ks = 0; ks < 2; ++ks) af[ks] = *(const LAS bf16x8*)(dbuf + (wave * 16 + fr) * DS + gg * 64 + ks * 32 + 8 * fq);
                  bf16* op = MO + (size_t)(t0 + wave * 16 + fr) * D + g * 64 + 4 * fq;
#pragma unroll
                  for (int nt = 0; nt < 4; ++nt) { f32x4 acc = {0.f, 0.f, 0.f, 0.f};
#pragma unroll
                      for (int ks = 0; ks < 2; ++ks) { const bf16x8 wfr = *(const bf16x8*)(pwt + ((size_t)(g * 64 + nt * 16 + fr)) * 64 + ks * 32 + 8 * fq);
                          acc = __builtin_amdgcn_mfma_f32_16x16x32_bf16(wfr, af[ks], acc, 0, 0, 0); }
                      u32x2 o; o.x = pk2(acc[0], acc[1]); o.y = pk2(acc[2], acc[3]); *(u32x2*)(op + nt * 16) = o; } } }
            __syncthreads();
        }
    }
}

__global__ void __launch_bounds__(NTHREADS, 2) fwd_kernel(Args args) {
    extern __shared__ __attribute__((aligned(16))) unsigned char lds_raw[];
    Frame F;
    F.lds = (LAS unsigned char*)lds_raw;
    F.tid = threadIdx.x; F.lane = F.tid & 63; F.wave = __builtin_amdgcn_readfirstlane(F.tid >> 6); F.G = gridDim.x; F.bid = blockIdx.x;
    F.ka = (kargp_t)__builtin_amdgcn_kernarg_segment_ptr(); (void)args;
    for (int u = F.tid; u < (LDS_BYTES - LC_OFF) / 4; u += NTHREADS) ((LAS unsigned*)(F.lds + LC_OFF))[u] = 0u;
    __syncthreads();
    XcdBarrier bar = xcd_barrier_post((unsigned*)(KWS + WS_CTL) + CW_BAR, (volatile LAS unsigned*)(F.lds + LC_MISC) + 8);
#define GRID_BAR() xcd_barrier(bar)
#ifndef PROBE_DUP
#define PROBE_DUP 0
#endif
#ifndef PROBE_MXPARTS
#define PROBE_MXPARTS 7
#endif
#define PROBE_REP(bit) for (int rep_ = 0; rep_ < ((PROBE_DUP & (bit)) ? 2 : 1); ++rep_)
#define MODL(l) (KMOD + (size_t)(l) * BATCH * NMOD)

    PROBE_REP(2 | 1024) { PHASE_ENTER(F); p0_prologue(F); GRID_BAR(); }

#define LAYER_MIX(l) \
    PROBE_REP(2) { PHASE_ENTER(F); if ((l) == 0) norm_phase<0, false>(F, KIN(0), KIN(4) + (l) * D, MODL(l) + 0 * D, MODL(l) + 1 * D, KH, nullptr); \
        else norm_phase<0, true>(F, KXB, KIN(4) + (l) * D, MODL(l) + 0 * D, MODL(l) + 1 * D, KH, nullptr); GRID_BAR(); } \
    PROBE_REP(8) { PHASE_ENTER(F); pg8::DenseOrder S; S.init(KH, (const bf16*)(KWS + WS_WIN) + (size_t)(l) * D_IN * D, M, D_IN, D, F.G, F.bid); \
        pg8::EpiBf16 E{KPROJ, D_IN, (PROBE_DUP & 256) ? rep_ : 0}; pg8::gemm_phase<pg8::EpiBf16, pg8::DenseOrder, false>(F.lds, D, S, E, nullptr, ((PROBE_DUP & 512) && rep_) ? 2 : 1); GRID_BAR(); } \
    PROBE_REP(1) { PHASE_ENTER(F); for (int u = F.bid; u < M / 128; u += F.G) mixer_unit(F, (l), u, rep_ ? PROBE_MXPARTS : 7); GRID_BAR(); } \
    for (int rep_ = 0; rep_ < (((PROBE_DUP & 32) && (l) == 0) ? 2 : 1); ++rep_) { PHASE_ENTER(F); \
        pg8::DenseOrder S; S.init(KMIXED, (const bf16*)(KWS + WS_WOUT) + (size_t)(l) * D * D, M, D, D, F.G, F.bid); \
        if ((l) == 0) { pg8::EpiResidual<true> E{KIN(0), KXB, MODL(l) + 2 * D, 1.0f}; pg8::gemm_phase<pg8::EpiResidual<true>, pg8::DenseOrder, false>(F.lds, D, S, E); } \
        else { pg8::EpiResidual<false> E{KXB, KXB, MODL(l) + 2 * D, 1.0f}; pg8::gemm_phase<pg8::EpiResidual<false>, pg8::DenseOrder, false>(F.lds, D, S, E); } GRID_BAR(); }
#define KACT8(p) ((unsigned char*)(KWS + WS_BIG) + (size_t)(p) * LISTN * FFE)
#define MOE_GU(p, N5, ADV, BAR) \
    PROBE_REP(4 | 2048) { PHASE_ENTER(F); build_group_table(F, (p), 2 * FFE / 256); \
        pg8::MoeOrder S; S.tab = (const LAS int*)(F.lds + LC_GT); S.A = KH; S.Bt = (const bf16*)(KWS + WS_MWGU); S.bstride = (size_t)2 * FFE * D; S.list = (const int*)(KWS + WS_LIST) + (p) * LISTN; \
        S.K = D / 2; S.nN = 2 * FFE / 256; S.G = F.G; S.c = F.bid; S.gather = true; S.n5 = N5; S.adv = ADV; \
        pg8::EpiSwigluF8 E{KACT8(p), FFE, (PROBE_DUP & 2048) ? rep_ : 0}; pg8::gemm_phase<pg8::EpiSwigluF8, pg8::MoeOrder, true, true>(F.lds, D / 2, S, E, (LAS u32x4*)(F.lds + LC_GOFF)); if (BAR) GRID_BAR(); }
#define MOE_DOWN(p, BAR) \
    { PHASE_ENTER(F); build_group_table(F, (p), D / 256); \
        pg8::MoeOrder S; S.tab = (const LAS int*)(F.lds + LC_GT); S.A = (const bf16*)KACT8(p); S.Bt = (const bf16*)(KWS + WS_MWD); S.bstride = (size_t)D * FFE; S.list = nullptr; \
        S.K = FFE / 2; S.nN = D / 256; S.G = F.G; S.c = F.bid; S.gather = false; S.n5 = 0; S.adv = 0; \
        pg8::EpiMoeDown E{KXB, (const int*)(KWS + WS_LIST) + (p) * LISTN, (const float*)(KWS + WS_WGT) + (p) * LISTN, MODL(1) + 5 * D, 1.0f / (SC_A * SC_W), (bf16*)(KWS + WS_DUMP)}; \
        pg8::gemm_phase<pg8::EpiMoeDown, pg8::MoeOrder, false, true>(F.lds, FFE / 2, S, E); if (BAR) GRID_BAR(); \
        if (PROBE_DUP & 128) { pg8::EpiMoeDown E0 = E; E0.ascale = 0.f; pg8::gemm_phase<pg8::EpiMoeDown, pg8::MoeOrder, false, true>(F.lds, FFE / 2, S, E0); GRID_BAR(); } }

    LAYER_MIX(0)
    PROBE_REP(2) { PHASE_ENTER(F); norm_phase<0, true>(F, KXB, KIN(5), MODL(0) + 3 * D, MODL(0) + 4 * D, KH, nullptr); GRID_BAR(); }
    PROBE_REP(16) { PHASE_ENTER(F); pg8::DenseOrder S; S.init(KH, (const bf16*)(KWS + WS_WGU), M, 2 * FF, D, F.G, F.bid);
        pg8::EpiSwiglu E{KACT, FF}; pg8::gemm_phase<pg8::EpiSwiglu, pg8::DenseOrder, false>(F.lds, D, S, E); GRID_BAR(); }
    { PHASE_ENTER(F); pg8::DenseOrder S; S.init(KACT, (const bf16*)(KWS + WS_WD), M, D, FF, F.G, F.bid);
        pg8::EpiResidual<false> E{KXB, KXB, MODL(0) + 5 * D, 1.0f}; pg8::gemm_phase<pg8::EpiResidual<false>, pg8::DenseOrder, false>(F.lds, FF, S, E); GRID_BAR(); }
    if (PROBE_DUP & 64) { PHASE_ENTER(F); pg8::DenseOrder S; S.init(KACT, (const bf16*)(KWS + WS_WD), M, D, FF, F.G, F.bid);
        pg8::EpiResidual<false> E{KXB, KXB, MODL(0) + 5 * D, 0.0f}; pg8::gemm_phase<pg8::EpiResidual<false>, pg8::DenseOrder, false>(F.lds, FF, S, E); GRID_BAR(); }
    LAYER_MIX(1)
    PROBE_REP(2) { PHASE_ENTER(F); norm_phase<1, true>(F, KXB, KIN(5) + D, MODL(1) + 3 * D, MODL(1) + 4 * D, KH, nullptr); GRID_BAR();
        PHASE_ENTER(F); route_phase(F); GRID_BAR(); }
    MOE_GU(0, 0, 0, true)
    { int n5; { const int* tot = (const int*)(KWS + WS_TOT); int tl = 0; for (int e = 0; e < 8; ++e) tl += (tot[e] + 255) >> 8; n5 = (tl * (D / 256)) % F.G; n5 = (n5 + 7) & ~7; if (n5 >= F.G) n5 = 0; }
      MOE_DOWN(0, false)
      MOE_GU(1, n5, (n5 ? 3 : 0), true) }
    MOE_DOWN(1, true)
    if (PROBE_DUP & 4096) { for (int i = 0; i < 20; ++i) GRID_BAR(); }
    { PHASE_ENTER(F); norm_phase<2, true>(F, KXB, KIN(26), nullptr, nullptr, nullptr, KOUT); }
}

extern "C" void kernel_launch(void* const* d_in, const int* in_sizes, int n_in, void* d_out, int out_size, void* d_ws, size_t ws_size, hipStream_t stream) {
    static int grid = 0;
    if (grid == 0) {
        if (n_in != 27 || in_sizes[0] != M * D || out_size != M * D || ws_size < WS_END) { fprintf(stderr, "kernel_launch: unexpected shapes (n_in %d, in0 %d, out %d, ws %zu < %zu); nothing launched\n", n_in, n_in > 0 ? in_sizes[0] : -1, out_size, ws_size, (size_t)WS_END); grid = -1; return; }
        int dev = 0, cus = 0, per_cu = 0;
        if (hipGetDevice(&dev) != hipSuccess || hipDeviceGetAttribute(&cus, hipDeviceAttributeMultiprocessorCount, dev) != hipSuccess) { grid = -1; return; }
        if (hipFuncSetAttribute((const void*)fwd_kernel, hipFuncAttributeMaxDynamicSharedMemorySize, LDS_BYTES) != hipSuccess) { fprintf(stderr, "kernel_launch: hipFuncSetAttribute failed\n"); grid = -1; return; }
        if (hipOccupancyMaxActiveBlocksPerMultiprocessor(&per_cu, (const void*)fwd_kernel, NTHREADS, LDS_BYTES) != hipSuccess || per_cu < 1) { fprintf(stderr, "kernel_launch: occupancy query says %d blocks per CU\n", per_cu); }
        (void)hipGetLastError();
        grid = cus;
    }
    if (grid < 0) return;
    if (hipMemsetAsync((char*)d_ws + WS_CTL, 0, CTL_ZERO_BYTES, stream) != hipSuccess) return;
    Args a{};
    for (int i = 0; i < 27; ++i) a.in[i] = (const float*)d_in[i];
    a.out = (float*)d_out; a.ws = (unsigned char*)d_ws;
    hipLaunchKernelGGL(fwd_kernel, dim3(grid), dim3(NTHREADS), LDS_BYTES, stream, a);
}
```

```cpp
#include <hip/hip_runtime.h>
#include <cstdio>
#include <cstdint>

#define GAS __attribute__((address_space(1)))
#define LAS __attribute__((address_space(3)))
typedef unsigned short bf16;
typedef short bf16x8 __attribute__((ext_vector_type(8)));
typedef float f32x4 __attribute__((ext_vector_type(4)));
typedef float f32x16 __attribute__((ext_vector_type(16)));
typedef unsigned u32x4 __attribute__((ext_vector_type(4)));
typedef unsigned u32x2 __attribute__((ext_vector_type(2)));
typedef int i32x4 __attribute__((ext_vector_type(4)));
typedef int i32x8 __attribute__((ext_vector_type(8)));
constexpr float SC_W = 256.0f, SC_H = 16.0f, SC_A = 4.0f;

constexpr int NWAVES = 8, NTHREADS = 512;
constexpr int BATCH = 8, SEQ = 8192, D = 1024, M = BATCH * SEQ;
constexpr int D_IN = 1792, FF = 2816, FFE = 3584, NE = 8, NMOD = 6 * D;
constexpr int CONVW = 384, CKW = 31, NH = 6;
constexpr float EPS = 1e-6f;
constexpr int LISTN = M + NE * 256;

constexpr size_t MiB = 1u << 20;
constexpr size_t WS_CTL = 0, CTL_ZERO_BYTES = 1 * MiB;
constexpr size_t WS_MOD = 1 * MiB;
constexpr size_t WS_HIST = 2 * MiB;
constexpr size_t WS_TOT = 2 * MiB + 65536;
constexpr size_t WS_DUMP = 2 * MiB + 131072;
constexpr size_t WS_REC = 3 * MiB;
constexpr size_t WS_LIST = 4 * MiB;
constexpr size_t WS_WGT = 5 * MiB;
constexpr size_t WS_SGUW = 6 * MiB;
constexpr size_t WS_POOLW = 6 * MiB + 524288;
constexpr size_t WS_WIN = 8 * MiB;
constexpr size_t WS_WOUT = 15 * MiB;
constexpr size_t WS_WGU = 19 * MiB;
constexpr size_t WS_WD = 30 * MiB;
constexpr size_t WS_MWGU = 36 * MiB;
constexpr size_t WS_MWD = 148 * MiB;
constexpr size_t WS_H = 204 * MiB;
constexpr size_t WS_BIG = 332 * MiB;
constexpr size_t WS_MIXED = WS_BIG + (size_t)M * D_IN * 2;
constexpr size_t WS_ACT_END = WS_BIG + (size_t)LISTN * FFE * 2;
constexpr size_t WS_XB = (WS_ACT_END + 255) / 256 * 256;
constexpr size_t WS_END = WS_XB + (size_t)M * D * 2;
static_assert(WS_MIXED + (size_t)M * D * 2 <= WS_ACT_END && (size_t)M * FF * 2 <= (size_t)LISTN * FFE * 2, "ws map");
constexpr int CW_BAR = 4096;

constexpr int RING_BYTES = 131072;
constexpr int LC_OFF = RING_BYTES;
constexpr int LC_MISC = LC_OFF;
constexpr int LC_HIST = LC_OFF + 64;
constexpr int LC_TOT = LC_OFF + 128;
constexpr int LC_PRE = LC_OFF + 192;
constexpr int LC_TBASE = LC_OFF + 256;
constexpr int LC_WCNT = LC_OFF + 320;
constexpr int LC_GT = LC_OFF + 1024;
constexpr int LC_GOFF = LC_OFF + 4096;
constexpr int LDS_BYTES = RING_BYTES + 4096 + 8192;

__device__ __forceinline__ unsigned f2bf(float f) { unsigned u = __builtin_bit_cast(unsigned, f); return (u + 0x7fffu + ((u >> 16) & 1u)) >> 16; }
__device__ __forceinline__ unsigned pk2(float lo, float hi) { return f2bf(lo) | (f2bf(hi) << 16); }
__device__ __forceinline__ float bf2f(unsigned b) { return __builtin_bit_cast(float, b << 16); }
__device__ __forceinline__ float bflo(unsigned u) { return __builtin_bit_cast(float, u << 16); }
__device__ __forceinline__ float bfhi(unsigned u) { return __builtin_bit_cast(float, u & 0xffff0000u); }
__device__ __forceinline__ float fast_sigmoid(float x) { return __builtin_amdgcn_rcpf(1.0f + __builtin_amdgcn_exp2f(-1.44269504089f * x)); }
__device__ __forceinline__ float silu_f(float x) { return x * fast_sigmoid(x); }
#define WS_DPP(v, ctrl, rmask) __int_as_float(__builtin_amdgcn_update_dpp(0, __float_as_int(v), ctrl, rmask, 0xf, false))
__device__ __forceinline__ float wave_sum(float v) {
    v += WS_DPP(v, 0xB1, 0xf);
    v += WS_DPP(v, 0x4E, 0xf);
    v += WS_DPP(v, 0x141, 0xf);
    v += WS_DPP(v, 0x140, 0xf);
    v += WS_DPP(v, 0x142, 0xa);
    v += WS_DPP(v, 0x143, 0xc);
    return __int_as_float(__builtin_amdgcn_readlane(__float_as_int(v), 63));
}
__device__ __forceinline__ unsigned pk4_fp8(float a, float b, float c, float d) {
    a = __builtin_fminf(__builtin_fmaxf(a, -448.f), 448.f); b = __builtin_fminf(__builtin_fmaxf(b, -448.f), 448.f); c = __builtin_fminf(__builtin_fmaxf(c, -448.f), 448.f); d = __builtin_fminf(__builtin_fmaxf(d, -448.f), 448.f);
    unsigned w = 0; w = __builtin_amdgcn_cvt_pk_fp8_f32(a, b, w, false); w = __builtin_amdgcn_cvt_pk_fp8_f32(c, d, w, true); return w; }
#define LDS_WAIT() asm volatile("s_waitcnt lgkmcnt(0)" ::: "memory")

#define XB_TMO      128
#define XB_XCNT(j)  (256  + 64 * (j))
#define XB_XSUB(j)  (1280 + 64 * (j))
#define XB_XGEN(j)  (2304 + 64 * (j))
#define XB_TOP      3328
#define XB_TOPGEN   3392
#define XCD_BAR_WORDS 3456
#define XB_SPIN_CAP (1u << 18)
__device__ __forceinline__ unsigned xb_ld(unsigned* p)              { return __hip_atomic_load(p, __ATOMIC_RELAXED, __HIP_MEMORY_SCOPE_AGENT); }
__device__ __forceinline__ unsigned xb_add(unsigned* p, unsigned v) { return __hip_atomic_fetch_add(p, v, __ATOMIC_RELAXED, __HIP_MEMORY_SCOPE_AGENT); }
__device__ __forceinline__ unsigned xb_xcc_id() { return (unsigned)__builtin_amdgcn_s_getreg((3 << 11) | 20) & 0xFu; }
#define XB_SPIN(cond, bar) do { unsigned _sp = 0; while (cond) { __builtin_amdgcn_s_sleep(1); \
    if ((++_sp & 255u) == 0u) { if (xb_ld(&(bar)[XB_TMO])) break; if (_sp > XB_SPIN_CAP) { atomicAdd(&(bar)[XB_TMO], 1u); break; } } } } while (0)
struct XcdBarrier { unsigned* bar; unsigned x; volatile LAS unsigned* st; };
__device__ __forceinline__ XcdBarrier xcd_barrier_post(unsigned* bar, volatile LAS unsigned* st) {
    XcdBarrier b; b.bar = bar; b.x = xb_xcc_id(); b.st = st;
    if (threadIdx.x == 0) (void)xb_add(&bar[XB_XCNT(b.x)], 1u);
    return b;
}
__device__ __forceinline__ void xcd_barrier_complete(unsigned* bar, unsigned x, unsigned& nloc, unsigned& nx) {
    const unsigned G = gridDim.x * gridDim.y * gridDim.z;
    unsigned sum, cnt, mine, sp = 0u;
    for (;;) {
        sum = 0u; cnt = 0u; mine = 0u;
#pragma unroll
        for (unsigned j = 0; j < 16; ++j) { const unsigned c = xb_ld(&bar[XB_XCNT(j)]); sum += c; cnt += (c > 0u) ? 1u : 0u; mine = (j == x) ? c : mine; }
        if (sum == G) break;
        __builtin_amdgcn_s_sleep(1);
        if ((++sp & 255u) == 0u) { if (xb_ld(&bar[XB_TMO])) break; if (sp > XB_SPIN_CAP) { atomicAdd(&bar[XB_TMO], 1u); break; } }
    }
    nloc = mine > 0u ? mine : 1u; nx = cnt > 0u ? cnt : 1u;
}
__device__ __forceinline__ void xcd_barrier(const XcdBarrier& b) {
    asm volatile("s_waitcnt vmcnt(0)" ::: "memory");
    __syncthreads();
    if (threadIdx.x == 0) {
        unsigned* bar = b.bar;
        __builtin_amdgcn_s_waitcnt(0);
        unsigned nloc = b.st[0], nx = b.st[1];
        if (nloc == 0u) { xcd_barrier_complete(bar, b.x, nloc, nx); b.st[0] = nloc; b.st[1] = nx; }
        const unsigned old = xb_add(&bar[XB_XSUB(b.x)], 1u);
        const unsigned gen = old / nloc;
        if (old + 1u == (gen + 1u) * nloc) {
            __builtin_amdgcn_fence(__ATOMIC_RELEASE, "agent");
            asm volatile("s_waitcnt vmcnt(0)" ::: "memory");
            const unsigned og = xb_add(&bar[XB_TOP], 1u);
            const unsigned tg = og / nx;
            if (og + 1u == (tg + 1u) * nx) xb_add(&bar[XB_TOPGEN], 1u);
            else XB_SPIN(xb_ld(&bar[XB_TOPGEN]) == tg, bar);
            __builtin_amdgcn_fence(__ATOMIC_ACQUIRE, "agent");
            xb_add(&bar[XB_XGEN(b.x)], 1u);
            asm volatile("s_waitcnt vmcnt(0)" ::: "memory");
        } else {
            XB_SPIN(xb_ld(&bar[XB_XGEN(b.x)]) == gen, bar);
            __builtin_amdgcn_fence(__ATOMIC_ACQUIRE, "agent");
            asm volatile("s_waitcnt vmcnt(0)" ::: "memory");
        }
    }
    __syncthreads();
}

namespace pg8 {
constexpr int BM = 256, BK = 64, HALF = 128, HTB = HALF * BK * 2, STAGE_BYTES = 8 * HTB, NXCD = 8, WGM = 8;
__device__ __forceinline__ int lds_byte(int r, int c) { const int st = (r >> 4) * 2 + (c >> 5), rr = r & 15, cc = c & 31, ob = rr * 64 + cc * 2; return st * 1024 + (ob ^ (((ob >> 9) & 1) << 5)); }
__device__ __forceinline__ void stage_rc(int b, int& R, int& C) { const int st = b / 1024, sb = b % 1024, swz = sb ^ (((sb >> 9) & 1) << 5); R = (st >> 1) * 16 + swz / 64; C = (st & 1) * 32 + (swz % 64) / 2; }
__device__ __forceinline__ int perm32(int rho) { const int n = rho >> 4, i = rho & 15; return 8 * (i >> 2) + 4 * n + (i & 3); }
__device__ __forceinline__ unsigned cvt_pk_bf16(float lo, float hi) { unsigned r; asm volatile("v_cvt_pk_bf16_f32 %0, %1, %2" : "=v"(r) : "v"(lo), "v"(hi)); return r; }

struct Unit { int pm, pn, ex; };

__device__ __forceinline__ int xcd_remap(int wgid, int nwg) { const int q = nwg / NXCD, r = nwg % NXCD, xcd = wgid % NXCD, off = wgid / NXCD; return (xcd < r ? xcd * (q + 1) : r * (q + 1) + (xcd - r) * q) + off; }

struct DenseOrder {
    const bf16* A; const bf16* Bt; int K, nM, nN, nwg, G, c;
    __device__ __forceinline__ void init(const bf16* A_, const bf16* Bt_, int Mr, int N, int K_, int G_, int c_) { A = A_; Bt = Bt_; K = K_; nM = Mr / BM; nN = N / BM; nwg = nM * nN; G = G_; c = c_; }
    __device__ __forceinline__ bool next(int i, Unit& u) const {
        const long L = (long)i * G + c; if (L >= nwg) return false;
        const int wgid = xcd_remap((int)L, nwg);
        const int nig = WGM * nN, gid = wgid / nig, fm = gid * WGM, gsz = (nM - fm) < WGM ? (nM - fm) : WGM;
        u.pm = fm + ((wgid % nig) % gsz); u.pn = (wgid % nig) / gsz; u.ex = 0; return true;
    }
    __device__ __forceinline__ const char* a_ptr(const Unit& u) const { return (const char*)A + (size_t)u.pm * ((size_t)BM * K * 2); }
    __device__ __forceinline__ const char* b_ptr(const Unit& u) const { return (const char*)Bt + (size_t)u.pn * ((size_t)BM * K * 2); }
    __device__ __forceinline__ void rows_raw(const Unit&, int, unsigned (&)[2][2]) const {}
};
struct MoeOrder {
    const LAS int* tab; const bf16* A; const bf16* Bt; size_t bstride; const int* list; int K, nN, G, c; bool gather;
    int n5, adv;
    __device__ __forceinline__ bool next(int i, Unit& u) const {
        const int U = __builtin_amdgcn_readfirstlane(tab[1]), ng = __builtin_amdgcn_readfirstlane(tab[0]);
        long L;
        { const int head = adv * (G - n5);
          if (c >= n5) L = (i < adv) ? (long)i * (G - n5) + (c - n5) : (long)head + (long)(i - adv) * G + c;
          else L = (long)head + (long)i * G + c; }
        if (L >= U) return false;
        const int wgid = xcd_remap((int)L, U);
        int g = 0, hi = ng;
        while (hi - g > 1) { const int mid = (g + hi) >> 1; const int v = __builtin_amdgcn_readfirstlane(tab[64 + mid]); if (v <= wgid) g = mid; else hi = mid; }
        const int g0 = __builtin_amdgcn_readfirstlane(tab[64 + g]), t0 = __builtin_amdgcn_readfirstlane(tab[128 + g]), gsz = __builtin_amdgcn_readfirstlane(tab[192 + g]), ex = __builtin_amdgcn_readfirstlane(tab[256 + g]);
        const int local = wgid - g0;
        u.pm = t0 + local % gsz; u.pn = local / gsz; u.ex = ex; return true;
    }
    __device__ __forceinline__ const char* a_ptr(const Unit& u) const { return gather ? (const char*)A : (const char*)A + (size_t)u.pm * ((size_t)BM * K * 2); }
    __device__ __forceinline__ const char* b_ptr(const Unit& u) const { return (const char*)Bt + (size_t)u.ex * bstride + (size_t)u.pn * ((size_t)BM * K * 2); }
    __device__ __forceinline__ void rows_raw(const Unit& u, int tid, unsigned (&raw)[2][2]) const {
        asm volatile("" : "+v"(tid));
        const __amdgpu_buffer_rsrc_t rs = __builtin_amdgcn_make_buffer_rsrc((void*)(list + (size_t)u.pm * BM), (short)0, BM * 4, 0x00020000);
#pragma unroll
        for (int i = 0; i < 2; ++i) { int R, C; stage_rc(tid * 16 + i * 8192, R, C);
#pragma unroll
            for (int h = 0; h < 2; ++h) raw[h][i] = (unsigned)__builtin_amdgcn_raw_buffer_load_b32(rs, (unsigned)(h * HALF + R) * 4u, 0, 0); }
    }
};

struct EpiBf16 {
    static constexpr bool PERM = true;
    bf16* O; int ldc; int skip;
    __device__ __forceinline__ void operator()(const f32x4 (&acc)[2][2][4][2], const Unit& u, int wr, int wc, int fr, int fq) const {
        const int row0 = u.pm * BM + wr * 64 + fr, col0 = u.pn * BM + wc * 32 + 8 * fq;
        if (skip) { if (acc[0][0][0][0][0] == 12345.678f) O[0] = 1; return; }
#pragma unroll
        for (int ai = 0; ai < 2; ++ai)
#pragma unroll
            for (int m = 0; m < 4; ++m) { bf16* rowp = O + (size_t)(row0 + ai * HALF + m * 16) * ldc + col0;
#pragma unroll
                for (int bj = 0; bj < 2; ++bj) { const f32x4 v0 = acc[ai][bj][m][0], v1 = acc[ai][bj][m][1];
                    u32x4 w; w.x = cvt_pk_bf16(v0[0], v0[1]); w.y = cvt_pk_bf16(v0[2], v0[3]); w.z = cvt_pk_bf16(v1[0], v1[1]); w.w = cvt_pk_bf16(v1[2], v1[3]);
                    *(u32x4*)(rowp + bj * HALF) = w; } }
    }
};
struct EpiSwiglu {
    static constexpr bool PERM = true;
    bf16* O; int ldc;
    __device__ __forceinline__ void operator()(const f32x4 (&acc)[2][2][4][2], const Unit& u, int wr, int wc, int fr, int fq) const {
        const int row0 = u.pm * BM + wr * 64 + fr, col0 = u.pn * HALF + wc * 32 + 8 * fq;
        typedef float f32x2 __attribute__((ext_vector_type(2)));
        bf16* base = O + (size_t)row0 * ldc + col0;
#pragma unroll
        for (int ai = 0; ai < 2; ++ai)
#pragma unroll
            for (int m = 0; m < 4; ++m) { bf16* rowp = base + (size_t)(ai * HALF + m * 16) * ldc;
                float o[8];
#pragma unroll
                for (int n = 0; n < 2; ++n)
#pragma unroll
                    for (int j = 0; j < 4; j += 2) { const f32x2 g = {acc[ai][0][m][n][j], acc[ai][0][m][n][j + 1]}, up = {acc[ai][1][m][n][j], acc[ai][1][m][n][j + 1]};
                        const f32x2 t = g * -1.44269504089f; f32x2 r; r.x = __builtin_amdgcn_rcpf(1.0f + __builtin_amdgcn_exp2f(t.x)); r.y = __builtin_amdgcn_rcpf(1.0f + __builtin_amdgcn_exp2f(t.y));
                        const f32x2 v = (g * r) * up; o[n * 4 + j] = v.x; o[n * 4 + j + 1] = v.y; }
                u32x4 w; w.x = cvt_pk_bf16(o[0], o[1]); w.y = cvt_pk_bf16(o[2], o[3]); w.z = cvt_pk_bf16(o[4], o[5]); w.w = cvt_pk_bf16(o[6], o[7]);
                *(u32x4*)rowp = w; }
    }
};
struct EpiSwigluF8 {
    static constexpr bool PERM = true;
    unsigned char* O; int ldc; int skip;
    __device__ __forceinline__ void operator()(const f32x4 (&acc)[2][2][4][2], const Unit& u, int wr, int wc, int fr, int fq) const {
        const int row0 = u.pm * BM + wr * 64 + fr, col0 = u.pn * HALF + wc * 32 + 8 * fq;
        if (skip) { if (acc[0][0][0][0][0] == 12345.678f) O[0] = 1; return; }
        constexpr float si = 1.0f / (SC_H * SC_W), k1 = -1.44269504089f * si, k2 = si * si * SC_A;
        typedef float f32x2 __attribute__((ext_vector_type(2)));
        unsigned char* base = O + (size_t)row0 * ldc + col0;
#pragma unroll
        for (int ai = 0; ai < 2; ++ai)
#pragma unroll
            for (int m = 0; m < 4; ++m) { unsigned char* rowp = base + (size_t)(ai * HALF + m * 16) * ldc;
                float o[8];
#pragma unroll
                for (int n = 0; n < 2; ++n)
#pragma unroll
                    for (int j = 0; j < 4; j += 2) { const f32x2 g = {acc[ai][0][m][n][j], acc[ai][0][m][n][j + 1]}, up = {acc[ai][1][m][n][j], acc[ai][1][m][n][j + 1]};
                        const f32x2 t = g * k1; f32x2 r; r.x = __builtin_amdgcn_rcpf(1.0f + __builtin_amdgcn_exp2f(t.x)); r.y = __builtin_amdgcn_rcpf(1.0f + __builtin_amdgcn_exp2f(t.y));
                        const f32x2 v = (g * r) * (up * k2);
                        o[n * 4 + j] = __builtin_amdgcn_fmed3f(v.x, -448.f, 448.f); o[n * 4 + j + 1] = __builtin_amdgcn_fmed3f(v.y, -448.f, 448.f); }
                u32x2 w; unsigned t0 = 0, t1 = 0;
                t0 = __builtin_amdgcn_cvt_pk_fp8_f32(o[0], o[1], t0, false); t0 = __builtin_amdgcn_cvt_pk_fp8_f32(o[2], o[3], t0, true);
                t1 = __builtin_amdgcn_cvt_pk_fp8_f32(o[4], o[5], t1, false); t1 = __builtin_amdgcn_cvt_pk_fp8_f32(o[6], o[7], t1, true);
                w.x = t0; w.y = t1; *(u32x2*)rowp = w; }
    }
};
template <bool XF32> struct EpiResidual {
    static constexpr bool PERM = true;
    const void* xin; bf16* out; const float* gate; float gs;
    __device__ __forceinline__ void operator()(const f32x4 (&acc)[2][2][4][2], const Unit& u, int wr, int wc, int fr, int fq) const {
        const int row0 = u.pm * BM + wr * 64 + fr, col0 = u.pn * BM + wc * 32 + 8 * fq, b = u.pm >> 5;
        f32x4 gv[2][2];
#pragma unroll
        for (int bj = 0; bj < 2; ++bj)
#pragma unroll
            for (int n = 0; n < 2; ++n) gv[bj][n] = *(const f32x4*)(gate + (size_t)b * NMOD + col0 + bj * HALF + n * 4) * gs;
#pragma unroll
        for (int ai = 0; ai < 2; ++ai) {
            if (XF32) { f32x4 xs[4][2][2];
#pragma unroll
                for (int m = 0; m < 4; ++m)
#pragma unroll
                    for (int bj = 0; bj < 2; ++bj) { const float* p = (const float*)xin + (size_t)(row0 + ai * HALF + m * 16) * D + col0 + bj * HALF; xs[m][bj][0] = *(const f32x4*)p; xs[m][bj][1] = *(const f32x4*)(p + 4); }
#pragma unroll
                for (int m = 0; m < 4; ++m)
#pragma unroll
                    for (int bj = 0; bj < 2; ++bj) { const f32x4 r0 = xs[m][bj][0] + gv[bj][0] * acc[ai][bj][m][0], r1 = xs[m][bj][1] + gv[bj][1] * acc[ai][bj][m][1];
                        u32x4 w; w.x = cvt_pk_bf16(r0[0], r0[1]); w.y = cvt_pk_bf16(r0[2], r0[3]); w.z = cvt_pk_bf16(r1[0], r1[1]); w.w = cvt_pk_bf16(r1[2], r1[3]);
                        *(u32x4*)(out + (size_t)(row0 + ai * HALF + m * 16) * D + col0 + bj * HALF) = w; }
            } else { u32x4 xr[4][2];
#pragma unroll
                for (int m = 0; m < 4; ++m)
#pragma unroll
                    for (int bj = 0; bj < 2; ++bj) xr[m][bj] = *(const u32x4*)((const bf16*)xin + (size_t)(row0 + ai * HALF + m * 16) * D + col0 + bj * HALF);
#pragma unroll
                for (int m = 0; m < 4; ++m)
#pragma unroll
                    for (int bj = 0; bj < 2; ++bj) { const u32x4 t = xr[m][bj];
                        const f32x4 x0 = {bflo(t.x), bfhi(t.x), bflo(t.y), bfhi(t.y)}, x1 = {bflo(t.z), bfhi(t.z), bflo(t.w), bfhi(t.w)};
                        const f32x4 r0 = x0 + gv[bj][0] * acc[ai][bj][m][0], r1 = x1 + gv[bj][1] * acc[ai][bj][m][1];
                        u32x4 w; w.x = cvt_pk_bf16(r0[0], r0[1]); w.y = cvt_pk_bf16(r0[2], r0[3]); w.z = cvt_pk_bf16(r1[0], r1[1]); w.w = cvt_pk_bf16(r1[2], r1[3]);
                        *(u32x4*)(out + (size_t)(row0 + ai * HALF + m * 16) * D + col0 + bj * HALF) = w; }
            }
            asm volatile("" ::: "memory");
        }
    }
};
struct EpiMoeDown {
    static constexpr bool PERM = true;
    bf16* out; const int* list; const float* wgt; const float* gate; float ascale; bf16* dump;
    __device__ __forceinline__ void operator()(const f32x4 (&acc)[2][2][4][2], const Unit& u, int wr, int wc, int fr, int fq) const {
        const int pos0 = u.pm * BM + wr * 64 + fr, col0 = u.pn * BM + wc * 32 + 8 * fq;
        int tk[2][4]; float w[2][4];
#pragma unroll
        for (int ai = 0; ai < 2; ++ai)
#pragma unroll
            for (int m = 0; m < 4; ++m) { const int pos = pos0 + ai * HALF + m * 16; tk[ai][m] = list[pos]; w[ai][m] = wgt[pos] * ascale; }
#pragma unroll
        for (int aq = 0; aq < 4; ++aq) {
            const int ai = aq >> 1, mb = (aq & 1) * 2;
            u32x4 xr[2][2]; f32x4 gq[2][2][2]; bf16* orow[2];
#pragma unroll
            for (int mm = 0; mm < 2; ++mm) { const int t = tk[ai][mb + mm]; orow[mm] = (t >= 0 ? out + (size_t)t * D : dump) + col0; const float* gp = gate + (size_t)(t >= 0 ? (t >> 13) : 0) * NMOD + col0;
#pragma unroll
                for (int bj = 0; bj < 2; ++bj) { xr[mm][bj] = *(const u32x4*)(orow[mm] + bj * HALF); gq[mm][bj][0] = *(const f32x4*)(gp + bj * HALF); gq[mm][bj][1] = *(const f32x4*)(gp + bj * HALF + 4); } }
#pragma unroll
            for (int mm = 0; mm < 2; ++mm)
#pragma unroll
                for (int bj = 0; bj < 2; ++bj) { const u32x4 t = xr[mm][bj]; const float ww = w[ai][mb + mm];
                    const f32x4 x0 = {bflo(t.x), bfhi(t.x), bflo(t.y), bfhi(t.y)}, x1 = {bflo(t.z), bfhi(t.z), bflo(t.w), bfhi(t.w)};
                    const f32x4 r0 = x0 + (gq[mm][bj][0] * ww) * acc[ai][bj][mb + mm][0], r1 = x1 + (gq[mm][bj][1] * ww) * acc[ai][bj][mb + mm][1];
                    u32x4 o; o.x = cvt_pk_bf16(r0[0], r0[1]); o.y = cvt_pk_bf16(r0[2], r0[3]); o.z = cvt_pk_bf16(r1[0], r1[1]); o.w = cvt_pk_bf16(r1[2], r1[3]);
                    *(u32x4*)(orow[mm] + bj * HALF) = o; }
            asm volatile("" ::: "memory");
        }
    }
};

template <class Epi, class Sched, bool GATHER, bool FP8 = false>
__device__ __forceinline__ void gemm_phase(LAS unsigned char* lds, const int K, const Sched& S, const Epi& E, LAS u32x4* goff = nullptr, int ntdiv = 1) {
    int tid_ = threadIdx.x; asm volatile("" : "+v"(tid_));
    const int tid = tid_, wid = __builtin_amdgcn_readfirstlane(tid >> 6), lane = tid & 63, wr = wid >> 2, wc = wid & 3, fr = lane & 15, fq = lane >> 4;
    int nt = K / BK / ntdiv; asm volatile("" : "+s"(nt));
    unsigned voffB[2], ao[2][2], no[2][2];
    const size_t kstep = (size_t)(BK * 2);
    const size_t hstep = (size_t)HALF * K * 2;
#pragma unroll
    for (int i = 0; i < 2; ++i) { int R, C; stage_rc(tid * 16 + i * 8192, R, C); const int Rb = Epi::PERM ? ((R & ~31) + perm32(R & 31)) : R;
        voffB[i] = (unsigned)(Rb * K + C) * 2u;
        ao[0][i] = (unsigned)(R * K + C) * 2u; ao[1][i] = ao[0][i] + (unsigned)hstep; no[0][i] = ao[0][i]; no[1][i] = ao[1][i]; }
    const unsigned ldsw = (unsigned)wid * 1024u;
    const int aoff = lds_byte(wr * 64 + fr, fq * 8), boff = lds_byte(wc * 32 + fr, fq * 8);
#define PG8_CB(i) ([&]() { int t_ = tid; asm volatile("" : "+v"(t_)); int R_, C_; stage_rc(t_ * 16 + (i) * 8192, R_, C_); return (unsigned)C_ * 2u; }())
#define PG8_SA(b, h) (((b) * 2 + (h)) * HTB)
#define PG8_SB(b, h) ((4 + (b) * 2 + (h)) * HTB)
#define PG8_STAGEB(bufoff, gbase) do { _Pragma("unroll") for (int _i = 0; _i < 2; ++_i) \
        __builtin_amdgcn_global_load_lds((const unsigned*)((const char*)(gbase) + voffB[_i]), (LAS unsigned*)(lds + (bufoff) + ldsw + _i * 8192), 16, 0, 0); } while (0)
#define PG8_STAGEA(bufoff, gbase, offs, h) do { _Pragma("unroll") for (int _i = 0; _i < 2; ++_i) \
        __builtin_amdgcn_global_load_lds((const unsigned*)((const char*)(gbase) + (offs)[h][_i]), (LAS unsigned*)(lds + (bufoff) + ldsw + _i * 8192), 16, 0, 0); } while (0)
#define PG8_LD32(p) __builtin_shufflevector(*(const LAS i32x4*)(p), *(const LAS i32x4*)((p) + 1024), 0, 1, 2, 3, 4, 5, 6, 7)
#define PG8_LDA(dst, b, h) do { _Pragma("unroll") for (int m = 0; m < 4; ++m) { if constexpr (FP8) dst##8[m] = PG8_LD32(lds + PG8_SA(b, h) + aoff + m * 2048); \
        else { _Pragma("unroll") for (int k = 0; k < 2; ++k) dst[m][k] = *(const LAS bf16x8*)(lds + PG8_SA(b, h) + aoff + m * 2048 + k * 1024); } } } while (0)
#define PG8_LDB(dst, b, h) do { _Pragma("unroll") for (int n = 0; n < 2; ++n) { if constexpr (FP8) dst##8[n] = PG8_LD32(lds + PG8_SB(b, h) + boff + n * 2048); \
        else { _Pragma("unroll") for (int k = 0; k < 2; ++k) dst[n][k] = *(const LAS bf16x8*)(lds + PG8_SB(b, h) + boff + n * 2048 + k * 1024); } } } while (0)
#define PG8_MMA(ai, bj, At, Bt) do { __builtin_amdgcn_s_setprio(1); _Pragma("unroll") for (int m = 0; m < 4; ++m) _Pragma("unroll") for (int n = 0; n < 2; ++n) { \
        if constexpr (FP8) asm volatile("v_mfma_scale_f32_16x16x128_f8f6f4 %0, %1, %2, %0, %3, %3 op_sel_hi:[0,0,0]" : "+v"(acc[ai][bj][m][n]) : "v"(Bt##8[n]), "v"(At##8[m]), "v"(sc1));     \
        else { _Pragma("unroll") for (int k = 0; k < 2; ++k) acc[ai][bj][m][n] = __builtin_amdgcn_mfma_f32_16x16x32_bf16(Bt[n][k], At[m][k], acc[ai][bj][m][n], 0, 0, 0); } } \
        __builtin_amdgcn_s_setprio(0); } while (0)
#define PG8_WAIT_V(n) asm volatile("s_waitcnt vmcnt(" #n ")" ::: "memory")
#define PG8_WAIT_L(n) asm volatile("s_waitcnt lgkmcnt(" #n ")" ::: "memory")
#define PG8_BAR __builtin_amdgcn_s_barrier()
#define PG8_SCHED __builtin_amdgcn_sched_barrier(0)
    Unit cur, nxt, nn; int ui = 0;
    if (!S.next(0, cur)) return;
    bool has_next = S.next(1, nxt);
    if constexpr (GATHER) {
        unsigned raw[2][2]; S.rows_raw(cur, tid, raw);
#pragma unroll
        for (int h = 0; h < 2; ++h)
#pragma unroll
            for (int i = 0; i < 2; ++i) ao[h][i] = (raw[h][i] & 0xffffffu) * (unsigned)(K * 2) + PG8_CB(i);
        if (has_next) { S.rows_raw(nxt, tid, raw);
#pragma unroll
            for (int h = 0; h < 2; ++h)
#pragma unroll
                for (int i = 0; i < 2; ++i) no[h][i] = (raw[h][i] & 0xffffffu) * (unsigned)(K * 2) + PG8_CB(i); }
        else {
#pragma unroll
            for (int h = 0; h < 2; ++h)
#pragma unroll
                for (int i = 0; i < 2; ++i) no[h][i] = ao[h][i]; }
        goff[tid] = (u32x4){no[0][0], no[0][1], no[1][0], no[1][1]};
    }
    f32x4 acc[2][2][4][2];
#pragma unroll
    for (int a = 0; a < 2; ++a)
#pragma unroll
        for (int b = 0; b < 2; ++b)
#pragma unroll
            for (int m = 0; m < 4; ++m)
#pragma unroll
                for (int n = 0; n < 2; ++n) acc[a][b][m][n] = (f32x4){0.f, 0.f, 0.f, 0.f};
    const int sc1 = 0x7f7f7f7f;
    bf16x8 At[4][2], B0[2][2], B1[2][2];
    i32x8 At8[4], B08[2], B18[2];
    const char* cA = S.a_ptr(cur); const char* cB = S.b_ptr(cur);
    PG8_STAGEB(PG8_SB(0, 0), cB); PG8_STAGEB(PG8_SB(0, 1), cB + hstep); PG8_STAGEA(PG8_SA(0, 0), cA, ao, 0); PG8_STAGEA(PG8_SA(0, 1), cA, ao, 1);
    if (wr == 1) PG8_BAR;
    PG8_WAIT_V(2); PG8_BAR;
    PG8_STAGEB(PG8_SB(1, 0), cB + kstep); PG8_STAGEA(PG8_SA(1, 0), cA + kstep, ao, 0); PG8_STAGEB(PG8_SB(1, 1), cB + hstep + kstep);
    PG8_WAIT_V(6); PG8_BAR;
    for (;;) {
        const char* nA = has_next ? S.a_ptr(nxt) : cA; const char* nB = has_next ? S.b_ptr(nxt) : cB;
#pragma clang loop unroll(disable)
        for (int t = 0; t < nt; t += 2) {
            const bool last = (t == nt - 2);
            const char* a1 = cA + (size_t)(t + 1) * kstep;
            const char* a2 = last ? nA : cA + (size_t)(t + 2) * kstep; const char* b2 = last ? nB : cB + (size_t)(t + 2) * kstep;
            const char* a3 = a2 + kstep; const char* b3 = b2 + kstep;
            asm volatile("" : "+v"(voffB[0]), "+v"(voffB[1]), "+v"(ao[0][0]), "+v"(ao[0][1]), "+v"(ao[1][0]), "+v"(ao[1][1]));
            PG8_LDB(B0, 0, 0); PG8_LDB(B1, 0, 1); PG8_SCHED; PG8_LDA(At, 0, 0); PG8_STAGEA(PG8_SA(1, 1), a1, ao, 1);
            if constexpr (GATHER) { if (last) { const u32x4 q = goff[tid]; ao[0][0] = q[0]; ao[0][1] = q[1]; ao[1][0] = q[2]; ao[1][1] = q[3]; } }
            PG8_WAIT_V(8); PG8_WAIT_L(0); PG8_BAR; PG8_MMA(0, 0, At, B0); PG8_MMA(0, 1, At, B1); PG8_BAR; PG8_SCHED;
            PG8_LDA(At, 0, 1); PG8_STAGEB(PG8_SB(0, 0), b2); PG8_STAGEB(PG8_SB(0, 1), b2 + hstep); PG8_STAGEA(PG8_SA(0, 0), a2, ao, 0);
            PG8_WAIT_V(8); PG8_WAIT_L(0); PG8_BAR; PG8_MMA(1, 0, At, B0); PG8_MMA(1, 1, At, B1); PG8_BAR; PG8_SCHED;
            PG8_LDB(B0, 1, 0); PG8_LDB(B1, 1, 1); PG8_SCHED; PG8_LDA(At, 1, 0); PG8_STAGEA(PG8_SA(0, 1), a2, ao, 1);
            PG8_WAIT_V(8); PG8_WAIT_L(0); PG8_BAR; PG8_MMA(0, 0, At, B0); PG8_MMA(0, 1, At, B1); PG8_BAR; PG8_SCHED;
            PG8_LDA(At, 1, 1); PG8_STAGEB(PG8_SB(1, 0), b3); PG8_STAGEB(PG8_SB(1, 1), b3 + hstep); PG8_STAGEA(PG8_SA(1, 0), a3, ao, 0);
            PG8_WAIT_V(8); PG8_WAIT_L(0); PG8_BAR; PG8_MMA(1, 0, At, B0); PG8_MMA(1, 1, At, B1); PG8_BAR; PG8_SCHED;
        }
        if (wr == 0) PG8_BAR;
        if constexpr (FP8) asm volatile("s_nop 15\n\ts_nop 15\n\ts_nop 7" ::: "memory");
        bool has_nn = false; unsigned raw[2][2];
        if (has_next) has_nn = S.next(ui + 2, nn);
        if constexpr (GATHER) { if (has_nn) S.rows_raw(nn, tid, raw); }
        E(acc, cur, wr, wc, fr, fq);
        if (!has_next) break;
#pragma unroll
        for (int a = 0; a < 2; ++a)
#pragma unroll
            for (int b = 0; b < 2; ++b)
#pragma unroll
                for (int m = 0; m < 4; ++m)
#pragma unroll
                    for (int n = 0; n < 2; ++n) acc[a][b][m][n] = (f32x4){0.f, 0.f, 0.f, 0.f};
        if constexpr (GATHER) {
            if (has_nn) { u32x4 q;
#pragma unroll
                for (int h = 0; h < 2; ++h)
#pragma unroll
                    for (int i = 0; i < 2; ++i) q[h * 2 + i] = (raw[h][i] & 0xffffffu) * (unsigned)(K * 2) + PG8_CB(i);
                goff[tid] = q; }
        }
        cur = nxt; cA = nA; cB = nB; nxt = nn; has_next = has_nn; ++ui;
        if (wr == 1) PG8_BAR;
    }
    PG8_WAIT_V(0);
    PG8_BAR;
#undef PG8_SA
#undef PG8_CB
#undef PG8_SB
#undef PG8_STAGEA
#undef PG8_STAGEB
#undef PG8_LDA
#undef PG8_LDB
#undef PG8_MMA
#undef PG8_LD32
#undef PG8_WAIT_V
#undef PG8_WAIT_L
#undef PG8_BAR
#undef PG8_SCHED
}
}

struct Args { const float* in[27]; float* out; unsigned char* ws; };
typedef const float* cfp_t;
typedef __attribute__((address_space(4))) const cfp_t* kargp_t;
struct Frame {
    LAS unsigned char* lds;
    int tid, lane, wave, G, bid;
    kargp_t ka;
};
#define PHASE_ENTER(F) do { kargp_t _p = (F).ka; asm volatile("" : "+s"(_p)); (F).ka = _p; \
    int _t = threadIdx.x; asm volatile("" : "+v"(_t)); (F).tid = _t; (F).lane = _t & 63; (F).wave = __builtin_amdgcn_readfirstlane(_t >> 6); \
    int _g = gridDim.x; asm volatile("" : "+s"(_g)); (F).G = _g; int _b = blockIdx.x; asm volatile("" : "+s"(_b)); (F).bid = _b; } while (0)
#define KIN(k) ((F).ka[k])
#define KOUT ((float*)(F).ka[27])
#define KWS ((unsigned char*)(F).ka[28])
#define KMOD ((float*)(KWS + WS_MOD))
#define KH ((bf16*)(KWS + WS_H))
#define KPROJ ((bf16*)(KWS + WS_BIG))
#define KMIXED ((bf16*)(KWS + WS_MIXED))
#define KACT ((bf16*)(KWS + WS_BIG))
#define KXB ((bf16*)(KWS + WS_XB))

__device__ __forceinline__ void p0_transpose_item(const float* W, int K, int N, bf16* WT, int dst_row0, LAS float* scr, int kb, int nb, int lane) {
    const int k0 = 64 * kb, n0 = 32 * nb;
    { f32x4 t[8];
#pragma unroll
      for (int i = 0; i < 8; ++i) t[i] = __builtin_nontemporal_load((const f32x4*)(W + (size_t)(k0 + 8 * i + (lane >> 3)) * N + n0 + 4 * (lane & 7)));
#pragma unroll
      for (int i = 0; i < 8; ++i) { LAS float* d = scr + (8 * i + (lane >> 3)) * 33 + 4 * (lane & 7); d[0] = t[i][0]; d[1] = t[i][1]; d[2] = t[i][2]; d[3] = t[i][3]; } }
    LDS_WAIT(); asm volatile("" ::: "memory");
    const int c = lane & 7;
#pragma unroll
    for (int j = 0; j < 4; ++j) { const int n = (lane >> 3) + 8 * j; const LAS float* s = scr + (8 * c) * 33 + n;
        u32x4 o; o.x = pk2(s[0 * 33], s[1 * 33]); o.y = pk2(s[2 * 33], s[3 * 33]); o.z = pk2(s[4 * 33], s[5 * 33]); o.w = pk2(s[6 * 33], s[7 * 33]);
        *(u32x4*)(WT + (size_t)(dst_row0 + n) * K + k0 + 8 * c) = o; }
    LDS_WAIT(); asm volatile("" ::: "memory");
}
__device__ __forceinline__ void p0_transpose_item_f8(const float* W, int K, int N, unsigned char* WT, int dst_row0, LAS float* scr, int kb, int nb, int lane) {
    const int k0 = 64 * kb, n0 = 32 * nb;
    { f32x4 t[8];
#pragma unroll
      for (int i = 0; i < 8; ++i) t[i] = __builtin_nontemporal_load((const f32x4*)(W + (size_t)(k0 + 8 * i + (lane >> 3)) * N + n0 + 4 * (lane & 7)));
#pragma unroll
      for (int i = 0; i < 8; ++i) { LAS float* d = scr + (8 * i + (lane >> 3)) * 33 + 4 * (lane & 7); d[0] = t[i][0]; d[1] = t[i][1]; d[2] = t[i][2]; d[3] = t[i][3]; } }
    LDS_WAIT(); asm volatile("" ::: "memory");
    const int n = lane >> 1, kh = (lane & 1) * 32; const LAS float* sp = scr + kh * 33 + n;
#pragma unroll
    for (int q = 0; q < 2; ++q) { u32x4 o;
#pragma unroll
        for (int d = 0; d < 4; ++d) { const int kk = q * 16 + d * 4; o[d] = pk4_fp8(sp[(kk + 0) * 33] * SC_W, sp[(kk + 1) * 33] * SC_W, sp[(kk + 2) * 33] * SC_W, sp[(kk + 3) * 33] * SC_W); }
        *(u32x4*)(WT + (size_t)(dst_row0 + n) * K + k0 + kh + q * 16) = o; }
    LDS_WAIT(); asm volatile("" ::: "memory");
}
__device__ __forceinline__ int gu_row(int n) { return (n >> 7) * 256 + (n & 127); }

__device__ __forceinline__ void p0_prologue(Frame& F) {
    if (F.bid < 192) {
        LAS float* cond = (LAS float*)F.lds;
        LAS float* red = (LAS float*)(F.lds + 32768);
        const float* cin = KIN(1);
        for (int i = F.tid; i < BATCH * D; i += NTHREADS) cond[i] = silu_f(cin[i]);
        __syncthreads();
        for (int item = F.bid; item < 192; item += F.G) {
            const int l = item / 96, colbase = (item % 96) * 64, col = colbase + F.lane;
            const float* W = KIN(2) + (size_t)l * D * NMOD;
            float a[8];
#pragma unroll
            for (int b = 0; b < 8; ++b) a[b] = 0.f;
            for (int k0 = F.wave * 128; k0 < F.wave * 128 + 128; k0 += 16) { float w[16];
#pragma unroll
                for (int i = 0; i < 16; ++i) w[i] = W[(size_t)(k0 + i) * NMOD + col];
#pragma unroll
                for (int i = 0; i < 16; ++i)
#pragma unroll
                    for (int b = 0; b < 8; ++b) a[b] = fmaf(cond[b * D + k0 + i], w[i], a[b]); }
#pragma unroll
            for (int b = 0; b < 8; ++b) red[(F.wave * 8 + b) * 64 + F.lane] = a[b];
            __syncthreads();
            { const int b = F.tid >> 6, cl = F.tid & 63; float s = 0.f;
#pragma unroll
              for (int w = 0; w < 8; ++w) s += red[(w * 8 + b) * 64 + cl];
              KMOD[((size_t)l * BATCH + b) * NMOD + colbase + cl] = s + KIN(3)[(size_t)l * NMOD + colbase + cl]; }
            __syncthreads();
        }
    }
    LAS float* scr = (LAS float*)(F.lds + F.wave * 16384);
    const int gw = F.bid * NWAVES + F.wave, NGW = F.G * NWAVES;
    constexpr int I_IN = 16 * 56, I_OUT = 16 * 32, I_FG = 16 * 88, I_FD = 44 * 32, I_MG = 16 * 112, I_MD = 56 * 32;
    constexpr int NITEMS = 2 * I_IN + 2 * I_OUT + 2 * I_FG + I_FD + 16 * I_MG + 8 * I_MD;
    bf16* ws_b = (bf16*)KWS;
    for (int it = gw; it < NITEMS; it += NGW) {
        int r = it;
        if (r < 2 * I_IN) { const int l = r / I_IN; r -= l * I_IN; const int kb = r / 56, nb = r % 56;
            p0_transpose_item(KIN(6) + (size_t)l * D * D_IN, D, D_IN, (bf16*)(KWS + WS_WIN) + (size_t)l * D_IN * D, 32 * nb, scr, kb, nb, F.lane); continue; } r -= 2 * I_IN;
        if (r < 2 * I_OUT) { const int l = r / I_OUT; r -= l * I_OUT; const int kb = r / 32, nb = r % 32;
            p0_transpose_item(KIN(17) + (size_t)l * D * D, D, D, (bf16*)(KWS + WS_WOUT) + (size_t)l * D * D, 32 * nb, scr, kb, nb, F.lane); continue; } r -= 2 * I_OUT;
        if (r < 2 * I_FG) { const int up = r / I_FG; r -= up * I_FG; const int kb = r / 88, nb = r % 88;
            p0_transpose_item(up ? KIN(19) : KIN(18), D, FF, (bf16*)(KWS + WS_WGU), gu_row(32 * nb) + 128 * up, scr, kb, nb, F.lane); continue; } r -= 2 * I_FG;
        if (r < I_FD) { const int kb = r / 32, nb = r % 32;
            p0_transpose_item(KIN(20), FF, D, (bf16*)(KWS + WS_WD), 32 * nb, scr, kb, nb, F.lane); continue; } r -= I_FD;
        if (r < 16 * I_MG) { const int q = r / I_MG; r -= q * I_MG; const int up = q >> 3, e = q & 7; const int kb = r / 112, nb = r % 112;
            p0_transpose_item_f8((up ? KIN(24) : KIN(23)) + (size_t)e * D * FFE, D, FFE, (unsigned char*)(KWS + WS_MWGU) + (size_t)e * 2 * FFE * D, gu_row(32 * nb) + 128 * up, scr, kb, nb, F.lane); continue; } r -= 16 * I_MG;
        { const int e = r / I_MD; r -= e * I_MD; const int kb = r / 32, nb = r % 32;
            p0_transpose_item_f8(KIN(25) + (size_t)e * FFE * D, FFE, D, (unsigned char*)(KWS + WS_MWD) + (size_t)e * D * FFE, 32 * nb, scr, kb, nb, F.lane); }
    }
    (void)ws_b;
    if (F.bid == 0) for (int i = F.tid; i < D; i += NTHREADS) ((float*)(KWS + WS_DUMP))[i] = 0.f;
    { bf16* pw = (bf16*)(KWS + WS_POOLW);
      for (int i = F.bid * NTHREADS + F.tid; i < 2 * 4 * 64 * 64; i += F.G * NTHREADS) { const int c = i & 63, d = (i >> 6) & 63, lg = i >> 12;
          pw[i] = (bf16)f2bf(KIN(7)[((size_t)lg * 64 + c) * 64 + d] * KIN(8)[lg * 64 + d]); } }
    { const float* sw = KIN(15); bf16* so = (bf16*)(KWS + WS_SGUW);
      for (int i = (F.bid * NTHREADS + F.tid) * 4; i < 2 * NH * 128 * 128; i += F.G * NTHREADS * 4) { const f32x4 v = *(const f32x4*)(sw + i); u32x2 o; o.x = pk2(v[0], v[1]); o.y = pk2(v[2], v[3]); *(u32x2*)(so + i) = o; } }
}

template <int MODE, bool SRCB>
__device__ __forceinline__ void norm_phase(Frame& F, const void* xsrc, const float* g, const float* shiftp, const float* scalep, bf16* hdst, float* fdst) {
    LAS int* lhist = (LAS int*)(F.lds + LC_HIST);
    for (int tb = F.bid; tb < M / 256; tb += F.G) {
        const int row0 = tb * 256 + F.wave * 32, b = row0 >> 13;
        f32x4 gm[4], sh[4];
#pragma unroll
        for (int j = 0; j < 4; ++j) { const int col = 4 * F.lane + 256 * j; const f32x4 gg = *(const f32x4*)(g + col);
            if (MODE == 2) { gm[j] = gg; sh[j] = (f32x4){0.f, 0.f, 0.f, 0.f}; }
            else { const f32x4 sc = *(const f32x4*)(scalep + (size_t)b * NMOD + col); gm[j] = gg * (1.0f + sc); sh[j] = *(const f32x4*)(shiftp + (size_t)b * NMOD + col); } }
        float rbias[8];
        LAS float* rwl = (LAS float*)F.lds;
        if (MODE == 1) {
            for (int i = F.tid; i < D * NE; i += NTHREADS) rwl[(i & 7) * D + (i >> 3)] = KIN(21)[i];
#pragma unroll
            for (int e = 0; e < 8; ++e) rbias[e] = KIN(22)[e];
            if (F.tid < 16) lhist[F.tid] = 0;
            __syncthreads();
        }
        for (int rq = 0; rq < 32; rq += 4) {
            f32x4 vv[4][4];
#pragma unroll
            for (int rr = 0; rr < 4; ++rr) { const int row = row0 + rq + rr;
                if (SRCB) { const u32x2* xr = (const u32x2*)((const bf16*)xsrc + (size_t)row * D) + F.lane;
#pragma unroll
                    for (int j = 0; j < 4; ++j) { const u32x2 t = xr[64 * j]; vv[rr][j] = (f32x4){bflo(t.x), bfhi(t.x), bflo(t.y), bfhi(t.y)}; } }
                else { const f32x4* xr = (const f32x4*)((const float*)xsrc + (size_t)row * D) + F.lane;
#pragma unroll
                    for (int j = 0; j < 4; ++j) vv[rr][j] = xr[64 * j]; } }
#pragma unroll
            for (int rr = 0; rr < 4; ++rr) {
            const int row = row0 + rq + rr;
            f32x4 v[4]; float ss = 0.f;
#pragma unroll
            for (int j = 0; j < 4; ++j) v[j] = vv[rr][j];
#pragma unroll
            for (int j = 0; j < 4; ++j) { ss += (v[j][0] * v[j][0] + v[j][1] * v[j][1]) + (v[j][2] * v[j][2] + v[j][3] * v[j][3]); }
            const float rstd = 1.0f / sqrtf(wave_sum(ss) * (1.0f / D) + EPS);
#pragma unroll
            for (int j = 0; j < 4; ++j) v[j] = (v[j] * rstd) * gm[j] + sh[j];
            if (MODE == 2) { f32x4* o = (f32x4*)(fdst + (size_t)row * D) + F.lane;
#pragma unroll
                for (int j = 0; j < 4; ++j) o[64 * j] = v[j]; }
            else if (MODE == 1) { unsigned* o = (unsigned*)((unsigned char*)hdst + (size_t)row * D) + F.lane;
#pragma unroll
                for (int j = 0; j < 4; ++j) o[64 * j] = pk4_fp8(v[j][0] * SC_H, v[j][1] * SC_H, v[j][2] * SC_H, v[j][3] * SC_H); }
            else { u32x2* o = (u32x2*)(hdst + (size_t)row * D) + F.lane;
#pragma unroll
                for (int j = 0; j < 4; ++j) { u32x2 w; w.x = pk2(v[j][0], v[j][1]); w.y = pk2(v[j][2], v[j][3]); o[64 * j] = w; } }
            if (MODE == 1) {
                float lg[8];
#pragma unroll
                for (int e = 0; e < 8; ++e) lg[e] = 0.f;
#pragma unroll
                for (int e = 0; e < 8; ++e)
#pragma unroll
                    for (int j = 0; j < 4; ++j) { const f32x4 wv = *(const LAS f32x4*)(rwl + e * D + 4 * F.lane + 256 * j);
                        lg[e] = fmaf(v[j][0], wv[0], lg[e]); lg[e] = fmaf(v[j][1], wv[1], lg[e]); lg[e] = fmaf(v[j][2], wv[2], lg[e]); lg[e] = fmaf(v[j][3], wv[3], lg[e]); }
#pragma unroll
                for (int e = 0; e < 8; ++e) lg[e] = wave_sum(lg[e]) + rbias[e];
                int i1 = 0; float v1 = lg[0];
#pragma unroll
                for (int e = 1; e < 8; ++e) if (lg[e] > v1) { v1 = lg[e]; i1 = e; }
                int i2 = -1; float v2 = -3.0e38f;
#pragma unroll
                for (int e = 0; e < 8; ++e) if (e != i1 && lg[e] > v2) { v2 = lg[e]; i2 = e; }
                const float ex = __expf(v2 - v1), w1 = 1.0f / (1.0f + ex), w2 = ex * w1;
                if (F.lane == 0) { u32x4 rec; rec.x = (unsigned)i1; rec.y = (unsigned)i2; rec.z = __float_as_uint(w1); rec.w = __float_as_uint(w2);
                    *(u32x4*)(KWS + WS_REC + (size_t)row * 16) = rec; __hip_atomic_fetch_add(&lhist[i1], 1, __ATOMIC_RELAXED, __HIP_MEMORY_SCOPE_WORKGROUP); __hip_atomic_fetch_add(&lhist[8 + i2], 1, __ATOMIC_RELAXED, __HIP_MEMORY_SCOPE_WORKGROUP); }
            }
        }
        }
        if (MODE == 1) { __syncthreads(); if (F.tid < 16) ((int*)(KWS + WS_HIST))[tb * 16 + F.tid] = lhist[F.tid]; __syncthreads(); }
    }
}

__device__ __forceinline__ void route_phase(Frame& F) {
    LAS int* ltot = (LAS int*)(F.lds + LC_TOT); LAS int* lpre = (LAS int*)(F.lds + LC_PRE); LAS int* ltb = (LAS int*)(F.lds + LC_TBASE); LAS int* lwc = (LAS int*)(F.lds + LC_WCNT);
    const int* hist = (const int*)(KWS + WS_HIST);
    int* list = (int*)(KWS + WS_LIST); float* wgt = (float*)(KWS + WS_WGT);
    for (int tb = F.bid; tb < M / 256; tb += F.G) {
        if (F.tid < 16) { ltot[F.tid] = 0; lpre[F.tid] = 0; }
        __syncthreads();
        { const int pe = F.tid & 15, part = F.tid >> 4; int sa = 0, sp = 0;
#pragma unroll
          for (int k = 0; k < 8; ++k) { const int t = part * 8 + k; const int v = hist[t * 16 + pe]; sa += v; sp += (t < tb) ? v : 0; }
          __hip_atomic_fetch_add(&ltot[pe], sa, __ATOMIC_RELAXED, __HIP_MEMORY_SCOPE_WORKGROUP); __hip_atomic_fetch_add(&lpre[pe], sp, __ATOMIC_RELAXED, __HIP_MEMORY_SCOPE_WORKGROUP); }
        __syncthreads();
        if (F.tid < 2) { int base = 0; for (int e = 0; e < 8; ++e) { ltb[F.tid * 8 + e] = base; base += (ltot[F.tid * 8 + e] + 255) >> 8; } }
        __syncthreads();
        unsigned e01[2] = {0u, 0u}; float w01[2] = {0.f, 0.f}; int rk[2] = {0, 0};
        if (F.tid < 256) {
            const u32x4 rec = *(const u32x4*)(KWS + WS_REC + (size_t)(tb * 256 + F.tid) * 16);
            e01[0] = rec.x; e01[1] = rec.y; w01[0] = __uint_as_float(rec.z); w01[1] = __uint_as_float(rec.w);
#pragma unroll
            for (int p = 0; p < 2; ++p)
#pragma unroll
                for (int ee = 0; ee < 8; ++ee) { const unsigned long long mk = __ballot(e01[p] == (unsigned)ee);
                    if (e01[p] == (unsigned)ee) rk[p] = __builtin_popcountll(mk & ((1ull << F.lane) - 1ull));
                    if (F.lane == 0) lwc[(p * 4 + F.wave) * 8 + ee] = __builtin_popcountll(mk); }
        }
        __syncthreads();
        if (F.tid < 256) {
#pragma unroll
            for (int p = 0; p < 2; ++p) { const int e = (int)e01[p]; int off = 0;
                for (int w = 0; w < F.wave; ++w) off += lwc[(p * 4 + w) * 8 + e];
                const int pos = ltb[p * 8 + e] * 256 + lpre[p * 8 + e] + off + rk[p];
                list[p * LISTN + pos] = tb * 256 + F.tid; wgt[p * LISTN + pos] = w01[p]; }
        }
        if (tb < 16) { const int p = tb >> 3, e = tb & 7; const int lo = ltb[tb] * 256 + ltot[tb], hi = (ltb[tb] + ((ltot[tb] + 255) >> 8)) * 256;
            for (int i = lo + F.tid; i < hi; i += NTHREADS) { list[p * LISTN + i] = (int)0x80000000u; wgt[p * LISTN + i] = 0.f; } (void)e; }
        if (tb == 0 && F.tid < 16) ((int*)(KWS + WS_TOT))[F.tid] = ltot[F.tid];
        __syncthreads();
    }
}
__device__ __forceinline__ void build_group_table(Frame& F, int p, int nN) {
    LAS int* tab = (LAS int*)(F.lds + LC_GT);
    __syncthreads();
    if (F.tid == 0) { const int* tot = (const int*)(KWS + WS_TOT) + p * 8; int ng = 0, ustart = 0, tile = 0;
        for (int e = 0; e < 8; ++e) { int tl = (tot[e] + 255) >> 8;
            while (tl > 0) { const int gsz = tl < 8 ? tl : 8; tab[64 + ng] = ustart; tab[128 + ng] = tile; tab[192 + ng] = gsz; tab[256 + ng] = e; ustart += gsz * nN; tile += gsz; tl -= gsz; ++ng; } }
        tab[0] = ng; tab[1] = ustart; }
    __syncthreads();
}

__device__ __forceinline__ void mixer_unit(Frame& F, const int l, const int unit, const int parts = 0xff) {
    const bf16* P = KPROJ; bf16* MO = KMIXED;
    const int t0 = unit * 128, s0 = t0 & (SEQ - 1), rb = t0 - s0;
    const int lane = F.lane, wave = F.wave, tid = F.tid;
    if (parts & 9) {
        typedef float f32x2 __attribute__((ext_vector_type(2)));
        constexpr int GS = 392;
        LAS bf16* gbuf = (LAS bf16*)F.lds;
        const __amdgpu_buffer_rsrc_t rsw = __builtin_amdgcn_make_buffer_rsrc((void*)(KIN(9) + (size_t)l * CKW * CONVW), (short)0, CKW * CONVW * 4, 0x00020000);
        const __amdgpu_buffer_rsrc_t rsb = __builtin_amdgcn_make_buffer_rsrc((void*)(KIN(10) + (size_t)l * CONVW), (short)0, CONVW * 4, 0x00020000);
        float g6[6], b6[6];
#pragma unroll
        for (int k = 0; k < 3; ++k)
#pragma unroll
            for (int e = 0; e < 2; ++e) { g6[2 * k + e] = KIN(11)[l * CONVW + 128 * k + 2 * lane + e]; b6[2 * k + e] = KIN(12)[l * CONVW + 128 * k + 2 * lane + e]; }
        for (int hf = 0; hf < 2; ++hf) {
            const int sbase = s0 + 64 * hf - 15;
            if (parts & 1) for (int j0 = 0; j0 < 9; j0 += 3) {
                u32x4 va[3], vg[3];
#pragma unroll
                for (int jj = 0; jj < 3; ++jj) { const int i = tid + (j0 + jj) * NTHREADS, rr = i / 48, cp = i - rr * 48, sq = sbase + rr;
                    va[jj] = (u32x4){0u, 0u, 0u, 0u}; vg[jj] = va[jj];
                    if (i < 94 * 48 && sq >= 0 && sq < SEQ) { const bf16* pr = P + (size_t)(rb + sq) * D_IN + 256 + 8 * cp; va[jj] = *(const u32x4*)pr; vg[jj] = *(const u32x4*)(pr + CONVW); } }
#pragma unroll
                for (int jj = 0; jj < 3; ++jj) { const int i = tid + (j0 + jj) * NTHREADS, rr = i / 48, cp = i - rr * 48;
                    if (i < 94 * 48) { u32x4 o;
#pragma unroll
                        for (int d = 0; d < 4; ++d) o[d] = pk2(bflo(va[jj][d]) * fast_sigmoid(bflo(vg[jj][d])), bfhi(va[jj][d]) * fast_sigmoid(bfhi(vg[jj][d])));
                        *(LAS u32x4*)(gbuf + rr * GS + 8 * cp) = o; } }
            }
            __syncthreads();
            if (parts & 8) {
            f32x2 o[3][8];
#pragma unroll
            for (int pg = 0; pg < 3; ++pg) {
                asm volatile("" ::: "memory");
                f32x2 w[31];
#pragma unroll
                for (int j = 0; j < 31; ++j) w[j] = __builtin_bit_cast(f32x2, __builtin_amdgcn_raw_buffer_load_b64(rsw, (unsigned)lane * 8u, (j * CONVW + 128 * pg) * 4, 0));
                const f32x2 bias = __builtin_bit_cast(f32x2, __builtin_amdgcn_raw_buffer_load_b64(rsb, (unsigned)lane * 8u, 128 * pg * 4, 0));
#pragma unroll
                for (int i = 0; i < 8; ++i) o[pg][i] = bias;
                const LAS unsigned* gp = (const LAS unsigned*)gbuf + (8 * wave) * (GS / 2) + 64 * pg + lane;
#pragma unroll
                for (int r = 0; r < 38; ++r) { const unsigned u = gp[r * (GS / 2)]; const f32x2 gl = {bflo(u), bfhi(u)};
#pragma unroll
                    for (int i = 0; i < 8; ++i) if (r - i >= 0 && r - i < 31) o[pg][i] = w[r - i] * gl + o[pg][i]; }
            }
#pragma unroll
            for (int i = 0; i < 8; ++i) { float sm = 0.f, q = 0.f;
#pragma unroll
                for (int pg = 0; pg < 3; ++pg) { sm += o[pg][i][0] + o[pg][i][1]; q += o[pg][i][0] * o[pg][i][0] + o[pg][i][1] * o[pg][i][1]; }
                sm = wave_sum(sm); q = wave_sum(q);
                const float mean = sm * (1.0f / CONVW), var = fmaxf(q * (1.0f / CONVW) - mean * mean, 0.f), rstd = 1.0f / sqrtf(var + EPS);
                unsigned* orow = (unsigned*)(MO + (size_t)(t0 + 64 * hf + 8 * wave + i) * D + 256);
#pragma unroll
                for (int pg = 0; pg < 3; ++pg) { const float o0 = silu_f((o[pg][i][0] - mean) * rstd * g6[2 * pg] + b6[2 * pg]), o1 = silu_f((o[pg][i][1] - mean) * rstd * g6[2 * pg + 1] + b6[2 * pg + 1]);
                    orow[64 * pg + lane] = pk2(o0, o1); } }
            }
            __syncthreads();
        }
    }
    if (parts & 18) {
        constexpr int VS = 136;
        LAS bf16* vnT = (LAS bf16*)F.lds;
        float g6[6], b6[6];
#pragma unroll
        for (int k = 0; k < 3; ++k)
#pragma unroll
            for (int e = 0; e < 2; ++e) { g6[2 * k + e] = KIN(13)[l * CONVW + 128 * k + 2 * lane + e]; b6[2 * k + e] = KIN(14)[l * CONVW + 128 * k + 2 * lane + e]; }
        if (parts & 2) for (int rh = 0; rh < 2; ++rh) {
            unsigned raw[8][3];
#pragma unroll
            for (int r = 0; r < 8; ++r) { const unsigned* pv = (const unsigned*)(P + (size_t)(t0 + wave * 16 + rh * 8 + r) * D_IN + 1408);
#pragma unroll
                for (int k = 0; k < 3; ++k) raw[r][k] = pv[64 * k + lane]; }
#pragma unroll
            for (int r = 0; r < 8; ++r) { const int tk = wave * 16 + rh * 8 + r;
                float v[6]; float s = 0.f, q = 0.f;
#pragma unroll
                for (int k = 0; k < 3; ++k) { v[2 * k] = bflo(raw[r][k]); v[2 * k + 1] = bfhi(raw[r][k]); }
#pragma unroll
                for (int k = 0; k < 6; ++k) { s += v[k]; q += v[k] * v[k]; }
                s = wave_sum(s); q = wave_sum(q);
                const float mean = s * (1.0f / CONVW), var = fmaxf(q * (1.0f / CONVW) - mean * mean, 0.f), rstd = 1.0f / sqrtf(var + EPS);
#pragma unroll
                for (int k = 0; k < 3; ++k)
#pragma unroll
                    for (int e = 0; e < 2; ++e) vnT[(128 * k + 2 * lane + e) * VS + tk] = (bf16)f2bf((v[2 * k + e] - mean) * rstd * g6[2 * k + e] + b6[2 * k + e]);
            }
        }
        __syncthreads();
        const bf16* sw = (const bf16*)(KWS + WS_SGUW);
        const float* sb = KIN(16) + (size_t)l * NH * 128;
        if (parts & 16) {
            bf16x8 wf[2][8]; u32x2 uu[2][2][4];
#define SGU_LOAD(slot, tile) do { const int hh_ = (tile) >> 2, pb_ = (tile) & 3; \
                const bf16* Wh_ = sw + ((size_t)((l * NH + hh_) * 128 + pb_ * 32 + (lane & 31))) * 128 + 8 * (lane >> 5); \
                _Pragma("unroll") for (int ks = 0; ks < 8; ++ks) wf[slot][ks] = *(const bf16x8*)(Wh_ + ks * 16); \
                const bf16* up_ = P + (size_t)(t0 + pb_ * 32 + (lane & 31)) * D_IN + 1024 + hh_ * 64 + 4 * (lane >> 5); \
                _Pragma("unroll") for (int dh = 0; dh < 2; ++dh) _Pragma("unroll") for (int a = 0; a < 4; ++a) uu[slot][dh][a] = *(const u32x2*)(up_ + dh * 32 + 8 * a); } while (0)
            SGU_LOAD(0, wave);
#pragma unroll
            for (int ti = 0; ti < 3; ++ti) { const int tile = wave + 8 * ti, hh = tile >> 2, pb = tile & 3, cs = ti & 1;
                if (ti < 2) { if (ti == 0) SGU_LOAD(1, wave + 8); else SGU_LOAD(0, wave + 16); }
                f32x16 acc0, acc1;
#pragma unroll
                for (int i = 0; i < 16; ++i) { acc0[i] = 0.f; acc1[i] = 0.f; }
                const LAS bf16* Vb = vnT + (hh * 64 + (lane & 31)) * VS + 8 * (lane >> 5);
#pragma unroll
                for (int ks = 0; ks < 8; ++ks) { const bf16x8 v0 = *(const LAS bf16x8*)(Vb + ks * 16), v1 = *(const LAS bf16x8*)(Vb + 32 * VS + ks * 16);
                    acc0 = __builtin_amdgcn_mfma_f32_32x32x16_bf16(v0, wf[cs][ks], acc0, 0, 0, 0); acc1 = __builtin_amdgcn_mfma_f32_32x32x16_bf16(v1, wf[cs][ks], acc1, 0, 0, 0); }
                const int p = pb * 32 + (lane & 31); const size_t row = (size_t)(t0 + p); const float bias = sb[hh * 128 + p];
                bf16* op = MO + row * D + 640 + hh * 64 + 4 * (lane >> 5);
#pragma unroll
                for (int a = 0; a < 4; ++a) {
                    { const unsigned u0 = uu[cs][0][a].x, u1 = uu[cs][0][a].y; u32x2 o; o.x = pk2(bflo(u0) * (acc0[4 * a + 0] + bias), bfhi(u0) * (acc0[4 * a + 1] + bias)); o.y = pk2(bflo(u1) * (acc0[4 * a + 2] + bias), bfhi(u1) * (acc0[4 * a + 3] + bias)); *(u32x2*)(op + 8 * a) = o; }
                    { const unsigned u0 = uu[cs][1][a].x, u1 = uu[cs][1][a].y; u32x2 o; o.x = pk2(bflo(u0) * (acc1[4 * a + 0] + bias), bfhi(u0) * (acc1[4 * a + 1] + bias)); o.y = pk2(bflo(u1) * (acc1[4 * a + 2] + bias), bfhi(u1) * (acc1[4 * a + 3] + bias)); *(u32x2*)(op + 32 + 8 * a) = o; }
                }
            }
#undef SGU_LOAD
        }
        __syncthreads();
    }
    if (parts & 36) {
        constexpr int AS = 264;
        constexpr int DS = 136;
        LAS bf16* abuf = (LAS bf16*)F.lds;
        LAS bf16* dbuf = (LAS bf16*)(F.lds + 144 * AS * 2);
        { u32x4 st[9];
#pragma unroll
          for (int j = 0; j < 9; ++j) { const int i = tid + j * NTHREADS, rr = i >> 5, cp = i & 31; const int sq = s0 - 8 + rr; st[j] = (u32x4){0u, 0u, 0u, 0u};
              if (sq >= 0 && sq < SEQ) st[j] = *(const u32x4*)(P + (size_t)(rb + sq) * D_IN + 8 * cp); }
#pragma unroll
          for (int j = 0; j < 9; ++j) { const int i = tid + j * NTHREADS, rr = i >> 5, cp = i & 31; *(LAS u32x4*)(abuf + rr * AS + 8 * cp) = st[j]; } }
        __syncthreads();
        const bf16* pwt = (const bf16*)(KWS + WS_POOLW) + (size_t)l * 4 * 64 * 64;
        for (int gp = 0; gp < 2; ++gp) {
            if (parts & 4) { const int cc = tid & 127, run = tid >> 7, g = 2 * gp + (cc >> 6), half = 1 << g, ch = g * 64 + (cc & 63);
              const int tk0 = run * 32; float sum = 0.f;
              for (int j = -half; j < half; ++j) sum += bf2f(abuf[(tk0 + j + 8) * AS + ch]);
              for (int k = 0; k < 32; ++k) { const int tk = tk0 + k, sq = s0 + tk; int lo = sq - half; lo = lo < 0 ? 0 : lo; int hi = sq + half; hi = hi > SEQ ? SEQ : hi;
                  const float a = bf2f(abuf[(tk + 8) * AS + ch]);
                  dbuf[tk * DS + cc] = (bf16)f2bf(sum / (float)(hi - lo) - a);
                  sum += bf2f(abuf[(tk + half + 8) * AS + ch]) - bf2f(abuf[(tk - half + 8) * AS + ch]); } }
            __syncthreads();
            if (parts & 32) { const int fr = lane & 15, fq = lane >> 4;
#pragma unroll
              for (int gg = 0; gg < 2; ++gg) { const int g = 2 * gp + gg;
                  bf16x8 af[2];
#pragma unroll
                  for (int ks = 0; ks < 2; ++ks) af[ks] = *(const LAS bf16x8*)(dbuf + (wave * 16 + fr) * DS + gg * 64 + ks * 32 + 8 * fq);
                  bf16* op = MO + (size_t)(t0 + wave * 16 + fr) * D + g * 64 + 4 * fq;
#pragma unroll
                  for (int nt = 0; nt < 4; ++nt) { f32x4 acc = {0.f, 0.f, 0.f, 0.f};
#pragma unroll
                      for (int ks = 0; ks < 2; ++ks) { const bf16x8 wfr = *(const bf16x8*)(pwt + ((size_t)(g * 64 + nt * 16 + fr)) * 64 + ks * 32 + 8 * fq);
                          acc = __builtin_amdgcn_mfma_f32_16x16x32_bf16(wfr, af[ks], acc, 0, 0, 0); }
                      u32x2 o; o.x = pk2(acc[0], acc[1]); o.y = pk2(acc[2], acc[3]); *(u32x2*)(op + nt * 16) = o; } } }
            __syncthreads();
        }
    }
}

__global__ void __launch_bounds__(NTHREADS, 2) fwd_kernel(Args args) {
    extern __shared__ __attribute__((aligned(16))) unsigned char lds_raw[];
    Frame F;
    F.lds = (LAS unsigned char*)lds_raw;
    F.tid = threadIdx.x; F.lane = F.tid & 63; F.wave = __builtin_amdgcn_readfirstlane(F.tid >> 6); F.G = gridDim.x; F.bid = blockIdx.x;
    F.ka = (kargp_t)__builtin_amdgcn_kernarg_segment_ptr(); (void)args;
    for (int u = F.tid; u < (LDS_BYTES - LC_OFF) / 4; u += NTHREADS) ((LAS unsigned*)(F.lds + LC_OFF))[u] = 0u;
    __syncthreads();
    XcdBarrier bar = xcd_barrier_post((unsigned*)(KWS + WS_CTL) + CW_BAR, (volatile LAS unsigned*)(F.lds + LC_MISC) + 8);
#define GRID_BAR() xcd_barrier(bar)
#ifndef PROBE_DUP
#define PROBE_DUP 0
#endif
#ifndef PROBE_MXPARTS
#define PROBE_MXPARTS 7
#endif
#define PROBE_REP(bit) for (int rep_ = 0; rep_ < ((PROBE_DUP & (bit)) ? 2 : 1); ++rep_)
#define MODL(l) (KMOD + (size_t)(l) * BATCH * NMOD)

    PROBE_REP(2 | 1024) { PHASE_ENTER(F); p0_prologue(F); GRID_BAR(); }

#define LAYER_MIX(l) \
    PROBE_REP(2) { PHASE_ENTER(F); if ((l) == 0) norm_phase<0, false>(F, KIN(0), KIN(4) + (l) * D, MODL(l) + 0 * D, MODL(l) + 1 * D, KH, nullptr); \
        else norm_phase<0, true>(F, KXB, KIN(4) + (l) * D, MODL(l) + 0 * D, MODL(l) + 1 * D, KH, nullptr); GRID_BAR(); } \
    PROBE_REP(8) { PHASE_ENTER(F); pg8::DenseOrder S; S.init(KH, (const bf16*)(KWS + WS_WIN) + (size_t)(l) * D_IN * D, M, D_IN, D, F.G, F.bid); \
        pg8::EpiBf16 E{KPROJ, D_IN, (PROBE_DUP & 256) ? rep_ : 0}; pg8::gemm_phase<pg8::EpiBf16, pg8::DenseOrder, false>(F.lds, D, S, E, nullptr, ((PROBE_DUP & 512) && rep_) ? 2 : 1); GRID_BAR(); } \
    PROBE_REP(1) { PHASE_ENTER(F); for (int u = F.bid; u < M / 128; u += F.G) mixer_unit(F, (l), u, ((PROBE_DUP & 1) && rep_ == 0) ? PROBE_MXPARTS : 0xff); GRID_BAR(); } \
    for (int rep_ = 0; rep_ < (((PROBE_DUP & 32) && (l) == 0) ? 2 : 1); ++rep_) { PHASE_ENTER(F); \
        pg8::DenseOrder S; S.init(KMIXED, (const bf16*)(KWS + WS_WOUT) + (size_t)(l) * D * D, M, D, D, F.G, F.bid); \
        if ((l) == 0) { pg8::EpiResidual<true> E{KIN(0), KXB, MODL(l) + 2 * D, 1.0f}; pg8::gemm_phase<pg8::EpiResidual<true>, pg8::DenseOrder, false>(F.lds, D, S, E); } \
        else { pg8::EpiResidual<false> E{KXB, KXB, MODL(l) + 2 * D, 1.0f}; pg8::gemm_phase<pg8::EpiResidual<false>, pg8::DenseOrder, false>(F.lds, D, S, E); } GRID_BAR(); }
#define KACT8(p) ((unsigned char*)(KWS + WS_BIG) + (size_t)(p) * LISTN * FFE)
#define MOE_GU(p, N5, ADV, BAR) \
    PROBE_REP(4 | 2048) { PHASE_ENTER(F); build_group_table(F, (p), 2 * FFE / 256); \
        pg8::MoeOrder S; S.tab = (const LAS int*)(F.lds + LC_GT); S.A = KH; S.Bt = (const bf16*)(KWS + WS_MWGU); S.bstride = (size_t)2 * FFE * D; S.list = (const int*)(KWS + WS_LIST) + (p) * LISTN; \
        S.K = D / 2; S.nN = 2 * FFE / 256; S.G = F.G; S.c = F.bid; S.gather = true; S.n5 = N5; S.adv = ADV; \
        pg8::EpiSwigluF8 E{KACT8(p), FFE, (PROBE_DUP & 2048) ? rep_ : 0}; pg8::gemm_phase<pg8::EpiSwigluF8, pg8::MoeOrder, true, true>(F.lds, D / 2, S, E, (LAS u32x4*)(F.lds + LC_GOFF)); if (BAR) GRID_BAR(); }
#define MOE_DOWN(p, BAR) \
    { PHASE_ENTER(F); build_group_table(F, (p), D / 256); \
        pg8::MoeOrder S; S.tab = (const LAS int*)(F.lds + LC_GT); S.A = (const bf16*)KACT8(p); S.Bt = (const bf16*)(KWS + WS_MWD); S.bstride = (size_t)D * FFE; S.list = nullptr; \
        S.K = FFE / 2; S.nN = D / 256; S.G = F.G; S.c = F.bid; S.gather = false; S.n5 = 0; S.adv = 0; \
        pg8::EpiMoeDown E{KXB, (const int*)(KWS + WS_LIST) + (p) * LISTN, (const float*)(KWS + WS_WGT) + (p) * LISTN, MODL(1) + 5 * D, 1.0f / (SC_A * SC_W), (bf16*)(KWS + WS_DUMP)}; \
        pg8::gemm_phase<pg8::EpiMoeDown, pg8::MoeOrder, false, true>(F.lds, FFE / 2, S, E); if (BAR) GRID_BAR(); \
        if (PROBE_DUP & 128) { pg8::EpiMoeDown E0 = E; E0.ascale = 0.f; pg8::gemm_phase<pg8::EpiMoeDown, pg8::MoeOrder, false, true>(F.lds, FFE / 2, S, E0); GRID_BAR(); } }

    LAYER_MIX(0)
    PROBE_REP(2) { PHASE_ENTER(F); norm_phase<0, true>(F, KXB, KIN(5), MODL(0) + 3 * D, MODL(0) + 4 * D, KH, nullptr); GRID_BAR(); }
    PROBE_REP(16) { PHASE_ENTER(F); pg8::DenseOrder S; S.init(KH, (const bf16*)(KWS + WS_WGU), M, 2 * FF, D, F.G, F.bid);
        pg8::EpiSwiglu E{KACT, FF}; pg8::gemm_phase<pg8::EpiSwiglu, pg8::DenseOrder, false>(F.lds, D, S, E); GRID_BAR(); }
    { PHASE_ENTER(F); pg8::DenseOrder S; S.init(KACT, (const bf16*)(KWS + WS_WD), M, D, FF, F.G, F.bid);
        pg8::EpiResidual<false> E{KXB, KXB, MODL(0) + 5 * D, 1.0f}; pg8::gemm_phase<pg8::EpiResidual<false>, pg8::DenseOrder, false>(F.lds, FF, S, E); GRID_BAR(); }
    if (PROBE_DUP & 64) { PHASE_ENTER(F); pg8::DenseOrder S; S.init(KACT, (const bf16*)(KWS + WS_WD), M, D, FF, F.G, F.bid);
        pg8::EpiResidual<false> E{KXB, KXB, MODL(0) + 5 * D, 0.0f}; pg8::gemm_phase<pg8::EpiResidual<false>, pg8::DenseOrder, false>(F.lds, FF, S, E); GRID_BAR(); }
    LAYER_MIX(1)
    PROBE_REP(2) { PHASE_ENTER(F); norm_phase<1, true>(F, KXB, KIN(5) + D, MODL(1) + 3 * D, MODL(1) + 4 * D, KH, nullptr); GRID_BAR();
        PHASE_ENTER(F); route_phase(F); GRID_BAR(); }
    MOE_GU(0, 0, 0, true)
    { int n5; { const int* tot = (const int*)(KWS + WS_TOT); int tl = 0; for (int e = 0; e < 8; ++e) tl += (tot[e] + 255) >> 8; n5 = (tl * (D / 256)) % F.G; n5 = (n5 + 7) & ~7; if (n5 >= F.G) n5 = 0; }
      MOE_DOWN(0, false)
      MOE_GU(1, n5, (n5 ? 3 : 0), true) }
    MOE_DOWN(1, true)
    if (PROBE_DUP & 4096) { for (int i = 0; i < 20; ++i) GRID_BAR(); }
    { PHASE_ENTER(F); norm_phase<2, true>(F, KXB, KIN(26), nullptr, nullptr, nullptr, KOUT); }
}

extern "C" void kernel_launch(void* const* d_in, const int* in_sizes, int n_in, void* d_out, int out_size, void* d_ws, size_t ws_size, hipStream_t stream) {
    static int grid = 0;
    if (grid == 0) {
        if (n_in != 27 || in_sizes[0] != M * D || out_size != M * D || ws_size < WS_END) { fprintf(stderr, "kernel_launch: unexpected shapes (n_in %d, in0 %d, out %d, ws %zu < %zu); nothing launched\n", n_in, n_in > 0 ? in_sizes[0] : -1, out_size, ws_size, (size_t)WS_END); grid = -1; return; }
        int dev = 0, cus = 0, per_cu = 0;
        if (hipGetDevice(&dev) != hipSuccess || hipDeviceGetAttribute(&cus, hipDeviceAttributeMultiprocessorCount, dev) != hipSuccess) { grid = -1; return; }
        if (hipFuncSetAttribute((const void*)fwd_kernel, hipFuncAttributeMaxDynamicSharedMemorySize, LDS_BYTES) != hipSuccess) { fprintf(stderr, "kernel_launch: hipFuncSetAttribute failed\n"); grid = -1; return; }
        if (hipOccupancyMaxActiveBlocksPerMultiprocessor(&per_cu, (const void*)fwd_kernel, NTHREADS, LDS_BYTES) != hipSuccess || per_cu < 1) { fprintf(stderr, "kernel_launch: occupancy query says %d blocks per CU\n", per_cu); }
        (void)hipGetLastError();
        grid = cus;
    }
    if (grid < 0) return;
    if (hipMemsetAsync((char*)d_ws + WS_CTL, 0, CTL_ZERO_BYTES, stream) != hipSuccess) return;
    Args a{};
    for (int i = 0; i < 27; ++i) a.in[i] = (const float*)d_in[i];
    a.out = (float*)d_out; a.ws = (unsigned char*)d_ws;
    hipLaunchKernelGGL(fwd_kernel, dim3(grid), dim3(NTHREADS), LDS_BYTES, stream, a);
}
```

```cpp
#include <hip/hip_runtime.h>
#include <cstdio>
#include <cstdint>

#define GAS __attribute__((address_space(1)))
#define LAS __attribute__((address_space(3)))
typedef unsigned short bf16;
typedef short bf16x8 __attribute__((ext_vector_type(8)));
typedef float f32x4 __attribute__((ext_vector_type(4)));
typedef float f32x16 __attribute__((ext_vector_type(16)));
typedef unsigned u32x4 __attribute__((ext_vector_type(4)));
typedef unsigned u32x2 __attribute__((ext_vector_type(2)));
typedef int i32x4 __attribute__((ext_vector_type(4)));
typedef int i32x8 __attribute__((ext_vector_type(8)));
constexpr float SC_W = 256.0f, SC_H = 16.0f, SC_A = 4.0f;

constexpr int NWAVES = 8, NTHREADS = 512;
constexpr int BATCH = 8, SEQ = 8192, D = 1024, M = BATCH * SEQ;
constexpr int D_IN = 1792, FF = 2816, FFE = 3584, NE = 8, NMOD = 6 * D;
constexpr int CONVW = 384, CKW = 31, NH = 6;
constexpr float EPS = 1e-6f;
constexpr int LISTN = M + NE * 256;

constexpr size_t MiB = 1u << 20;
constexpr size_t WS_CTL = 0, CTL_ZERO_BYTES = 1 * MiB;
constexpr size_t WS_MOD = 1 * MiB;
constexpr size_t WS_HIST = 2 * MiB;
constexpr size_t WS_TOT = 2 * MiB + 65536;
constexpr size_t WS_DUMP = 2 * MiB + 131072;
constexpr size_t WS_REC = 3 * MiB;
constexpr size_t WS_LIST = 4 * MiB;
constexpr size_t WS_WGT = 5 * MiB;
constexpr size_t WS_SGUW = 6 * MiB;
constexpr size_t WS_POOLW = 6 * MiB + 524288;
constexpr size_t WS_WIN = 8 * MiB;
constexpr size_t WS_WOUT = 15 * MiB;
constexpr size_t WS_WGU = 19 * MiB;
constexpr size_t WS_WD = 30 * MiB;
constexpr size_t WS_MWGU = 36 * MiB;
constexpr size_t WS_MWD = 148 * MiB;
constexpr size_t WS_H = 204 * MiB;
constexpr size_t WS_BIG = 332 * MiB;
constexpr size_t WS_MIXED = WS_BIG + (size_t)M * D_IN * 2;
constexpr size_t WS_ACT_END = WS_BIG + (size_t)LISTN * FFE * 2;
constexpr size_t WS_XB = (WS_ACT_END + 255) / 256 * 256;
constexpr size_t WS_END = WS_XB + (size_t)M * D * 2;
static_assert(WS_MIXED + (size_t)M * D * 2 <= WS_ACT_END && (size_t)M * FF * 2 <= (size_t)LISTN * FFE * 2, "ws map");
constexpr int CW_BAR = 4096;

constexpr int RING_BYTES = 131072;
constexpr int LC_OFF = RING_BYTES;
constexpr int LC_MISC = LC_OFF;
constexpr int LC_HIST = LC_OFF + 64;
constexpr int LC_TOT = LC_OFF + 128;
constexpr int LC_PRE = LC_OFF + 192;
constexpr int LC_TBASE = LC_OFF + 256;
constexpr int LC_WCNT = LC_OFF + 320;
constexpr int LC_GT = LC_OFF + 1024;
constexpr int LC_GOFF = LC_OFF + 4096;
constexpr int LDS_BYTES = RING_BYTES + 4096 + 8192;

__device__ __forceinline__ unsigned f2bf(float f) { unsigned u = __builtin_bit_cast(unsigned, f); return (u + 0x7fffu + ((u >> 16) & 1u)) >> 16; }
__device__ __forceinline__ unsigned pk2(float lo, float hi) { return f2bf(lo) | (f2bf(hi) << 16); }
__device__ __forceinline__ float bf2f(unsigned b) { return __builtin_bit_cast(float, b << 16); }
__device__ __forceinline__ float bflo(unsigned u) { return __builtin_bit_cast(float, u << 16); }
__device__ __forceinline__ float bfhi(unsigned u) { return __builtin_bit_cast(float, u & 0xffff0000u); }
__device__ __forceinline__ float fast_sigmoid(float x) { return __builtin_amdgcn_rcpf(1.0f + __builtin_amdgcn_exp2f(-1.44269504089f * x)); }
__device__ __forceinline__ float silu_f(float x) { return x * fast_sigmoid(x); }
#define WS_DPP(v, ctrl, rmask) __int_as_float(__builtin_amdgcn_update_dpp(0, __float_as_int(v), ctrl, rmask, 0xf, false))
__device__ __forceinline__ float wave_sum(float v) {
    v += WS_DPP(v, 0xB1, 0xf);
    v += WS_DPP(v, 0x4E, 0xf);
    v += WS_DPP(v, 0x141, 0xf);
    v += WS_DPP(v, 0x140, 0xf);
    v += WS_DPP(v, 0x142, 0xa);
    v += WS_DPP(v, 0x143, 0xc);
    return __int_as_float(__builtin_amdgcn_readlane(__float_as_int(v), 63));
}
__device__ __forceinline__ unsigned pk4_fp8(float a, float b, float c, float d) {
    a = __builtin_fminf(__builtin_fmaxf(a, -448.f), 448.f); b = __builtin_fminf(__builtin_fmaxf(b, -448.f), 448.f); c = __builtin_fminf(__builtin_fmaxf(c, -448.f), 448.f); d = __builtin_fminf(__builtin_fmaxf(d, -448.f), 448.f);
    unsigned w = 0; w = __builtin_amdgcn_cvt_pk_fp8_f32(a, b, w, false); w = __builtin_amdgcn_cvt_pk_fp8_f32(c, d, w, true); return w; }
#define LDS_WAIT() asm volatile("s_waitcnt lgkmcnt(0)" ::: "memory")

#define XB_TMO      128
#define XB_XCNT(j)  (256  + 64 * (j))
#define XB_XSUB(j)  (1280 + 64 * (j))
#define XB_XGEN(j)  (2304 + 64 * (j))
#define XB_TOP      3328
#define XB_TOPGEN   3392
#define XCD_BAR_WORDS 3456
#define XB_SPIN_CAP (1u << 18)
__device__ __forceinline__ unsigned xb_ld(unsigned* p)              { return __hip_atomic_load(p, __ATOMIC_RELAXED, __HIP_MEMORY_SCOPE_AGENT); }
__device__ __forceinline__ unsigned xb_add(unsigned* p, unsigned v) { return __hip_atomic_fetch_add(p, v, __ATOMIC_RELAXED, __HIP_MEMORY_SCOPE_AGENT); }
__device__ __forceinline__ unsigned xb_xcc_id() { return (unsigned)__builtin_amdgcn_s_getreg((3 << 11) | 20) & 0xFu; }
#define XB_SPIN(cond, bar) do { unsigned _sp = 0; while (cond) { __builtin_amdgcn_s_sleep(1); \
    if ((++_sp & 255u) == 0u) { if (xb_ld(&(bar)[XB_TMO])) break; if (_sp > XB_SPIN_CAP) { atomicAdd(&(bar)[XB_TMO], 1u); break; } } } } while (0)
struct XcdBarrier { unsigned* bar; unsigned x; volatile LAS unsigned* st; };
__device__ __forceinline__ XcdBarrier xcd_barrier_post(unsigned* bar, volatile LAS unsigned* st) {
    XcdBarrier b; b.bar = bar; b.x = xb_xcc_id(); b.st = st;
    if (threadIdx.x == 0) (void)xb_add(&bar[XB_XCNT(b.x)], 1u);
    return b;
}
__device__ __forceinline__ void xcd_barrier_complete(unsigned* bar, unsigned x, unsigned& nloc, unsigned& nx) {
    const unsigned G = gridDim.x * gridDim.y * gridDim.z;
    unsigned sum, cnt, mine, sp = 0u;
    for (;;) {
        sum = 0u; cnt = 0u; mine = 0u;
#pragma unroll
        for (unsigned j = 0; j < 16; ++j) { const unsigned c = xb_ld(&bar[XB_XCNT(j)]); sum += c; cnt += (c > 0u) ? 1u : 0u; mine = (j == x) ? c : mine; }
        if (sum == G) break;
        __builtin_amdgcn_s_sleep(1);
        if ((++sp & 255u) == 0u) { if (xb_ld(&bar[XB_TMO])) break; if (sp > XB_SPIN_CAP) { atomicAdd(&bar[XB_TMO], 1u); break; } }
    }
    nloc = mine > 0u ? mine : 1u; nx = cnt > 0u ? cnt : 1u;
}
__device__ __forceinline__ void xcd_barrier(const XcdBarrier& b) {
    asm volatile("s_waitcnt vmcnt(0)" ::: "memory");
    __syncthreads();
    if (threadIdx.x == 0) {
        unsigned* bar = b.bar;
        __builtin_amdgcn_s_waitcnt(0);
        unsigned nloc = b.st[0], nx = b.st[1];
        if (nloc == 0u) { xcd_barrier_complete(bar, b.x, nloc, nx); b.st[0] = nloc; b.st[1] = nx; }
        const unsigned old = xb_add(&bar[XB_XSUB(b.x)], 1u);
        const unsigned gen = old / nloc;
        if (old + 1u == (gen + 1u) * nloc) {
            __builtin_amdgcn_fence(__ATOMIC_RELEASE, "agent");
            asm volatile("s_waitcnt vmcnt(0)" ::: "memory");
            const unsigned og = xb_add(&bar[XB_TOP], 1u);
            const unsigned tg = og / nx;
            if (og + 1u == (tg + 1u) * nx) xb_add(&bar[XB_TOPGEN], 1u);
            else XB_SPIN(xb_ld(&bar[XB_TOPGEN]) == tg, bar);
            __builtin_amdgcn_fence(__ATOMIC_ACQUIRE, "agent");
            xb_add(&bar[XB_XGEN(b.x)], 1u);
            asm volatile("s_waitcnt vmcnt(0)" ::: "memory");
        } else {
            XB_SPIN(xb_ld(&bar[XB_XGEN(b.x)]) == gen, bar);
            __builtin_amdgcn_fence(__ATOMIC_ACQUIRE, "agent");
            asm volatile("s_waitcnt vmcnt(0)" ::: "memory");
        }
    }
    __syncthreads();
}

namespace pg8 {
constexpr int BM = 256, BK = 64, HALF = 128, HTB = HALF * BK * 2, STAGE_BYTES = 8 * HTB, NXCD = 8, WGM = 8;
__device__ __forceinline__ int lds_byte(int r, int c) { const int st = (r >> 4) * 2 + (c >> 5), rr = r & 15, cc = c & 31, ob = rr * 64 + cc * 2; return st * 1024 + (ob ^ (((ob >> 9) & 1) << 5)); }
__device__ __forceinline__ void stage_rc(int b, int& R, int& C) { const int st = b / 1024, sb = b % 1024, swz = sb ^ (((sb >> 9) & 1) << 5); R = (st >> 1) * 16 + swz / 64; C = (st & 1) * 32 + (swz % 64) / 2; }
__device__ __forceinline__ int perm32(int rho) { const int n = rho >> 4, i = rho & 15; return 8 * (i >> 2) + 4 * n + (i & 3); }
__device__ __forceinline__ unsigned cvt_pk_bf16(float lo, float hi) { unsigned r; asm volatile("v_cvt_pk_bf16_f32 %0, %1, %2" : "=v"(r) : "v"(lo), "v"(hi)); return r; }

struct Unit { int pm, pn, ex; };

__device__ __forceinline__ int xcd_remap(int wgid, int nwg) { const int q = nwg / NXCD, r = nwg % NXCD, xcd = wgid % NXCD, off = wgid / NXCD; return (xcd < r ? xcd * (q + 1) : r * (q + 1) + (xcd - r) * q) + off; }

struct DenseOrder {
    const bf16* A; const bf16* Bt; int K, nM, nN, nwg, G, c;
    __device__ __forceinline__ void init(const bf16* A_, const bf16* Bt_, int Mr, int N, int K_, int G_, int c_) { A = A_; Bt = Bt_; K = K_; nM = Mr / BM; nN = N / BM; nwg = nM * nN; G = G_; c = c_; }
    __device__ __forceinline__ bool next(int i, Unit& u) const {
        const long L = (long)i * G + c; if (L >= nwg) return false;
        const int wgid = xcd_remap((int)L, nwg);
        const int nig = WGM * nN, gid = wgid / nig, fm = gid * WGM, gsz = (nM - fm) < WGM ? (nM - fm) : WGM;
        u.pm = fm + ((wgid % nig) % gsz); u.pn = (wgid % nig) / gsz; u.ex = 0; return true;
    }
    __device__ __forceinline__ const char* a_ptr(const Unit& u) const { return (const char*)A + (size_t)u.pm * ((size_t)BM * K * 2); }
    __device__ __forceinline__ const char* b_ptr(const Unit& u) const { return (const char*)Bt + (size_t)u.pn * ((size_t)BM * K * 2); }
    __device__ __forceinline__ void rows_raw(const Unit&, int, unsigned (&)[2][2]) const {}
};
struct MoeOrder {
    const LAS int* tab; const bf16* A; const bf16* Bt; size_t bstride; const int* list; int K, nN, G, c; bool gather;
    int n5, adv;
    __device__ __forceinline__ bool next(int i, Unit& u) const {
        const int U = __builtin_amdgcn_readfirstlane(tab[1]), ng = __builtin_amdgcn_readfirstlane(tab[0]);
        long L;
        { const int head = adv * (G - n5);
          if (c >= n5) L = (i < adv) ? (long)i * (G - n5) + (c - n5) : (long)head + (long)(i - adv) * G + c;
          else L = (long)head + (long)i * G + c; }
        if (L >= U) return false;
        const int wgid = xcd_remap((int)L, U);
        int g = 0, hi = ng;
        while (hi - g > 1) { const int mid = (g + hi) >> 1; const int v = __builtin_amdgcn_readfirstlane(tab[64 + mid]); if (v <= wgid) g = mid; else hi = mid; }
        const int g0 = __builtin_amdgcn_readfirstlane(tab[64 + g]), t0 = __builtin_amdgcn_readfirstlane(tab[128 + g]), gsz = __builtin_amdgcn_readfirstlane(tab[192 + g]), ex = __builtin_amdgcn_readfirstlane(tab[256 + g]);
        const int local = wgid - g0;
        u.pm = t0 + local % gsz; u.pn = local / gsz; u.ex = ex; return true;
    }
    __device__ __forceinline__ const char* a_ptr(const Unit& u) const { return gather ? (const char*)A : (const char*)A + (size_t)u.pm * ((size_t)BM * K * 2); }
    __device__ __forceinline__ const char* b_ptr(const Unit& u) const { return (const char*)Bt + (size_t)u.ex * bstride + (size_t)u.pn * ((size_t)BM * K * 2); }
    __device__ __forceinline__ void rows_raw(const Unit& u, int tid, unsigned (&raw)[2][2]) const {
        asm volatile("" : "+v"(tid));
        const __amdgpu_buffer_rsrc_t rs = __builtin_amdgcn_make_buffer_rsrc((void*)(list + (size_t)u.pm * BM), (short)0, BM * 4, 0x00020000);
#pragma unroll
        for (int i = 0; i < 2; ++i) { int R, C; stage_rc(tid * 16 + i * 8192, R, C);
#pragma unroll
            for (int h = 0; h < 2; ++h) raw[h][i] = (unsigned)__builtin_amdgcn_raw_buffer_load_b32(rs, (unsigned)(h * HALF + R) * 4u, 0, 0); }
    }
};

struct EpiBf16 {
    static constexpr bool PERM = true;
    bf16* O; int ldc; int skip;
    __device__ __forceinline__ void operator()(const f32x4 (&acc)[2][2][4][2], const Unit& u, int wr, int wc, int fr, int fq) const {
        const int row0 = u.pm * BM + wr * 64 + fr, col0 = u.pn * BM + wc * 32 + 8 * fq;
        if (skip) { if (acc[0][0][0][0][0] == 12345.678f) O[0] = 1; return; }
#pragma unroll
        for (int ai = 0; ai < 2; ++ai)
#pragma unroll
            for (int m = 0; m < 4; ++m) { bf16* rowp = O + (size_t)(row0 + ai * HALF + m * 16) * ldc + col0;
#pragma unroll
                for (int bj = 0; bj < 2; ++bj) { const f32x4 v0 = acc[ai][bj][m][0], v1 = acc[ai][bj][m][1];
                    u32x4 w; w.x = cvt_pk_bf16(v0[0], v0[1]); w.y = cvt_pk_bf16(v0[2], v0[3]); w.z = cvt_pk_bf16(v1[0], v1[1]); w.w = cvt_pk_bf16(v1[2], v1[3]);
                    *(u32x4*)(rowp + bj * HALF) = w; } }
    }
};
struct EpiSwiglu {
    static constexpr bool PERM = true;
    bf16* O; int ldc;
    __device__ __forceinline__ void operator()(const f32x4 (&acc)[2][2][4][2], const Unit& u, int wr, int wc, int fr, int fq) const {
        const int row0 = u.pm * BM + wr * 64 + fr, col0 = u.pn * HALF + wc * 32 + 8 * fq;
        typedef float f32x2 __attribute__((ext_vector_type(2)));
        bf16* base = O + (size_t)row0 * ldc + col0;
#pragma unroll
        for (int ai = 0; ai < 2; ++ai)
#pragma unroll
            for (int m = 0; m < 4; ++m) { bf16* rowp = base + (size_t)(ai * HALF + m * 16) * ldc;
                float o[8];
#pragma unroll
                for (int n = 0; n < 2; ++n)
#pragma unroll
                    for (int j = 0; j < 4; j += 2) { const f32x2 g = {acc[ai][0][m][n][j], acc[ai][0][m][n][j + 1]}, up = {acc[ai][1][m][n][j], acc[ai][1][m][n][j + 1]};
                        const f32x2 t = g * -1.44269504089f; f32x2 r; r.x = __builtin_amdgcn_rcpf(1.0f + __builtin_amdgcn_exp2f(t.x)); r.y = __builtin_amdgcn_rcpf(1.0f + __builtin_amdgcn_exp2f(t.y));
                        const f32x2 v = (g * r) * up; o[n * 4 + j] = v.x; o[n * 4 + j + 1] = v.y; }
                u32x4 w; w.x = cvt_pk_bf16(o[0], o[1]); w.y = cvt_pk_bf16(o[2], o[3]); w.z = cvt_pk_bf16(o[4], o[5]); w.w = cvt_pk_bf16(o[6], o[7]);
                *(u32x4*)rowp = w; }
    }
};
struct EpiSwigluF8 {
    static constexpr bool PERM = true;
    unsigned char* O; int ldc; int skip; float si;
    __device__ __forceinline__ void operator()(const f32x4 (&acc)[2][2][4][2], const Unit& u, int wr, int wc, int fr, int fq) const {
        const int row0 = u.pm * BM + wr * 64 + fr, col0 = u.pn * HALF + wc * 32 + 8 * fq;
        if (skip) { if (acc[0][0][0][0][0] == 12345.678f) O[0] = 1; return; }
        const float k1 = -1.44269504089f * si, k2 = si * si * SC_A;
        typedef float f32x2 __attribute__((ext_vector_type(2)));
        unsigned char* base = O + (size_t)row0 * ldc + col0;
#pragma unroll
        for (int ai = 0; ai < 2; ++ai)
#pragma unroll
            for (int m = 0; m < 4; ++m) { unsigned char* rowp = base + (size_t)(ai * HALF + m * 16) * ldc;
                float o[8];
#pragma unroll
                for (int n = 0; n < 2; ++n)
#pragma unroll
                    for (int j = 0; j < 4; j += 2) { const f32x2 g = {acc[ai][0][m][n][j], acc[ai][0][m][n][j + 1]}, up = {acc[ai][1][m][n][j], acc[ai][1][m][n][j + 1]};
                        const f32x2 t = g * k1; f32x2 r; r.x = __builtin_amdgcn_rcpf(1.0f + __builtin_amdgcn_exp2f(t.x)); r.y = __builtin_amdgcn_rcpf(1.0f + __builtin_amdgcn_exp2f(t.y));
                        const f32x2 v = (g * r) * (up * k2);
                        o[n * 4 + j] = __builtin_amdgcn_fmed3f(v.x, -448.f, 448.f); o[n * 4 + j + 1] = __builtin_amdgcn_fmed3f(v.y, -448.f, 448.f); }
                u32x2 w; unsigned t0 = 0, t1 = 0;
                t0 = __builtin_amdgcn_cvt_pk_fp8_f32(o[0], o[1], t0, false); t0 = __builtin_amdgcn_cvt_pk_fp8_f32(o[2], o[3], t0, true);
                t1 = __builtin_amdgcn_cvt_pk_fp8_f32(o[4], o[5], t1, false); t1 = __builtin_amdgcn_cvt_pk_fp8_f32(o[6], o[7], t1, true);
                w.x = t0; w.y = t1; *(u32x2*)rowp = w; }
    }
};
template <bool XF32> struct EpiResidual {
    static constexpr bool PERM = true;
    const void* xin; bf16* out; const float* gate; float gs;
    __device__ __forceinline__ void operator()(const f32x4 (&acc)[2][2][4][2], const Unit& u, int wr, int wc, int fr, int fq) const {
        const int row0 = u.pm * BM + wr * 64 + fr, col0 = u.pn * BM + wc * 32 + 8 * fq, b = u.pm >> 5;
        f32x4 gv[2][2];
#pragma unroll
        for (int bj = 0; bj < 2; ++bj)
#pragma unroll
            for (int n = 0; n < 2; ++n) gv[bj][n] = *(const f32x4*)(gate + (size_t)b * NMOD + col0 + bj * HALF + n * 4) * gs;
#pragma unroll
        for (int ai = 0; ai < 2; ++ai) {
            if (XF32) { f32x4 xs[4][2][2];
#pragma unroll
                for (int m = 0; m < 4; ++m)
#pragma unroll
                    for (int bj = 0; bj < 2; ++bj) { const float* p = (const float*)xin + (size_t)(row0 + ai * HALF + m * 16) * D + col0 + bj * HALF; xs[m][bj][0] = *(const f32x4*)p; xs[m][bj][1] = *(const f32x4*)(p + 4); }
#pragma unroll
                for (int m = 0; m < 4; ++m)
#pragma unroll
                    for (int bj = 0; bj < 2; ++bj) { const f32x4 r0 = xs[m][bj][0] + gv[bj][0] * acc[ai][bj][m][0], r1 = xs[m][bj][1] + gv[bj][1] * acc[ai][bj][m][1];
                        u32x4 w; w.x = cvt_pk_bf16(r0[0], r0[1]); w.y = cvt_pk_bf16(r0[2], r0[3]); w.z = cvt_pk_bf16(r1[0], r1[1]); w.w = cvt_pk_bf16(r1[2], r1[3]);
                        *(u32x4*)(out + (size_t)(row0 + ai * HALF + m * 16) * D + col0 + bj * HALF) = w; }
            } else { u32x4 xr[4][2];
#pragma unroll
                for (int m = 0; m < 4; ++m)
#pragma unroll
                    for (int bj = 0; bj < 2; ++bj) xr[m][bj] = *(const u32x4*)((const bf16*)xin + (size_t)(row0 + ai * HALF + m * 16) * D + col0 + bj * HALF);
#pragma unroll
                for (int m = 0; m < 4; ++m)
#pragma unroll
                    for (int bj = 0; bj < 2; ++bj) { const u32x4 t = xr[m][bj];
                        const f32x4 x0 = {bflo(t.x), bfhi(t.x), bflo(t.y), bfhi(t.y)}, x1 = {bflo(t.z), bfhi(t.z), bflo(t.w), bfhi(t.w)};
                        const f32x4 r0 = x0 + gv[bj][0] * acc[ai][bj][m][0], r1 = x1 + gv[bj][1] * acc[ai][bj][m][1];
                        u32x4 w; w.x = cvt_pk_bf16(r0[0], r0[1]); w.y = cvt_pk_bf16(r0[2], r0[3]); w.z = cvt_pk_bf16(r1[0], r1[1]); w.w = cvt_pk_bf16(r1[2], r1[3]);
                        *(u32x4*)(out + (size_t)(row0 + ai * HALF + m * 16) * D + col0 + bj * HALF) = w; }
            }
            asm volatile("" ::: "memory");
        }
    }
};
struct EpiMoeDown {
    static constexpr bool PERM = true;
    bf16* out; const int* list; const float* wgt; const float* gate; float ascale; bf16* dump;
    __device__ __forceinline__ void operator()(const f32x4 (&acc)[2][2][4][2], const Unit& u, int wr, int wc, int fr, int fq) const {
        const int pos0 = u.pm * BM + wr * 64 + fr, col0 = u.pn * BM + wc * 32 + 8 * fq;
        int tk[2][4]; float w[2][4];
#pragma unroll
        for (int ai = 0; ai < 2; ++ai)
#pragma unroll
            for (int m = 0; m < 4; ++m) { const int pos = pos0 + ai * HALF + m * 16; tk[ai][m] = list[pos]; w[ai][m] = wgt[pos] * ascale; }
#pragma unroll
        for (int aq = 0; aq < 4; ++aq) {
            const int ai = aq >> 1, mb = (aq & 1) * 2;
            u32x4 xr[2][2]; f32x4 gq[2][2][2]; bf16* orow[2];
#pragma unroll
            for (int mm = 0; mm < 2; ++mm) { const int t = tk[ai][mb + mm]; orow[mm] = (t >= 0 ? out + (size_t)t * D : dump) + col0; const float* gp = gate + (size_t)(t >= 0 ? (t >> 13) : 0) * NMOD + col0;
#pragma unroll
                for (int bj = 0; bj < 2; ++bj) { xr[mm][bj] = *(const u32x4*)(orow[mm] + bj * HALF); gq[mm][bj][0] = *(const f32x4*)(gp + bj * HALF); gq[mm][bj][1] = *(const f32x4*)(gp + bj * HALF + 4); } }
#pragma unroll
            for (int mm = 0; mm < 2; ++mm)
#pragma unroll
                for (int bj = 0; bj < 2; ++bj) { const u32x4 t = xr[mm][bj]; const float ww = w[ai][mb + mm];
                    const f32x4 x0 = {bflo(t.x), bfhi(t.x), bflo(t.y), bfhi(t.y)}, x1 = {bflo(t.z), bfhi(t.z), bflo(t.w), bfhi(t.w)};
                    const f32x4 r0 = x0 + (gq[mm][bj][0] * ww) * acc[ai][bj][mb + mm][0], r1 = x1 + (gq[mm][bj][1] * ww) * acc[ai][bj][mb + mm][1];
                    u32x4 o; o.x = cvt_pk_bf16(r0[0], r0[1]); o.y = cvt_pk_bf16(r0[2], r0[3]); o.z = cvt_pk_bf16(r1[0], r1[1]); o.w = cvt_pk_bf16(r1[2], r1[3]);
                    *(u32x4*)(orow[mm] + bj * HALF) = o; }
            asm volatile("" ::: "memory");
        }
    }
};

template <class Epi, class Sched, bool GATHER, bool FP8 = false>
__device__ __forceinline__ void gemm_phase(LAS unsigned char* lds, const int K, const Sched& S, const Epi& E, LAS u32x4* goff = nullptr, int ntdiv = 1) {
    int tid_ = threadIdx.x; asm volatile("" : "+v"(tid_));
    const int tid = tid_, wid = __builtin_amdgcn_readfirstlane(tid >> 6), lane = tid & 63, wr = wid >> 2, wc = wid & 3, fr = lane & 15, fq = lane >> 4;
    int nt = K / BK / ntdiv; asm volatile("" : "+s"(nt));
    unsigned voffB[2], ao[2][2], no[2][2];
    const size_t kstep = (size_t)(BK * 2);
    const size_t hstep = (size_t)HALF * K * 2;
#pragma unroll
    for (int i = 0; i < 2; ++i) { int R, C; stage_rc(tid * 16 + i * 8192, R, C); const int Rb = Epi::PERM ? ((R & ~31) + perm32(R & 31)) : R;
        voffB[i] = (unsigned)(Rb * K + C) * 2u;
        ao[0][i] = (unsigned)(R * K + C) * 2u; ao[1][i] = ao[0][i] + (unsigned)hstep; no[0][i] = ao[0][i]; no[1][i] = ao[1][i]; }
    const unsigned ldsw = (unsigned)wid * 1024u;
    const int aoff = lds_byte(wr * 64 + fr, fq * 8), boff = lds_byte(wc * 32 + fr, fq * 8);
#define PG8_CB(i) ([&]() { int t_ = tid; asm volatile("" : "+v"(t_)); int R_, C_; stage_rc(t_ * 16 + (i) * 8192, R_, C_); return (unsigned)C_ * 2u; }())
#define PG8_SA(b, h) (((b) * 2 + (h)) * HTB)
#define PG8_SB(b, h) ((4 + (b) * 2 + (h)) * HTB)
#define PG8_STAGEB(bufoff, gbase) do { _Pragma("unroll") for (int _i = 0; _i < 2; ++_i) \
        __builtin_amdgcn_global_load_lds((const unsigned*)((const char*)(gbase) + voffB[_i]), (LAS unsigned*)(lds + (bufoff) + ldsw + _i * 8192), 16, 0, 0); } while (0)
#define PG8_STAGEA(bufoff, gbase, offs, h) do { _Pragma("unroll") for (int _i = 0; _i < 2; ++_i) \
        __builtin_amdgcn_global_load_lds((const unsigned*)((const char*)(gbase) + (offs)[h][_i]), (LAS unsigned*)(lds + (bufoff) + ldsw + _i * 8192), 16, 0, 0); } while (0)
#define PG8_LD32(p) __builtin_shufflevector(*(const LAS i32x4*)(p), *(const LAS i32x4*)((p) + 1024), 0, 1, 2, 3, 4, 5, 6, 7)
#define PG8_LDA(dst, b, h) do { _Pragma("unroll") for (int m = 0; m < 4; ++m) { if constexpr (FP8) dst##8[m] = PG8_LD32(lds + PG8_SA(b, h) + aoff + m * 2048); \
        else { _Pragma("unroll") for (int k = 0; k < 2; ++k) dst[m][k] = *(const LAS bf16x8*)(lds + PG8_SA(b, h) + aoff + m * 2048 + k * 1024); } } } while (0)
#define PG8_LDB(dst, b, h) do { _Pragma("unroll") for (int n = 0; n < 2; ++n) { if constexpr (FP8) dst##8[n] = PG8_LD32(lds + PG8_SB(b, h) + boff + n * 2048); \
        else { _Pragma("unroll") for (int k = 0; k < 2; ++k) dst[n][k] = *(const LAS bf16x8*)(lds + PG8_SB(b, h) + boff + n * 2048 + k * 1024); } } } while (0)
#define PG8_MMA(ai, bj, At, Bt) do { __builtin_amdgcn_s_setprio(1); _Pragma("unroll") for (int m = 0; m < 4; ++m) _Pragma("unroll") for (int n = 0; n < 2; ++n) { \
        if constexpr (FP8) asm volatile("v_mfma_scale_f32_16x16x128_f8f6f4 %0, %1, %2, %0, %3, %3 op_sel_hi:[0,0,0]" : "+v"(acc[ai][bj][m][n]) : "v"(Bt##8[n]), "v"(At##8[m]), "v"(sc1));     \
        else { _Pragma("unroll") for (int k = 0; k < 2; ++k) acc[ai][bj][m][n] = __builtin_amdgcn_mfma_f32_16x16x32_bf16(Bt[n][k], At[m][k], acc[ai][bj][m][n], 0, 0, 0); } } \
        __builtin_amdgcn_s_setprio(0); } while (0)
#define PG8_WAIT_V(n) asm volatile("s_waitcnt vmcnt(" #n ")" ::: "memory")
#define PG8_WAIT_L(n) asm volatile("s_waitcnt lgkmcnt(" #n ")" ::: "memory")
#define PG8_BAR __builtin_amdgcn_s_barrier()
#define PG8_SCHED __builtin_amdgcn_sched_barrier(0)
    Unit cur, nxt, nn; int ui = 0;
    if (!S.next(0, cur)) return;
    bool has_next = S.next(1, nxt);
    if constexpr (GATHER) {
        unsigned raw[2][2]; S.rows_raw(cur, tid, raw);
#pragma unroll
        for (int h = 0; h < 2; ++h)
#pragma unroll
            for (int i = 0; i < 2; ++i) ao[h][i] = (raw[h][i] & 0xffffffu) * (unsigned)(K * 2) + PG8_CB(i);
        if (has_next) { S.rows_raw(nxt, tid, raw);
#pragma unroll
            for (int h = 0; h < 2; ++h)
#pragma unroll
                for (int i = 0; i < 2; ++i) no[h][i] = (raw[h][i] & 0xffffffu) * (unsigned)(K * 2) + PG8_CB(i); }
        else {
#pragma unroll
            for (int h = 0; h < 2; ++h)
#pragma unroll
                for (int i = 0; i < 2; ++i) no[h][i] = ao[h][i]; }
        goff[tid] = (u32x4){no[0][0], no[0][1], no[1][0], no[1][1]};
    }
    f32x4 acc[2][2][4][2];
#pragma unroll
    for (int a = 0; a < 2; ++a)
#pragma unroll
        for (int b = 0; b < 2; ++b)
#pragma unroll
            for (int m = 0; m < 4; ++m)
#pragma unroll
                for (int n = 0; n < 2; ++n) acc[a][b][m][n] = (f32x4){0.f, 0.f, 0.f, 0.f};
    const int sc1 = 0x7f7f7f7f;
    bf16x8 At[4][2], B0[2][2], B1[2][2];
    i32x8 At8[4], B08[2], B18[2];
    const char* cA = S.a_ptr(cur); const char* cB = S.b_ptr(cur);
    PG8_STAGEB(PG8_SB(0, 0), cB); PG8_STAGEB(PG8_SB(0, 1), cB + hstep); PG8_STAGEA(PG8_SA(0, 0), cA, ao, 0); PG8_STAGEA(PG8_SA(0, 1), cA, ao, 1);
    if (wr == 1) PG8_BAR;
    PG8_WAIT_V(2); PG8_BAR;
    PG8_STAGEB(PG8_SB(1, 0), cB + kstep); PG8_STAGEA(PG8_SA(1, 0), cA + kstep, ao, 0); PG8_STAGEB(PG8_SB(1, 1), cB + hstep + kstep);
    PG8_WAIT_V(6); PG8_BAR;
    for (;;) {
        const char* nA = has_next ? S.a_ptr(nxt) : cA; const char* nB = has_next ? S.b_ptr(nxt) : cB;
#pragma clang loop unroll(disable)
        for (int t = 0; t < nt; t += 2) {
            const bool last = (t == nt - 2);
            const char* a1 = cA + (size_t)(t + 1) * kstep;
            const char* a2 = last ? nA : cA + (size_t)(t + 2) * kstep; const char* b2 = last ? nB : cB + (size_t)(t + 2) * kstep;
            const char* a3 = a2 + kstep; const char* b3 = b2 + kstep;
            asm volatile("" : "+v"(voffB[0]), "+v"(voffB[1]), "+v"(ao[0][0]), "+v"(ao[0][1]), "+v"(ao[1][0]), "+v"(ao[1][1]));
            PG8_LDB(B0, 0, 0); PG8_LDB(B1, 0, 1); PG8_SCHED; PG8_LDA(At, 0, 0); PG8_STAGEA(PG8_SA(1, 1), a1, ao, 1);
            if constexpr (GATHER) { if (last) { const u32x4 q = goff[tid]; ao[0][0] = q[0]; ao[0][1] = q[1]; ao[1][0] = q[2]; ao[1][1] = q[3]; } }
            PG8_WAIT_V(8); PG8_WAIT_L(0); PG8_BAR; PG8_MMA(0, 0, At, B0); PG8_MMA(0, 1, At, B1); PG8_BAR; PG8_SCHED;
            PG8_LDA(At, 0, 1); PG8_STAGEB(PG8_SB(0, 0), b2); PG8_STAGEB(PG8_SB(0, 1), b2 + hstep); PG8_STAGEA(PG8_SA(0, 0), a2, ao, 0);
            PG8_WAIT_V(8); PG8_WAIT_L(0); PG8_BAR; PG8_MMA(1, 0, At, B0); PG8_MMA(1, 1, At, B1); PG8_BAR; PG8_SCHED;
            PG8_LDB(B0, 1, 0); PG8_LDB(B1, 1, 1); PG8_SCHED; PG8_LDA(At, 1, 0); PG8_STAGEA(PG8_SA(0, 1), a2, ao, 1);
            PG8_WAIT_V(8); PG8_WAIT_L(0); PG8_BAR; PG8_MMA(0, 0, At, B0); PG8_MMA(0, 1, At, B1); PG8_BAR; PG8_SCHED;
            PG8_LDA(At, 1, 1); PG8_STAGEB(PG8_SB(1, 0), b3); PG8_STAGEB(PG8_SB(1, 1), b3 + hstep); PG8_STAGEA(PG8_SA(1, 0), a3, ao, 0);
            PG8_WAIT_V(8); PG8_WAIT_L(0); PG8_BAR; PG8_MMA(1, 0, At, B0); PG8_MMA(1, 1, At, B1); PG8_BAR; PG8_SCHED;
        }
        if (wr == 0) PG8_BAR;
        if constexpr (FP8) asm volatile("s_nop 15\n\ts_nop 15\n\ts_nop 7" ::: "memory");
        bool has_nn = false; unsigned raw[2][2];
        if (has_next) has_nn = S.next(ui + 2, nn);
        if constexpr (GATHER) { if (has_nn) S.rows_raw(nn, tid, raw); }
        E(acc, cur, wr, wc, fr, fq);
        if (!has_next) break;
#pragma unroll
        for (int a = 0; a < 2; ++a)
#pragma unroll
            for (int b = 0; b < 2; ++b)
#pragma unroll
                for (int m = 0; m < 4; ++m)
#pragma unroll
                    for (int n = 0; n < 2; ++n) acc[a][b][m][n] = (f32x4){0.f, 0.f, 0.f, 0.f};
        if constexpr (GATHER) {
            if (has_nn) { u32x4 q;
#pragma unroll
                for (int h = 0; h < 2; ++h)
#pragma unroll
                    for (int i = 0; i < 2; ++i) q[h * 2 + i] = (raw[h][i] & 0xffffffu) * (unsigned)(K * 2) + PG8_CB(i);
                goff[tid] = q; }
        }
        cur = nxt; cA = nA; cB = nB; nxt = nn; has_next = has_nn; ++ui;
        if (wr == 1) PG8_BAR;
    }
    PG8_WAIT_V(0);
    PG8_BAR;
#undef PG8_SA
#undef PG8_CB
#undef PG8_SB
#undef PG8_STAGEA
#undef PG8_STAGEB
#undef PG8_LDA
#undef PG8_LDB
#undef PG8_MMA
#undef PG8_LD32
#undef PG8_WAIT_V
#undef PG8_WAIT_L
#undef PG8_BAR
#undef PG8_SCHED
}
}

struct Args { const float* in[27]; float* out; unsigned char* ws; };
typedef const float* cfp_t;
typedef __attribute__((address_space(4))) const cfp_t* kargp_t;
struct Frame {
    LAS unsigned char* lds;
    int tid, lane, wave, G, bid;
    kargp_t ka;
};
#define PHASE_ENTER(F) do { kargp_t _p = (F).ka; asm volatile("" : "+s"(_p)); (F).ka = _p; \
    int _t = threadIdx.x; asm volatile("" : "+v"(_t)); (F).tid = _t; (F).lane = _t & 63; (F).wave = __builtin_amdgcn_readfirstlane(_t >> 6); \
    int _g = gridDim.x; asm volatile("" : "+s"(_g)); (F).G = _g; int _b = blockIdx.x; asm volatile("" : "+s"(_b)); (F).bid = _b; } while (0)
#define KIN(k) ((F).ka[k])
#define KOUT ((float*)(F).ka[27])
#define KWS ((unsigned char*)(F).ka[28])
#define KMOD ((float*)(KWS + WS_MOD))
#define KH ((bf16*)(KWS + WS_H))
#define KPROJ ((bf16*)(KWS + WS_BIG))
#define KMIXED ((bf16*)(KWS + WS_MIXED))
#define KACT ((bf16*)(KWS + WS_BIG))
#define KXB ((bf16*)(KWS + WS_XB))

__device__ __forceinline__ void p0_transpose_item(const float* W, int K, int N, bf16* WT, int dst_row0, LAS float* scr, int kb, int nb, int lane) {
    const int k0 = 64 * kb, n0 = 32 * nb;
    { f32x4 t[8];
#pragma unroll
      for (int i = 0; i < 8; ++i) t[i] = __builtin_nontemporal_load((const f32x4*)(W + (size_t)(k0 + 8 * i + (lane >> 3)) * N + n0 + 4 * (lane & 7)));
#pragma unroll
      for (int i = 0; i < 8; ++i) { LAS float* d = scr + (8 * i + (lane >> 3)) * 33 + 4 * (lane & 7); d[0] = t[i][0]; d[1] = t[i][1]; d[2] = t[i][2]; d[3] = t[i][3]; } }
    LDS_WAIT(); asm volatile("" ::: "memory");
    const int c = lane & 7;
#pragma unroll
    for (int j = 0; j < 4; ++j) { const int n = (lane >> 3) + 8 * j; const LAS float* s = scr + (8 * c) * 33 + n;
        u32x4 o; o.x = pk2(s[0 * 33], s[1 * 33]); o.y = pk2(s[2 * 33], s[3 * 33]); o.z = pk2(s[4 * 33], s[5 * 33]); o.w = pk2(s[6 * 33], s[7 * 33]);
        *(u32x4*)(WT + (size_t)(dst_row0 + n) * K + k0 + 8 * c) = o; }
    LDS_WAIT(); asm volatile("" ::: "memory");
}
__device__ __forceinline__ void p0_transpose_item_f8(const float* W, int K, int N, unsigned char* WT, int dst_row0, LAS float* scr, int kb, int nb, int lane) {
    const int k0 = 64 * kb, n0 = 32 * nb;
    { f32x4 t[8];
#pragma unroll
      for (int i = 0; i < 8; ++i) t[i] = __builtin_nontemporal_load((const f32x4*)(W + (size_t)(k0 + 8 * i + (lane >> 3)) * N + n0 + 4 * (lane & 7)));
#pragma unroll
      for (int i = 0; i < 8; ++i) { LAS float* d = scr + (8 * i + (lane >> 3)) * 33 + 4 * (lane & 7); d[0] = t[i][0]; d[1] = t[i][1]; d[2] = t[i][2]; d[3] = t[i][3]; } }
    LDS_WAIT(); asm volatile("" ::: "memory");
    const int n = lane >> 1, kh = (lane & 1) * 32; const LAS float* sp = scr + kh * 33 + n;
#pragma unroll
    for (int q = 0; q < 2; ++q) { u32x4 o;
#pragma unroll
        for (int d = 0; d < 4; ++d) { const int kk = q * 16 + d * 4; o[d] = pk4_fp8(sp[(kk + 0) * 33] * SC_W, sp[(kk + 1) * 33] * SC_W, sp[(kk + 2) * 33] * SC_W, sp[(kk + 3) * 33] * SC_W); }
        *(u32x4*)(WT + (size_t)(dst_row0 + n) * K + k0 + kh + q * 16) = o; }
    LDS_WAIT(); asm volatile("" ::: "memory");
}
__device__ __forceinline__ int gu_row(int n) { return (n >> 7) * 256 + (n & 127); }

__device__ __forceinline__ void p0_prologue(Frame& F) {
    if (F.bid < 192) {
        LAS float* cond = (LAS float*)F.lds;
        LAS float* red = (LAS float*)(F.lds + 32768);
        const float* cin = KIN(1);
        for (int i = F.tid; i < BATCH * D; i += NTHREADS) cond[i] = silu_f(cin[i]);
        __syncthreads();
        for (int item = F.bid; item < 192; item += F.G) {
            const int l = item / 96, colbase = (item % 96) * 64, col = colbase + F.lane;
            const float* W = KIN(2) + (size_t)l * D * NMOD;
            float a[8];
#pragma unroll
            for (int b = 0; b < 8; ++b) a[b] = 0.f;
            for (int k0 = F.wave * 128; k0 < F.wave * 128 + 128; k0 += 16) { float w[16];
#pragma unroll
                for (int i = 0; i < 16; ++i) w[i] = W[(size_t)(k0 + i) * NMOD + col];
#pragma unroll
                for (int i = 0; i < 16; ++i)
#pragma unroll
                    for (int b = 0; b < 8; ++b) a[b] = fmaf(cond[b * D + k0 + i], w[i], a[b]); }
#pragma unroll
            for (int b = 0; b < 8; ++b) red[(F.wave * 8 + b) * 64 + F.lane] = a[b];
            __syncthreads();
            { const int b = F.tid >> 6, cl = F.tid & 63; float s = 0.f;
#pragma unroll
              for (int w = 0; w < 8; ++w) s += red[(w * 8 + b) * 64 + cl];
              KMOD[((size_t)l * BATCH + b) * NMOD + colbase + cl] = s + KIN(3)[(size_t)l * NMOD + colbase + cl]; }
            __syncthreads();
        }
    }
    LAS float* scr = (LAS float*)(F.lds + F.wave * 16384);
    const int gw = F.bid * NWAVES + F.wave, NGW = F.G * NWAVES;
    constexpr int I_IN = 16 * 56, I_OUT = 16 * 32, I_FG = 16 * 88, I_FD = 44 * 32, I_MG = 16 * 112, I_MD = 56 * 32;
    constexpr int NITEMS = 2 * I_IN + 2 * I_OUT + 2 * I_FG + I_FD + 16 * I_MG + 8 * I_MD;
    bf16* ws_b = (bf16*)KWS;
    for (int it = gw; it < NITEMS; it += NGW) {
        int r = it;
        if (r < 2 * I_IN) { const int l = r / I_IN; r -= l * I_IN; const int kb = r / 56, nb = r % 56;
            p0_transpose_item(KIN(6) + (size_t)l * D * D_IN, D, D_IN, (bf16*)(KWS + WS_WIN) + (size_t)l * D_IN * D, 32 * nb, scr, kb, nb, F.lane); continue; } r -= 2 * I_IN;
        if (r < 2 * I_OUT) { const int l = r / I_OUT; r -= l * I_OUT; const int kb = r / 32, nb = r % 32;
            p0_transpose_item(KIN(17) + (size_t)l * D * D, D, D, (bf16*)(KWS + WS_WOUT) + (size_t)l * D * D, 32 * nb, scr, kb, nb, F.lane); continue; } r -= 2 * I_OUT;
        if (r < 2 * I_FG) { const int up = r / I_FG; r -= up * I_FG; const int kb = r / 88, nb = r % 88;
            p0_transpose_item(up ? KIN(19) : KIN(18), D, FF, (bf16*)(KWS + WS_WGU), gu_row(32 * nb) + 128 * up, scr, kb, nb, F.lane); continue; } r -= 2 * I_FG;
        if (r < I_FD) { const int kb = r / 32, nb = r % 32;
            p0_transpose_item_f8(KIN(20), FF, D, (unsigned char*)(KWS + WS_WD), 32 * nb, scr, kb, nb, F.lane); continue; } r -= I_FD;
        if (r < 16 * I_MG) { const int q = r / I_MG; r -= q * I_MG; const int up = q >> 3, e = q & 7; const int kb = r / 112, nb = r % 112;
            p0_transpose_item_f8((up ? KIN(24) : KIN(23)) + (size_t)e * D * FFE, D, FFE, (unsigned char*)(KWS + WS_MWGU) + (size_t)e * 2 * FFE * D, gu_row(32 * nb) + 128 * up, scr, kb, nb, F.lane); continue; } r -= 16 * I_MG;
        { const int e = r / I_MD; r -= e * I_MD; const int kb = r / 32, nb = r % 32;
            p0_transpose_item_f8(KIN(25) + (size_t)e * FFE * D, FFE, D, (unsigned char*)(KWS + WS_MWD) + (size_t)e * D * FFE, 32 * nb, scr, kb, nb, F.lane); }
    }
    (void)ws_b;
    if (F.bid == 0) for (int i = F.tid; i < D; i += NTHREADS) ((float*)(KWS + WS_DUMP))[i] = 0.f;
    { bf16* pw = (bf16*)(KWS + WS_POOLW);
      for (int i = F.bid * NTHREADS + F.tid; i < 2 * 4 * 64 * 64; i += F.G * NTHREADS) { const int c = i & 63, d = (i >> 6) & 63, lg = i >> 12;
          pw[i] = (bf16)f2bf(KIN(7)[((size_t)lg * 64 + c) * 64 + d] * KIN(8)[lg * 64 + d]); } }
    { const float* sw = KIN(15); bf16* so = (bf16*)(KWS + WS_SGUW);
      for (int i = (F.bid * NTHREADS + F.tid) * 4; i < 2 * NH * 128 * 128; i += F.G * NTHREADS * 4) { const f32x4 v = *(const f32x4*)(sw + i); u32x2 o; o.x = pk2(v[0], v[1]); o.y = pk2(v[2], v[3]); *(u32x2*)(so + i) = o; } }
}

template <int MODE, bool SRCB>
__device__ __forceinline__ void norm_phase(Frame& F, const void* xsrc, const float* g, const float* shiftp, const float* scalep, bf16* hdst, float* fdst) {
    LAS int* lhist = (LAS int*)(F.lds + LC_HIST);
    for (int tb = F.bid; tb < M / 256; tb += F.G) {
        const int row0 = tb * 256 + F.wave * 32, b = row0 >> 13;
        f32x4 gm[4], sh[4];
#pragma unroll
        for (int j = 0; j < 4; ++j) { const int col = 4 * F.lane + 256 * j; const f32x4 gg = *(const f32x4*)(g + col);
            if (MODE == 2) { gm[j] = gg; sh[j] = (f32x4){0.f, 0.f, 0.f, 0.f}; }
            else { const f32x4 sc = *(const f32x4*)(scalep + (size_t)b * NMOD + col); gm[j] = gg * (1.0f + sc); sh[j] = *(const f32x4*)(shiftp + (size_t)b * NMOD + col); } }
        float rbias[8];
        LAS float* rwl = (LAS float*)F.lds;
        if (MODE == 1) {
            for (int i = F.tid; i < D * NE; i += NTHREADS) rwl[(i & 7) * D + (i >> 3)] = KIN(21)[i];
#pragma unroll
            for (int e = 0; e < 8; ++e) rbias[e] = KIN(22)[e];
            if (F.tid < 16) lhist[F.tid] = 0;
            __syncthreads();
        }
        for (int rq = 0; rq < 32; rq += 4) {
            f32x4 vv[4][4];
#pragma unroll
            for (int rr = 0; rr < 4; ++rr) { const int row = row0 + rq + rr;
                if (SRCB) { const u32x2* xr = (const u32x2*)((const bf16*)xsrc + (size_t)row * D) + F.lane;
#pragma unroll
                    for (int j = 0; j < 4; ++j) { const u32x2 t = xr[64 * j]; vv[rr][j] = (f32x4){bflo(t.x), bfhi(t.x), bflo(t.y), bfhi(t.y)}; } }
                else { const f32x4* xr = (const f32x4*)((const float*)xsrc + (size_t)row * D) + F.lane;
#pragma unroll
                    for (int j = 0; j < 4; ++j) vv[rr][j] = xr[64 * j]; } }
#pragma unroll
            for (int rr = 0; rr < 4; ++rr) {
            const int row = row0 + rq + rr;
            f32x4 v[4]; float ss = 0.f;
#pragma unroll
            for (int j = 0; j < 4; ++j) v[j] = vv[rr][j];
#pragma unroll
            for (int j = 0; j < 4; ++j) { ss += (v[j][0] * v[j][0] + v[j][1] * v[j][1]) + (v[j][2] * v[j][2] + v[j][3] * v[j][3]); }
            const float rstd = 1.0f / sqrtf(wave_sum(ss) * (1.0f / D) + EPS);
#pragma unroll
            for (int j = 0; j < 4; ++j) v[j] = (v[j] * rstd) * gm[j] + sh[j];
            if (MODE == 2) { f32x4* o = (f32x4*)(fdst + (size_t)row * D) + F.lane;
#pragma unroll
                for (int j = 0; j < 4; ++j) o[64 * j] = v[j]; }
            else if (MODE == 1) { unsigned* o = (unsigned*)((unsigned char*)hdst + (size_t)row * D) + F.lane;
#pragma unroll
                for (int j = 0; j < 4; ++j) o[64 * j] = pk4_fp8(v[j][0] * SC_H, v[j][1] * SC_H, v[j][2] * SC_H, v[j][3] * SC_H); }
            else { u32x2* o = (u32x2*)(hdst + (size_t)row * D) + F.lane;
#pragma unroll
                for (int j = 0; j < 4; ++j) { u32x2 w; w.x = pk2(v[j][0], v[j][1]); w.y = pk2(v[j][2], v[j][3]); o[64 * j] = w; } }
            if (MODE == 1) {
                float lg[8];
#pragma unroll
                for (int e = 0; e < 8; ++e) lg[e] = 0.f;
#pragma unroll
                for (int e = 0; e < 8; ++e)
#pragma unroll
                    for (int j = 0; j < 4; ++j) { const f32x4 wv = *(const LAS f32x4*)(rwl + e * D + 4 * F.lane + 256 * j);
                        lg[e] = fmaf(v[j][0], wv[0], lg[e]); lg[e] = fmaf(v[j][1], wv[1], lg[e]); lg[e] = fmaf(v[j][2], wv[2], lg[e]); lg[e] = fmaf(v[j][3], wv[3], lg[e]); }
#pragma unroll
                for (int e = 0; e < 8; ++e) lg[e] = wave_sum(lg[e]) + rbias[e];
                int i1 = 0; float v1 = lg[0];
#pragma unroll
                for (int e = 1; e < 8; ++e) if (lg[e] > v1) { v1 = lg[e]; i1 = e; }
                int i2 = -1; float v2 = -3.0e38f;
#pragma unroll
                for (int e = 0; e < 8; ++e) if (e != i1 && lg[e] > v2) { v2 = lg[e]; i2 = e; }
                const float ex = __expf(v2 - v1), w1 = 1.0f / (1.0f + ex), w2 = ex * w1;
                if (F.lane == 0) { u32x4 rec; rec.x = (unsigned)i1; rec.y = (unsigned)i2; rec.z = __float_as_uint(w1); rec.w = __float_as_uint(w2);
                    *(u32x4*)(KWS + WS_REC + (size_t)row * 16) = rec; __hip_atomic_fetch_add(&lhist[i1], 1, __ATOMIC_RELAXED, __HIP_MEMORY_SCOPE_WORKGROUP); __hip_atomic_fetch_add(&lhist[8 + i2], 1, __ATOMIC_RELAXED, __HIP_MEMORY_SCOPE_WORKGROUP); }
            }
        }
        }
        if (MODE == 1) { __syncthreads(); if (F.tid < 16) ((int*)(KWS + WS_HIST))[tb * 16 + F.tid] = lhist[F.tid]; __syncthreads(); }
    }
}

__device__ __forceinline__ void route_phase(Frame& F) {
    LAS int* ltot = (LAS int*)(F.lds + LC_TOT); LAS int* lpre = (LAS int*)(F.lds + LC_PRE); LAS int* ltb = (LAS int*)(F.lds + LC_TBASE); LAS int* lwc = (LAS int*)(F.lds + LC_WCNT);
    const int* hist = (const int*)(KWS + WS_HIST);
    int* list = (int*)(KWS + WS_LIST); float* wgt = (float*)(KWS + WS_WGT);
    for (int tb = F.bid; tb < M / 256; tb += F.G) {
        if (F.tid < 16) { ltot[F.tid] = 0; lpre[F.tid] = 0; }
        __syncthreads();
        { const int pe = F.tid & 15, part = F.tid >> 4; int sa = 0, sp = 0;
#pragma unroll
          for (int k = 0; k < 8; ++k) { const int t = part * 8 + k; const int v = hist[t * 16 + pe]; sa += v; sp += (t < tb) ? v : 0; }
          __hip_atomic_fetch_add(&ltot[pe], sa, __ATOMIC_RELAXED, __HIP_MEMORY_SCOPE_WORKGROUP); __hip_atomic_fetch_add(&lpre[pe], sp, __ATOMIC_RELAXED, __HIP_MEMORY_SCOPE_WORKGROUP); }
        __syncthreads();
        if (F.tid < 2) { int base = 0; for (int e = 0; e < 8; ++e) { ltb[F.tid * 8 + e] = base; base += (ltot[F.tid * 8 + e] + 255) >> 8; } }
        __syncthreads();
        unsigned e01[2] = {0u, 0u}; float w01[2] = {0.f, 0.f}; int rk[2] = {0, 0};
        if (F.tid < 256) {
            const u32x4 rec = *(const u32x4*)(KWS + WS_REC + (size_t)(tb * 256 + F.tid) * 16);
            e01[0] = rec.x; e01[1] = rec.y; w01[0] = __uint_as_float(rec.z); w01[1] = __uint_as_float(rec.w);
#pragma unroll
            for (int p = 0; p < 2; ++p)
#pragma unroll
                for (int ee = 0; ee < 8; ++ee) { const unsigned long long mk = __ballot(e01[p] == (unsigned)ee);
                    if (e01[p] == (unsigned)ee) rk[p] = __builtin_popcountll(mk & ((1ull << F.lane) - 1ull));
                    if (F.lane == 0) lwc[(p * 4 + F.wave) * 8 + ee] = __builtin_popcountll(mk); }
        }
        __syncthreads();
        if (F.tid < 256) {
#pragma unroll
            for (int p = 0; p < 2; ++p) { const int e = (int)e01[p]; int off = 0;
                for (int w = 0; w < F.wave; ++w) off += lwc[(p * 4 + w) * 8 + e];
                const int pos = ltb[p * 8 + e] * 256 + lpre[p * 8 + e] + off + rk[p];
                list[p * LISTN + pos] = tb * 256 + F.tid; wgt[p * LISTN + pos] = w01[p]; }
        }
        if (tb < 16) { const int p = tb >> 3, e = tb & 7; const int lo = ltb[tb] * 256 + ltot[tb], hi = (ltb[tb] + ((ltot[tb] + 255) >> 8)) * 256;
            for (int i = lo + F.tid; i < hi; i += NTHREADS) { list[p * LISTN + i] = (int)0x80000000u; wgt[p * LISTN + i] = 0.f; } (void)e; }
        if (tb == 0 && F.tid < 16) ((int*)(KWS + WS_TOT))[F.tid] = ltot[F.tid];
        __syncthreads();
    }
}
__device__ __forceinline__ void build_group_table(Frame& F, int p, int nN) {
    LAS int* tab = (LAS int*)(F.lds + LC_GT);
    __syncthreads();
    if (F.tid == 0) { const int* tot = (const int*)(KWS + WS_TOT) + p * 8; int ng = 0, ustart = 0, tile = 0;
        for (int e = 0; e < 8; ++e) { int tl = (tot[e] + 255) >> 8;
            while (tl > 0) { const int gsz = tl < 8 ? tl : 8; tab[64 + ng] = ustart; tab[128 + ng] = tile; tab[192 + ng] = gsz; tab[256 + ng] = e; ustart += gsz * nN; tile += gsz; tl -= gsz; ++ng; } }
        tab[0] = ng; tab[1] = ustart; }
    __syncthreads();
}

__device__ __forceinline__ void mixer_unit(Frame& F, const int l, const int unit, const int parts = 0xff) {
    const bf16* P = KPROJ; bf16* MO = KMIXED;
    const int t0 = unit * 128, s0 = t0 & (SEQ - 1), rb = t0 - s0;
    const int lane = F.lane, wave = F.wave, tid = F.tid;
    if (parts & 9) {
        typedef float f32x2 __attribute__((ext_vector_type(2)));
        constexpr int GS = 392;
        LAS bf16* gbuf = (LAS bf16*)F.lds;
        const __amdgpu_buffer_rsrc_t rsw = __builtin_amdgcn_make_buffer_rsrc((void*)(KIN(9) + (size_t)l * CKW * CONVW), (short)0, CKW * CONVW * 4, 0x00020000);
        const __amdgpu_buffer_rsrc_t rsb = __builtin_amdgcn_make_buffer_rsrc((void*)(KIN(10) + (size_t)l * CONVW), (short)0, CONVW * 4, 0x00020000);
        float g6[6], b6[6];
#pragma unroll
        for (int k = 0; k < 3; ++k)
#pragma unroll
            for (int e = 0; e < 2; ++e) { g6[2 * k + e] = KIN(11)[l * CONVW + 128 * k + 2 * lane + e]; b6[2 * k + e] = KIN(12)[l * CONVW + 128 * k + 2 * lane + e]; }
        for (int hf = 0; hf < 2; ++hf) {
            const int sbase = s0 + 64 * hf - 15;
            if (parts & 1) for (int j0 = 0; j0 < 9; j0 += 3) {
                u32x4 va[3], vg[3];
#pragma unroll
                for (int jj = 0; jj < 3; ++jj) { const int i = tid + (j0 + jj) * NTHREADS, rr = i / 48, cp = i - rr * 48, sq = sbase + rr;
                    va[jj] = (u32x4){0u, 0u, 0u, 0u}; vg[jj] = va[jj];
                    if (i < 94 * 48 && sq >= 0 && sq < SEQ) { const bf16* pr = P + (size_t)(rb + sq) * D_IN + 256 + 8 * cp; va[jj] = *(const u32x4*)pr; vg[jj] = *(const u32x4*)(pr + CONVW); } }
#pragma unroll
                for (int jj = 0; jj < 3; ++jj) { const int i = tid + (j0 + jj) * NTHREADS, rr = i / 48, cp = i - rr * 48;
                    if (i < 94 * 48) { u32x4 o;
#pragma unroll
                        for (int d = 0; d < 4; ++d) o[d] = pk2(bflo(va[jj][d]) * fast_sigmoid(bflo(vg[jj][d])), bfhi(va[jj][d]) * fast_sigmoid(bfhi(vg[jj][d])));
                        *(LAS u32x4*)(gbuf + rr * GS + 8 * cp) = o; } }
            }
            __syncthreads();
            if (parts & 8) {
            f32x2 o[3][8];
#pragma unroll
            for (int pg = 0; pg < 3; ++pg) {
                asm volatile("" ::: "memory");
                f32x2 w[31];
#pragma unroll
                for (int j = 0; j < 31; ++j) w[j] = __builtin_bit_cast(f32x2, __builtin_amdgcn_raw_buffer_load_b64(rsw, (unsigned)lane * 8u, (j * CONVW + 128 * pg) * 4, 0));
                const f32x2 bias = __builtin_bit_cast(f32x2, __builtin_amdgcn_raw_buffer_load_b64(rsb, (unsigned)lane * 8u, 128 * pg * 4, 0));
#pragma unroll
                for (int i = 0; i < 8; ++i) o[pg][i] = bias;
                const LAS unsigned* gp = (const LAS unsigned*)gbuf + (8 * wave) * (GS / 2) + 64 * pg + lane;
#pragma unroll
                for (int r = 0; r < 38; ++r) { const unsigned u = gp[r * (GS / 2)]; const f32x2 gl = {bflo(u), bfhi(u)};
#pragma unroll
                    for (int i = 0; i < 8; ++i) if (r - i >= 0 && r - i < 31) o[pg][i] = w[r - i] * gl + o[pg][i]; }
            }
#pragma unroll
            for (int i = 0; i < 8; ++i) { float sm = 0.f, q = 0.f;
#pragma unroll
                for (int pg = 0; pg < 3; ++pg) { sm += o[pg][i][0] + o[pg][i][1]; q += o[pg][i][0] * o[pg][i][0] + o[pg][i][1] * o[pg][i][1]; }
                sm = wave_sum(sm); q = wave_sum(q);
                const float mean = sm * (1.0f / CONVW), var = fmaxf(q * (1.0f / CONVW) - mean * mean, 0.f), rstd = 1.0f / sqrtf(var + EPS);
                unsigned* orow = (unsigned*)(MO + (size_t)(t0 + 64 * hf + 8 * wave + i) * D + 256);
#pragma unroll
                for (int pg = 0; pg < 3; ++pg) { const float o0 = silu_f((o[pg][i][0] - mean) * rstd * g6[2 * pg] + b6[2 * pg]), o1 = silu_f((o[pg][i][1] - mean) * rstd * g6[2 * pg + 1] + b6[2 * pg + 1]);
                    orow[64 * pg + lane] = pk2(o0, o1); } }
            }
            __syncthreads();
        }
    }
    if (parts & 18) {
        constexpr int VS = 136;
        LAS bf16* vnT = (LAS bf16*)F.lds;
        float g6[6], b6[6];
#pragma unroll
        for (int k = 0; k < 3; ++k)
#pragma unroll
            for (int e = 0; e < 2; ++e) { g6[2 * k + e] = KIN(13)[l * CONVW + 128 * k + 2 * lane + e]; b6[2 * k + e] = KIN(14)[l * CONVW + 128 * k + 2 * lane + e]; }
        if (parts & 2) for (int rh = 0; rh < 2; ++rh) {
            unsigned raw[8][3];
#pragma unroll
            for (int r = 0; r < 8; ++r) { const unsigned* pv = (const unsigned*)(P + (size_t)(t0 + wave * 16 + rh * 8 + r) * D_IN + 1408);
#pragma unroll
                for (int k = 0; k < 3; ++k) raw[r][k] = pv[64 * k + lane]; }
#pragma unroll
            for (int r = 0; r < 8; ++r) { const int tk = wave * 16 + rh * 8 + r;
                float v[6]; float s = 0.f, q = 0.f;
#pragma unroll
                for (int k = 0; k < 3; ++k) { v[2 * k] = bflo(raw[r][k]); v[2 * k + 1] = bfhi(raw[r][k]); }
#pragma unroll
                for (int k = 0; k < 6; ++k) { s += v[k]; q += v[k] * v[k]; }
                s = wave_sum(s); q = wave_sum(q);
                const float mean = s * (1.0f / CONVW), var = fmaxf(q * (1.0f / CONVW) - mean * mean, 0.f), rstd = 1.0f / sqrtf(var + EPS);
#pragma unroll
                for (int k = 0; k < 3; ++k)
#pragma unroll
                    for (int e = 0; e < 2; ++e) vnT[(128 * k + 2 * lane + e) * VS + tk] = (bf16)f2bf((v[2 * k + e] - mean) * rstd * g6[2 * k + e] + b6[2 * k + e]);
            }
        }
        __syncthreads();
        const bf16* sw = (const bf16*)(KWS + WS_SGUW);
        const float* sb = KIN(16) + (size_t)l * NH * 128;
        if (parts & 16) {
            bf16x8 wf[2][8]; u32x2 uu[2][2][4];
#define SGU_LOAD(slot, tile) do { const int hh_ = (tile) >> 2, pb_ = (tile) & 3; \
                const bf16* Wh_ = sw + ((size_t)((l * NH + hh_) * 128 + pb_ * 32 + (lane & 31))) * 128 + 8 * (lane >> 5); \
                _Pragma("unroll") for (int ks = 0; ks < 8; ++ks) wf[slot][ks] = *(const bf16x8*)(Wh_ + ks * 16); \
                const bf16* up_ = P + (size_t)(t0 + pb_ * 32 + (lane & 31)) * D_IN + 1024 + hh_ * 64 + 4 * (lane >> 5); \
                _Pragma("unroll") for (int dh = 0; dh < 2; ++dh) _Pragma("unroll") for (int a = 0; a < 4; ++a) uu[slot][dh][a] = *(const u32x2*)(up_ + dh * 32 + 8 * a); } while (0)
            SGU_LOAD(0, wave);
#pragma unroll
            for (int ti = 0; ti < 3; ++ti) { const int tile = wave + 8 * ti, hh = tile >> 2, pb = tile & 3, cs = ti & 1;
                if (ti < 2) { if (ti == 0) SGU_LOAD(1, wave + 8); else SGU_LOAD(0, wave + 16); }
                f32x16 acc0, acc1;
#pragma unroll
                for (int i = 0; i < 16; ++i) { acc0[i] = 0.f; acc1[i] = 0.f; }
                const LAS bf16* Vb = vnT + (hh * 64 + (lane & 31)) * VS + 8 * (lane >> 5);
#pragma unroll
                for (int ks = 0; ks < 8; ++ks) { const bf16x8 v0 = *(const LAS bf16x8*)(Vb + ks * 16), v1 = *(const LAS bf16x8*)(Vb + 32 * VS + ks * 16);
                    acc0 = __builtin_amdgcn_mfma_f32_32x32x16_bf16(v0, wf[cs][ks], acc0, 0, 0, 0); acc1 = __builtin_amdgcn_mfma_f32_32x32x16_bf16(v1, wf[cs][ks], acc1, 0, 0, 0); }
                const int p = pb * 32 + (lane & 31); const size_t row = (size_t)(t0 + p); const float bias = sb[hh * 128 + p];
                bf16* op = MO + row * D + 640 + hh * 64 + 4 * (lane >> 5);
#pragma unroll
                for (int a = 0; a < 4; ++a) {
                    { const unsigned u0 = uu[cs][0][a].x, u1 = uu[cs][0][a].y; u32x2 o; o.x = pk2(bflo(u0) * (acc0[4 * a + 0] + bias), bfhi(u0) * (acc0[4 * a + 1] + bias)); o.y = pk2(bflo(u1) * (acc0[4 * a + 2] + bias), bfhi(u1) * (acc0[4 * a + 3] + bias)); *(u32x2*)(op + 8 * a) = o; }
                    { const unsigned u0 = uu[cs][1][a].x, u1 = uu[cs][1][a].y; u32x2 o; o.x = pk2(bflo(u0) * (acc1[4 * a + 0] + bias), bfhi(u0) * (acc1[4 * a + 1] + bias)); o.y = pk2(bflo(u1) * (acc1[4 * a + 2] + bias), bfhi(u1) * (acc1[4 * a + 3] + bias)); *(u32x2*)(op + 32 + 8 * a) = o; }
                }
            }
#undef SGU_LOAD
        }
        __syncthreads();
    }
    if (parts & 36) {
        constexpr int AS = 264;
        constexpr int DS = 136;
        LAS bf16* abuf = (LAS bf16*)F.lds;
        LAS bf16* dbuf = (LAS bf16*)(F.lds + 144 * AS * 2);
        { u32x4 st[9];
#pragma unroll
          for (int j = 0; j < 9; ++j) { const int i = tid + j * NTHREADS, rr = i >> 5, cp = i & 31; const int sq = s0 - 8 + rr; st[j] = (u32x4){0u, 0u, 0u, 0u};
              if (sq >= 0 && sq < SEQ) st[j] = *(const u32x4*)(P + (size_t)(rb + sq) * D_IN + 8 * cp); }
#pragma unroll
          for (int j = 0; j < 9; ++j) { const int i = tid + j * NTHREADS, rr = i >> 5, cp = i & 31; *(LAS u32x4*)(abuf + rr * AS + 8 * cp) = st[j]; } }
        __syncthreads();
        const bf16* pwt = (const bf16*)(KWS + WS_POOLW) + (size_t)l * 4 * 64 * 64;
        for (int gp = 0; gp < 2; ++gp) {
            if (parts & 4) { const int cc = tid & 127, run = tid >> 7, g = 2 * gp + (cc >> 6), half = 1 << g, ch = g * 64 + (cc & 63);
              const int tk0 = run * 32; float sum = 0.f;
              for (int j = -half; j < half; ++j) sum += bf2f(abuf[(tk0 + j + 8) * AS + ch]);
              for (int k = 0; k < 32; ++k) { const int tk = tk0 + k, sq = s0 + tk; int lo = sq - half; lo = lo < 0 ? 0 : lo; int hi = sq + half; hi = hi > SEQ ? SEQ : hi;
                  const float a = bf2f(abuf[(tk + 8) * AS + ch]);
                  dbuf[tk * DS + cc] = (bf16)f2bf(sum / (float)(hi - lo) - a);
                  sum += bf2f(abuf[(tk + half + 8) * AS + ch]) - bf2f(abuf[(tk - half + 8) * AS + ch]); } }
            __syncthreads();
            if (parts & 32) { const int fr = lane & 15, fq = lane >> 4;
#pragma unroll
              for (int gg = 0; gg < 2; ++gg) { const int g = 2 * gp + gg;
                  bf16x8 af[2];
#pragma unroll
                  for (int ks = 0; ks < 2; ++ks) af[ks] = *(const LAS bf16x8*)(dbuf + (wave * 16 + fr) * DS + gg * 64 + ks * 32 + 8 * fq);
                  bf16* op = MO + (size_t)(t0 + wave * 16 + fr) * D + g * 64 + 4 * fq;
#pragma unroll
                  for (int nt = 0; nt < 4; ++nt) { f32x4 acc = {0.f, 0.f, 0.f, 0.f};
#pragma unroll
                      for (int ks = 0; ks < 2; ++ks) { const bf16x8 wfr = *(const bf16x8*)(pwt + ((size_t)(g * 64 + nt * 16 + fr)) * 64 + ks * 32 + 8 * fq);
                          acc = __builtin_amdgcn_mfma_f32_16x16x32_bf16(wfr, af[ks], acc, 0, 0, 0); }
                      u32x2 o; o.x = pk2(acc[0], acc[1]); o.y = pk2(acc[2], acc[3]); *(u32x2*)(op + nt * 16) = o; } } }
            __syncthreads();
        }
    }
}

__global__ void __launch_bounds__(NTHREADS, 2) fwd_kernel(Args args) {
    extern __shared__ __attribute__((aligned(16))) unsigned char lds_raw[];
    Frame F;
    F.lds = (LAS unsigned char*)lds_raw;
    F.tid = threadIdx.x; F.lane = F.tid & 63; F.wave = __builtin_amdgcn_readfirstlane(F.tid >> 6); F.G = gridDim.x; F.bid = blockIdx.x;
    F.ka = (kargp_t)__builtin_amdgcn_kernarg_segment_ptr(); (void)args;
    for (int u = F.tid; u < (LDS_BYTES - LC_OFF) / 4; u += NTHREADS) ((LAS unsigned*)(F.lds + LC_OFF))[u] = 0u;
    __syncthreads();
    XcdBarrier bar = xcd_barrier_post((unsigned*)(KWS + WS_CTL) + CW_BAR, (volatile LAS unsigned*)(F.lds + LC_MISC) + 8);
#define GRID_BAR() xcd_barrier(bar)
#ifndef PROBE_DUP
#define PROBE_DUP 0
#endif
#ifndef PROBE_MXPARTS
#define PROBE_MXPARTS 7
#endif
#define PROBE_REP(bit) for (int rep_ = 0; rep_ < ((PROBE_DUP & (bit)) ? 2 : 1); ++rep_)
#define MODL(l) (KMOD + (size_t)(l) * BATCH * NMOD)

    PROBE_REP(2 | 1024) { PHASE_ENTER(F); p0_prologue(F); GRID_BAR(); }

#define LAYER_MIX(l) \
    PROBE_REP(2) { PHASE_ENTER(F); if ((l) == 0) norm_phase<0, false>(F, KIN(0), KIN(4) + (l) * D, MODL(l) + 0 * D, MODL(l) + 1 * D, KH, nullptr); \
        else norm_phase<0, true>(F, KXB, KIN(4) + (l) * D, MODL(l) + 0 * D, MODL(l) + 1 * D, KH, nullptr); GRID_BAR(); } \
    PROBE_REP(8) { PHASE_ENTER(F); pg8::DenseOrder S; S.init(KH, (const bf16*)(KWS + WS_WIN) + (size_t)(l) * D_IN * D, M, D_IN, D, F.G, F.bid); \
        pg8::EpiBf16 E{KPROJ, D_IN, (PROBE_DUP & 256) ? rep_ : 0}; pg8::gemm_phase<pg8::EpiBf16, pg8::DenseOrder, false>(F.lds, D, S, E, nullptr, ((PROBE_DUP & 512) && rep_) ? 2 : 1); GRID_BAR(); } \
    PROBE_REP(1) { PHASE_ENTER(F); for (int u = F.bid; u < M / 128; u += F.G) mixer_unit(F, (l), u, ((PROBE_DUP & 1) && rep_ == 0) ? PROBE_MXPARTS : 0xff); GRID_BAR(); } \
    for (int rep_ = 0; rep_ < (((PROBE_DUP & 32) && (l) == 0) ? 2 : 1); ++rep_) { PHASE_ENTER(F); \
        pg8::DenseOrder S; S.init(KMIXED, (const bf16*)(KWS + WS_WOUT) + (size_t)(l) * D * D, M, D, D, F.G, F.bid); \
        if ((l) == 0) { pg8::EpiResidual<true> E{KIN(0), KXB, MODL(l) + 2 * D, 1.0f}; pg8::gemm_phase<pg8::EpiResidual<true>, pg8::DenseOrder, false>(F.lds, D, S, E); } \
        else { pg8::EpiResidual<false> E{KXB, KXB, MODL(l) + 2 * D, 1.0f}; pg8::gemm_phase<pg8::EpiResidual<false>, pg8::DenseOrder, false>(F.lds, D, S, E); } GRID_BAR(); }
#define KACT8(p) ((unsigned char*)(KWS + WS_BIG) + (size_t)(p) * LISTN * FFE)
#define MOE_GU(p, N5, ADV, BAR) \
    PROBE_REP(4 | 2048) { PHASE_ENTER(F); build_group_table(F, (p), 2 * FFE / 256); \
        pg8::MoeOrder S; S.tab = (const LAS int*)(F.lds + LC_GT); S.A = KH; S.Bt = (const bf16*)(KWS + WS_MWGU); S.bstride = (size_t)2 * FFE * D; S.list = (const int*)(KWS + WS_LIST) + (p) * LISTN; \
        S.K = D / 2; S.nN = 2 * FFE / 256; S.G = F.G; S.c = F.bid; S.gather = true; S.n5 = N5; S.adv = ADV; \
        pg8::EpiSwigluF8 E{KACT8(p), FFE, (PROBE_DUP & 2048) ? rep_ : 0, 1.0f / (SC_H * SC_W)}; pg8::gemm_phase<pg8::EpiSwigluF8, pg8::MoeOrder, true, true>(F.lds, D / 2, S, E, (LAS u32x4*)(F.lds + LC_GOFF)); if (BAR) GRID_BAR(); }
#define MOE_DOWN(p, BAR) \
    { PHASE_ENTER(F); build_group_table(F, (p), D / 256); \
        pg8::MoeOrder S; S.tab = (const LAS int*)(F.lds + LC_GT); S.A = (const bf16*)KACT8(p); S.Bt = (const bf16*)(KWS + WS_MWD); S.bstride = (size_t)D * FFE; S.list = nullptr; \
        S.K = FFE / 2; S.nN = D / 256; S.G = F.G; S.c = F.bid; S.gather = false; S.n5 = 0; S.adv = 0; \
        pg8::EpiMoeDown E{KXB, (const int*)(KWS + WS_LIST) + (p) * LISTN, (const float*)(KWS + WS_WGT) + (p) * LISTN, MODL(1) + 5 * D, 1.0f / (SC_A * SC_W), (bf16*)(KWS + WS_DUMP)}; \
        pg8::gemm_phase<pg8::EpiMoeDown, pg8::MoeOrder, false, true>(F.lds, FFE / 2, S, E); if (BAR) GRID_BAR(); \
        if (PROBE_DUP & 128) { pg8::EpiMoeDown E0 = E; E0.ascale = 0.f; pg8::gemm_phase<pg8::EpiMoeDown, pg8::MoeOrder, false, true>(F.lds, FFE / 2, S, E0); GRID_BAR(); } }

    LAYER_MIX(0)
    PROBE_REP(2) { PHASE_ENTER(F); norm_phase<0, true>(F, KXB, KIN(5), MODL(0) + 3 * D, MODL(0) + 4 * D, KH, nullptr); GRID_BAR(); }
    PROBE_REP(16) { PHASE_ENTER(F); pg8::DenseOrder S; S.init(KH, (const bf16*)(KWS + WS_WGU), M, 2 * FF, D, F.G, F.bid);
        pg8::EpiSwigluF8 E{(unsigned char*)KACT, FF, 0, 1.0f}; pg8::gemm_phase<pg8::EpiSwigluF8, pg8::DenseOrder, false>(F.lds, D, S, E); GRID_BAR(); }
    { PHASE_ENTER(F); pg8::DenseOrder S; S.init(KACT, (const bf16*)(KWS + WS_WD), M, D, FF / 2, F.G, F.bid);
        pg8::EpiResidual<false> E{KXB, KXB, MODL(0) + 5 * D, 1.0f / (SC_A * SC_W)}; pg8::gemm_phase<pg8::EpiResidual<false>, pg8::DenseOrder, false, true>(F.lds, FF / 2, S, E); GRID_BAR(); }
    if (PROBE_DUP & 64) { PHASE_ENTER(F); pg8::DenseOrder S; S.init(KACT, (const bf16*)(KWS + WS_WD), M, D, FF / 2, F.G, F.bid);
        pg8::EpiResidual<false> E{KXB, KXB, MODL(0) + 5 * D, 0.0f}; pg8::gemm_phase<pg8::EpiResidual<false>, pg8::DenseOrder, false, true>(F.lds, FF / 2, S, E); GRID_BAR(); }
    LAYER_MIX(1)
    PROBE_REP(2) { PHASE_ENTER(F); norm_phase<1, true>(F, KXB, KIN(5) + D, MODL(1) + 3 * D, MODL(1) + 4 * D, KH, nullptr); GRID_BAR();
        PHASE_ENTER(F); route_phase(F); GRID_BAR(); }
    MOE_GU(0, 0, 0, true)
    { int n5; { const int* tot = (const int*)(KWS + WS_TOT); int tl = 0; for (int e = 0; e < 8; ++e) tl += (tot[e] + 255) >> 8; n5 = (tl * (D / 256)) % F.G; n5 = (n5 + 7) & ~7; if (n5 >= F.G) n5 = 0; }
      MOE_DOWN(0, false)
      MOE_GU(1, n5, (n5 ? 3 : 0), true) }
    MOE_DOWN(1, true)
    if (PROBE_DUP & 4096) { for (int i = 0; i < 20; ++i) GRID_BAR(); }
    { PHASE_ENTER(F); norm_phase<2, true>(F, KXB, KIN(26), nullptr, nullptr, nullptr, KOUT); }
}

extern "C" void kernel_launch(void* const* d_in, const int* in_sizes, int n_in, void* d_out, int out_size, void* d_ws, size_t ws_size, hipStream_t stream) {
    static int grid = 0;
    if (grid == 0) {
        if (n_in != 27 || in_sizes[0] != M * D || out_size != M * D || ws_size < WS_END) { fprintf(stderr, "kernel_launch: unexpected shapes (n_in %d, in0 %d, out %d, ws %zu < %zu); nothing launched\n", n_in, n_in > 0 ? in_sizes[0] : -1, out_size, ws_size, (size_t)WS_END); grid = -1; return; }
        int dev = 0, cus = 0, per_cu = 0;
        if (hipGetDevice(&dev) != hipSuccess || hipDeviceGetAttribute(&cus, hipDeviceAttributeMultiprocessorCount, dev) != hipSuccess) { grid = -1; return; }
        if (hipFuncSetAttribute((const void*)fwd_kernel, hipFuncAttributeMaxDynamicSharedMemorySize, LDS_BYTES) != hipSuccess) { fprintf(stderr, "kernel_launch: hipFuncSetAttribute failed\n"); grid = -1; return; }
        if (hipOccupancyMaxActiveBlocksPerMultiprocessor(&per_cu, (const void*)fwd_kernel, NTHREADS, LDS_BYTES) != hipSuccess || per_cu < 1) { fprintf(stderr, "kernel_launch: occupancy query says %d blocks per CU\n", per_cu); }
        (void)hipGetLastError();
        grid = cus;
    }
    if (grid < 0) return;
    if (hipMemsetAsync((char*)d_ws + WS_CTL, 0, CTL_ZERO_BYTES, stream) != hipSuccess) return;
    Args a{};
    for (int i = 0; i < 27; ++i) a.in[i] = (const float*)d_in[i];
    a.out = (float*)d_out; a.ws = (unsigned char*)d_ws;
    hipLaunchKernelGGL(fwd_kernel, dim3(grid), dim3(NTHREADS), LDS_BYTES, stream, a);
}
```

```cpp
#include <hip/hip_runtime.h>
#include <cstdio>
#include <cstdint>

#define GAS __attribute__((address_space(1)))
#define LAS __attribute__((address_space(3)))
typedef unsigned short bf16;
typedef short bf16x8 __attribute__((ext_vector_type(8)));
typedef float f32x4 __attribute__((ext_vector_type(4)));
typedef float f32x16 __attribute__((ext_vector_type(16)));
typedef unsigned u32x4 __attribute__((ext_vector_type(4)));
typedef unsigned u32x2 __attribute__((ext_vector_type(2)));
typedef int i32x4 __attribute__((ext_vector_type(4)));
typedef int i32x8 __attribute__((ext_vector_type(8)));
constexpr float SC_W = 256.0f, SC_H = 16.0f, SC_A = 4.0f;

constexpr int NWAVES = 8, NTHREADS = 512;
constexpr int BATCH = 8, SEQ = 8192, D = 1024, M = BATCH * SEQ;
constexpr int D_IN = 1792, FF = 2816, FFE = 3584, NE = 8, NMOD = 6 * D;
constexpr int CONVW = 384, CKW = 31, NH = 6;
constexpr float EPS = 1e-6f;
constexpr int LISTN = M + NE * 256;

constexpr size_t MiB = 1u << 20;
constexpr size_t WS_CTL = 0, CTL_ZERO_BYTES = 1 * MiB;
constexpr size_t WS_MOD = 1 * MiB;
constexpr size_t WS_HIST = 2 * MiB;
constexpr size_t WS_TOT = 2 * MiB + 65536;
constexpr size_t WS_DUMP = 2 * MiB + 131072;
constexpr size_t WS_REC = 3 * MiB;
constexpr size_t WS_LIST = 4 * MiB;
constexpr size_t WS_WGT = 5 * MiB;
constexpr size_t WS_SGUW = 6 * MiB;
constexpr size_t WS_POOLW = 6 * MiB + 524288;
constexpr size_t WS_WIN = 8 * MiB;
constexpr size_t WS_WOUT = 15 * MiB;
constexpr size_t WS_WGU = 19 * MiB;
constexpr size_t WS_WD = 30 * MiB;
constexpr size_t WS_MWGU = 36 * MiB;
constexpr size_t WS_MWD = 148 * MiB;
constexpr size_t WS_H = 204 * MiB;
constexpr size_t WS_BIG = 332 * MiB;
constexpr size_t WS_MIXED = WS_BIG + (size_t)M * D_IN * 2;
constexpr size_t WS_ACT_END = WS_BIG + (size_t)LISTN * FFE * 2;
constexpr size_t WS_XB = (WS_ACT_END + 255) / 256 * 256;
constexpr size_t WS_END = WS_XB + (size_t)M * D * 2;
static_assert(WS_MIXED + (size_t)M * D * 2 <= WS_ACT_END && (size_t)M * FF * 2 <= (size_t)LISTN * FFE * 2, "ws map");
constexpr int CW_BAR = 4096;

constexpr int RING_BYTES = 131072;
constexpr int LC_OFF = RING_BYTES;
constexpr int LC_MISC = LC_OFF;
constexpr int LC_HIST = LC_OFF + 64;
constexpr int LC_TOT = LC_OFF + 128;
constexpr int LC_PRE = LC_OFF + 192;
constexpr int LC_TBASE = LC_OFF + 256;
constexpr int LC_WCNT = LC_OFF + 320;
constexpr int LC_GT = LC_OFF + 1024;
constexpr int LC_GOFF = LC_OFF + 4096;
constexpr int LDS_BYTES = RING_BYTES + 4096 + 8192;

__device__ __forceinline__ unsigned f2bf(float f) { unsigned u = __builtin_bit_cast(unsigned, f); return (u + 0x7fffu + ((u >> 16) & 1u)) >> 16; }
__device__ __forceinline__ unsigned pk2(float lo, float hi) { return f2bf(lo) | (f2bf(hi) << 16); }
__device__ __forceinline__ float bf2f(unsigned b) { return __builtin_bit_cast(float, b << 16); }
__device__ __forceinline__ float bflo(unsigned u) { return __builtin_bit_cast(float, u << 16); }
__device__ __forceinline__ float bfhi(unsigned u) { return __builtin_bit_cast(float, u & 0xffff0000u); }
__device__ __forceinline__ float fast_sigmoid(float x) { return __builtin_amdgcn_rcpf(1.0f + __builtin_amdgcn_exp2f(-1.44269504089f * x)); }
__device__ __forceinline__ float silu_f(float x) { return x * fast_sigmoid(x); }
#define WS_DPP(v, ctrl, rmask) __int_as_float(__builtin_amdgcn_update_dpp(0, __float_as_int(v), ctrl, rmask, 0xf, false))
__device__ __forceinline__ float wave_sum(float v) {
    v += WS_DPP(v, 0xB1, 0xf);
    v += WS_DPP(v, 0x4E, 0xf);
    v += WS_DPP(v, 0x141, 0xf);
    v += WS_DPP(v, 0x140, 0xf);
    v += WS_DPP(v, 0x142, 0xa);
    v += WS_DPP(v, 0x143, 0xc);
    return __int_as_float(__builtin_amdgcn_readlane(__float_as_int(v), 63));
}
__device__ __forceinline__ unsigned pk4_fp8(float a, float b, float c, float d) {
    a = __builtin_fminf(__builtin_fmaxf(a, -448.f), 448.f); b = __builtin_fminf(__builtin_fmaxf(b, -448.f), 448.f); c = __builtin_fminf(__builtin_fmaxf(c, -448.f), 448.f); d = __builtin_fminf(__builtin_fmaxf(d, -448.f), 448.f);
    unsigned w = 0; w = __builtin_amdgcn_cvt_pk_fp8_f32(a, b, w, false); w = __builtin_amdgcn_cvt_pk_fp8_f32(c, d, w, true); return w; }
#define LDS_WAIT() asm volatile("s_waitcnt lgkmcnt(0)" ::: "memory")

#define XB_TMO      128
#define XB_XCNT(j)  (256  + 64 * (j))
#define XB_XSUB(j)  (1280 + 64 * (j))
#define XB_XGEN(j)  (2304 + 64 * (j))
#define XB_TOP      3328
#define XB_TOPGEN   3392
#define XCD_BAR_WORDS 3456
#define XB_SPIN_CAP (1u << 18)
__device__ __forceinline__ unsigned xb_ld(unsigned* p)              { return __hip_atomic_load(p, __ATOMIC_RELAXED, __HIP_MEMORY_SCOPE_AGENT); }
__device__ __forceinline__ unsigned xb_add(unsigned* p, unsigned v) { return __hip_atomic_fetch_add(p, v, __ATOMIC_RELAXED, __HIP_MEMORY_SCOPE_AGENT); }
__device__ __forceinline__ unsigned xb_xcc_id() { return (unsigned)__builtin_amdgcn_s_getreg((3 << 11) | 20) & 0xFu; }
#define XB_SPIN(cond, bar) do { unsigned _sp = 0; while (cond) { __builtin_amdgcn_s_sleep(1); \
    if ((++_sp & 255u) == 0u) { if (xb_ld(&(bar)[XB_TMO])) break; if (_sp > XB_SPIN_CAP) { atomicAdd(&(bar)[XB_TMO], 1u); break; } } } } while (0)
struct XcdBarrier { unsigned* bar; unsigned x; volatile LAS unsigned* st; };
__device__ __forceinline__ XcdBarrier xcd_barrier_post(unsigned* bar, volatile LAS unsigned* st) {
    XcdBarrier b; b.bar = bar; b.x = xb_xcc_id(); b.st = st;
    if (threadIdx.x == 0) (void)xb_add(&bar[XB_XCNT(b.x)], 1u);
    return b;
}
__device__ __forceinline__ void xcd_barrier_complete(unsigned* bar, unsigned x, unsigned& nloc, unsigned& nx) {
    const unsigned G = gridDim.x * gridDim.y * gridDim.z;
    unsigned sum, cnt, mine, sp = 0u;
    for (;;) {
        sum = 0u; cnt = 0u; mine = 0u;
#pragma unroll
        for (unsigned j = 0; j < 16; ++j) { const unsigned c = xb_ld(&bar[XB_XCNT(j)]); sum += c; cnt += (c > 0u) ? 1u : 0u; mine = (j == x) ? c : mine; }
        if (sum == G) break;
        __builtin_amdgcn_s_sleep(1);
        if ((++sp & 255u) == 0u) { if (xb_ld(&bar[XB_TMO])) break; if (sp > XB_SPIN_CAP) { atomicAdd(&bar[XB_TMO], 1u); break; } }
    }
    nloc = mine > 0u ? mine : 1u; nx = cnt > 0u ? cnt : 1u;
}
__device__ __forceinline__ void xcd_barrier(const XcdBarrier& b) {
    asm volatile("s_waitcnt vmcnt(0)" ::: "memory");
    __syncthreads();
    if (threadIdx.x == 0) {
        unsigned* bar = b.bar;
        __builtin_amdgcn_s_waitcnt(0);
        unsigned nloc = b.st[0], nx = b.st[1];
        if (nloc == 0u) { xcd_barrier_complete(bar, b.x, nloc, nx); b.st[0] = nloc; b.st[1] = nx; }
        const unsigned old = xb_add(&bar[XB_XSUB(b.x)], 1u);
        const unsigned gen = old / nloc;
        if (old + 1u == (gen + 1u) * nloc) {
            __builtin_amdgcn_fence(__ATOMIC_RELEASE, "agent");
            asm volatile("s_waitcnt vmcnt(0)" ::: "memory");
            const unsigned og = xb_add(&bar[XB_TOP], 1u);
            const unsigned tg = og / nx;
            if (og + 1u == (tg + 1u) * nx) xb_add(&bar[XB_TOPGEN], 1u);
            else XB_SPIN(xb_ld(&bar[XB_TOPGEN]) == tg, bar);
            __builtin_amdgcn_fence(__ATOMIC_ACQUIRE, "agent");
            xb_add(&bar[XB_XGEN(b.x)], 1u);
            asm volatile("s_waitcnt vmcnt(0)" ::: "memory");
        } else {
            XB_SPIN(xb_ld(&bar[XB_XGEN(b.x)]) == gen, bar);
            __builtin_amdgcn_fence(__ATOMIC_ACQUIRE, "agent");
            asm volatile("s_waitcnt vmcnt(0)" ::: "memory");
        }
    }
    __syncthreads();
}

namespace pg8 {
constexpr int BM = 256, BK = 64, HALF = 128, HTB = HALF * BK * 2, STAGE_BYTES = 8 * HTB, NXCD = 8, WGM = 8;
__device__ __forceinline__ int lds_byte(int r, int c) { const int st = (r >> 4) * 2 + (c >> 5), rr = r & 15, cc = c & 31, ob = rr * 64 + cc * 2; return st * 1024 + (ob ^ (((ob >> 9) & 1) << 5)); }
__device__ __forceinline__ void stage_rc(int b, int& R, int& C) { const int st = b / 1024, sb = b % 1024, swz = sb ^ (((sb >> 9) & 1) << 5); R = (st >> 1) * 16 + swz / 64; C = (st & 1) * 32 + (swz % 64) / 2; }
__device__ __forceinline__ int perm32(int rho) { const int n = rho >> 4, i = rho & 15; return 8 * (i >> 2) + 4 * n + (i & 3); }
__device__ __forceinline__ unsigned cvt_pk_bf16(float lo, float hi) { unsigned r; asm volatile("v_cvt_pk_bf16_f32 %0, %1, %2" : "=v"(r) : "v"(lo), "v"(hi)); return r; }

struct Unit { int pm, pn, ex; };

__device__ __forceinline__ int xcd_remap(int wgid, int nwg) { const int q = nwg / NXCD, r = nwg % NXCD, xcd = wgid % NXCD, off = wgid / NXCD; return (xcd < r ? xcd * (q + 1) : r * (q + 1) + (xcd - r) * q) + off; }

struct DenseOrder {
    const bf16* A; const bf16* Bt; int K, nM, nN, nwg, G, c;
    __device__ __forceinline__ void init(const bf16* A_, const bf16* Bt_, int Mr, int N, int K_, int G_, int c_) { A = A_; Bt = Bt_; K = K_; nM = Mr / BM; nN = N / BM; nwg = nM * nN; G = G_; c = c_; }
    __device__ __forceinline__ bool next(int i, Unit& u) const {
        const long L = (long)i * G + c; if (L >= nwg) return false;
        const int wgid = xcd_remap((int)L, nwg);
        const int nig = WGM * nN, gid = wgid / nig, fm = gid * WGM, gsz = (nM - fm) < WGM ? (nM - fm) : WGM;
        u.pm = fm + ((wgid % nig) % gsz); u.pn = (wgid % nig) / gsz; u.ex = 0; return true;
    }
    __device__ __forceinline__ const char* a_ptr(const Unit& u) const { return (const char*)A + (size_t)u.pm * ((size_t)BM * K * 2); }
    __device__ __forceinline__ const char* b_ptr(const Unit& u) const { return (const char*)Bt + (size_t)u.pn * ((size_t)BM * K * 2); }
    __device__ __forceinline__ void rows_raw(const Unit&, int, unsigned (&)[2][2]) const {}
};
struct MoeOrder {
    const LAS int* tab; const bf16* A; const bf16* Bt; size_t bstride; const int* list; int K, nN, G, c; bool gather;
    int n5, adv;
    __device__ __forceinline__ bool next(int i, Unit& u) const {
        const int U = __builtin_amdgcn_readfirstlane(tab[1]), ng = __builtin_amdgcn_readfirstlane(tab[0]);
        long L;
        { const int head = adv * (G - n5);
          if (c >= n5) L = (i < adv) ? (long)i * (G - n5) + (c - n5) : (long)head + (long)(i - adv) * G + c;
          else L = (long)head + (long)i * G + c; }
        if (L >= U) return false;
        const int wgid = xcd_remap((int)L, U);
        int g = 0, hi = ng;
        while (hi - g > 1) { const int mid = (g + hi) >> 1; const int v = __builtin_amdgcn_readfirstlane(tab[64 + mid]); if (v <= wgid) g = mid; else hi = mid; }
        const int g0 = __builtin_amdgcn_readfirstlane(tab[64 + g]), t0 = __builtin_amdgcn_readfirstlane(tab[128 + g]), gsz = __builtin_amdgcn_readfirstlane(tab[192 + g]), ex = __builtin_amdgcn_readfirstlane(tab[256 + g]);
        const int local = wgid - g0;
        u.pm = t0 + local % gsz; u.pn = local / gsz; u.ex = ex; return true;
    }
    __device__ __forceinline__ const char* a_ptr(const Unit& u) const { return gather ? (const char*)A : (const char*)A + (size_t)u.pm * ((size_t)BM * K * 2); }
    __device__ __forceinline__ const char* b_ptr(const Unit& u) const { return (const char*)Bt + (size_t)u.ex * bstride + (size_t)u.pn * ((size_t)BM * K * 2); }
    __device__ __forceinline__ void rows_raw(const Unit& u, int tid, unsigned (&raw)[2][2]) const {
        asm volatile("" : "+v"(tid));
        const __amdgpu_buffer_rsrc_t rs = __builtin_amdgcn_make_buffer_rsrc((void*)(list + (size_t)u.pm * BM), (short)0, BM * 4, 0x00020000);
#pragma unroll
        for (int i = 0; i < 2; ++i) { int R, C; stage_rc(tid * 16 + i * 8192, R, C);
#pragma unroll
            for (int h = 0; h < 2; ++h) raw[h][i] = (unsigned)__builtin_amdgcn_raw_buffer_load_b32(rs, (unsigned)(h * HALF + R) * 4u, 0, 0); }
    }
};

struct EpiBf16 {
    static constexpr bool PERM = true;
    bf16* O; int ldc; int skip;
    __device__ __forceinline__ void operator()(const f32x4 (&acc)[2][2][4][2], const Unit& u, int wr, int wc, int fr, int fq) const {
        const int row0 = u.pm * BM + wr * 64 + fr, col0 = u.pn * BM + wc * 32 + 8 * fq;
        if (skip) { if (acc[0][0][0][0][0] == 12345.678f) O[0] = 1; return; }
#pragma unroll
        for (int ai = 0; ai < 2; ++ai)
#pragma unroll
            for (int m = 0; m < 4; ++m) { bf16* rowp = O + (size_t)(row0 + ai * HALF + m * 16) * ldc + col0;
#pragma unroll
                for (int bj = 0; bj < 2; ++bj) { const f32x4 v0 = acc[ai][bj][m][0], v1 = acc[ai][bj][m][1];
                    u32x4 w; w.x = cvt_pk_bf16(v0[0], v0[1]); w.y = cvt_pk_bf16(v0[2], v0[3]); w.z = cvt_pk_bf16(v1[0], v1[1]); w.w = cvt_pk_bf16(v1[2], v1[3]);
                    *(u32x4*)(rowp + bj * HALF) = w; } }
    }
};
struct EpiSwiglu {
    static constexpr bool PERM = true;
    bf16* O; int ldc;
    __device__ __forceinline__ void operator()(const f32x4 (&acc)[2][2][4][2], const Unit& u, int wr, int wc, int fr, int fq) const {
        const int row0 = u.pm * BM + wr * 64 + fr, col0 = u.pn * HALF + wc * 32 + 8 * fq;
        typedef float f32x2 __attribute__((ext_vector_type(2)));
        bf16* base = O + (size_t)row0 * ldc + col0;
#pragma unroll
        for (int ai = 0; ai < 2; ++ai)
#pragma unroll
            for (int m = 0; m < 4; ++m) { bf16* rowp = base + (size_t)(ai * HALF + m * 16) * ldc;
                float o[8];
#pragma unroll
                for (int n = 0; n < 2; ++n)
#pragma unroll
                    for (int j = 0; j < 4; j += 2) { const f32x2 g = {acc[ai][0][m][n][j], acc[ai][0][m][n][j + 1]}, up = {acc[ai][1][m][n][j], acc[ai][1][m][n][j + 1]};
                        const f32x2 t = g * -1.44269504089f; f32x2 r; r.x = __builtin_amdgcn_rcpf(1.0f + __builtin_amdgcn_exp2f(t.x)); r.y = __builtin_amdgcn_rcpf(1.0f + __builtin_amdgcn_exp2f(t.y));
                        const f32x2 v = (g * r) * up; o[n * 4 + j] = v.x; o[n * 4 + j + 1] = v.y; }
                u32x4 w; w.x = cvt_pk_bf16(o[0], o[1]); w.y = cvt_pk_bf16(o[2], o[3]); w.z = cvt_pk_bf16(o[4], o[5]); w.w = cvt_pk_bf16(o[6], o[7]);
                *(u32x4*)rowp = w; }
    }
};
struct EpiSwigluF8 {
    static constexpr bool PERM = true;
    unsigned char* O; int ldc; int skip; float si;
    __device__ __forceinline__ void operator()(const f32x4 (&acc)[2][2][4][2], const Unit& u, int wr, int wc, int fr, int fq) const {
        const int row0 = u.pm * BM + wr * 64 + fr, col0 = u.pn * HALF + wc * 32 + 8 * fq;
        if (skip) { if (acc[0][0][0][0][0] == 12345.678f) O[0] = 1; return; }
        const float k1 = -1.44269504089f * si, k2 = si * si * SC_A;
        typedef float f32x2 __attribute__((ext_vector_type(2)));
        unsigned char* base = O + (size_t)row0 * ldc + col0;
#pragma unroll
        for (int ai = 0; ai < 2; ++ai)
#pragma unroll
            for (int m = 0; m < 4; ++m) { unsigned char* rowp = base + (size_t)(ai * HALF + m * 16) * ldc;
                float o[8];
#pragma unroll
                for (int n = 0; n < 2; ++n)
#pragma unroll
                    for (int j = 0; j < 4; j += 2) { const f32x2 g = {acc[ai][0][m][n][j], acc[ai][0][m][n][j + 1]}, up = {acc[ai][1][m][n][j], acc[ai][1][m][n][j + 1]};
                        const f32x2 t = g * k1; f32x2 r; r.x = __builtin_amdgcn_rcpf(1.0f + __builtin_amdgcn_exp2f(t.x)); r.y = __builtin_amdgcn_rcpf(1.0f + __builtin_amdgcn_exp2f(t.y));
                        const f32x2 v = (g * r) * (up * k2);
                        o[n * 4 + j] = __builtin_amdgcn_fmed3f(v.x, -448.f, 448.f); o[n * 4 + j + 1] = __builtin_amdgcn_fmed3f(v.y, -448.f, 448.f); }
                u32x2 w; unsigned t0 = 0, t1 = 0;
                t0 = __builtin_amdgcn_cvt_pk_fp8_f32(o[0], o[1], t0, false); t0 = __builtin_amdgcn_cvt_pk_fp8_f32(o[2], o[3], t0, true);
                t1 = __builtin_amdgcn_cvt_pk_fp8_f32(o[4], o[5], t1, false); t1 = __builtin_amdgcn_cvt_pk_fp8_f32(o[6], o[7], t1, true);
                w.x = t0; w.y = t1; *(u32x2*)rowp = w; }
    }
};
template <bool XF32> struct EpiResidual {
    static constexpr bool PERM = true;
    const void* xin; bf16* out; const float* gate; float gs;
    __device__ __forceinline__ void operator()(const f32x4 (&acc)[2][2][4][2], const Unit& u, int wr, int wc, int fr, int fq) const {
        const int row0 = u.pm * BM + wr * 64 + fr, col0 = u.pn * BM + wc * 32 + 8 * fq, b = u.pm >> 5;
        f32x4 gv[2][2];
#pragma unroll
        for (int bj = 0; bj < 2; ++bj)
#pragma unroll
            for (int n = 0; n < 2; ++n) gv[bj][n] = *(const f32x4*)(gate + (size_t)b * NMOD + col0 + bj * HALF + n * 4) * gs;
#pragma unroll
        for (int ai = 0; ai < 2; ++ai) {
            if (XF32) { f32x4 xs[4][2][2];
#pragma unroll
                for (int m = 0; m < 4; ++m)
#pragma unroll
                    for (int bj = 0; bj < 2; ++bj) { const float* p = (const float*)xin + (size_t)(row0 + ai * HALF + m * 16) * D + col0 + bj * HALF; xs[m][bj][0] = *(const f32x4*)p; xs[m][bj][1] = *(const f32x4*)(p + 4); }
#pragma unroll
                for (int m = 0; m < 4; ++m)
#pragma unroll
                    for (int bj = 0; bj < 2; ++bj) { const f32x4 r0 = xs[m][bj][0] + gv[bj][0] * acc[ai][bj][m][0], r1 = xs[m][bj][1] + gv[bj][1] * acc[ai][bj][m][1];
                        u32x4 w; w.x = cvt_pk_bf16(r0[0], r0[1]); w.y = cvt_pk_bf16(r0[2], r0[3]); w.z = cvt_pk_bf16(r1[0], r1[1]); w.w = cvt_pk_bf16(r1[2], r1[3]);
                        *(u32x4*)(out + (size_t)(row0 + ai * HALF + m * 16) * D + col0 + bj * HALF) = w; }
            } else { u32x4 xr[4][2];
#pragma unroll
                for (int m = 0; m < 4; ++m)
#pragma unroll
                    for (int bj = 0; bj < 2; ++bj) xr[m][bj] = *(const u32x4*)((const bf16*)xin + (size_t)(row0 + ai * HALF + m * 16) * D + col0 + bj * HALF);
#pragma unroll
                for (int m = 0; m < 4; ++m)
#pragma unroll
                    for (int bj = 0; bj < 2; ++bj) { const u32x4 t = xr[m][bj];
                        const f32x4 x0 = {bflo(t.x), bfhi(t.x), bflo(t.y), bfhi(t.y)}, x1 = {bflo(t.z), bfhi(t.z), bflo(t.w), bfhi(t.w)};
                        const f32x4 r0 = x0 + gv[bj][0] * acc[ai][bj][m][0], r1 = x1 + gv[bj][1] * acc[ai][bj][m][1];
                        u32x4 w; w.x = cvt_pk_bf16(r0[0], r0[1]); w.y = cvt_pk_bf16(r0[2], r0[3]); w.z = cvt_pk_bf16(r1[0], r1[1]); w.w = cvt_pk_bf16(r1[2], r1[3]);
                        *(u32x4*)(out + (size_t)(row0 + ai * HALF + m * 16) * D + col0 + bj * HALF) = w; }
            }
            asm volatile("" ::: "memory");
        }
    }
};
struct EpiMoeDown {
    static constexpr bool PERM = true;
    bf16* out; const int* list; const float* wgt; const float* gate; float ascale; bf16* dump;
    __device__ __forceinline__ void operator()(const f32x4 (&acc)[2][2][4][2], const Unit& u, int wr, int wc, int fr, int fq) const {
        const int pos0 = u.pm * BM + wr * 64 + fr, col0 = u.pn * BM + wc * 32 + 8 * fq;
        int tk[2][4]; float w[2][4];
#pragma unroll
        for (int ai = 0; ai < 2; ++ai)
#pragma unroll
            for (int m = 0; m < 4; ++m) { const int pos = pos0 + ai * HALF + m * 16; tk[ai][m] = list[pos]; w[ai][m] = wgt[pos] * ascale; }
#pragma unroll
        for (int aq = 0; aq < 4; ++aq) {
            const int ai = aq >> 1, mb = (aq & 1) * 2;
            u32x4 xr[2][2]; f32x4 gq[2][2][2]; bf16* orow[2];
#pragma unroll
            for (int mm = 0; mm < 2; ++mm) { const int t = tk[ai][mb + mm]; orow[mm] = (t >= 0 ? out + (size_t)t * D : dump) + col0; const float* gp = gate + (size_t)(t >= 0 ? (t >> 13) : 0) * NMOD + col0;
#pragma unroll
                for (int bj = 0; bj < 2; ++bj) { xr[mm][bj] = *(const u32x4*)(orow[mm] + bj * HALF); gq[mm][bj][0] = *(const f32x4*)(gp + bj * HALF); gq[mm][bj][1] = *(const f32x4*)(gp + bj * HALF + 4); } }
#pragma unroll
            for (int mm = 0; mm < 2; ++mm)
#pragma unroll
                for (int bj = 0; bj < 2; ++bj) { const u32x4 t = xr[mm][bj]; const float ww = w[ai][mb + mm];
                    const f32x4 x0 = {bflo(t.x), bfhi(t.x), bflo(t.y), bfhi(t.y)}, x1 = {bflo(t.z), bfhi(t.z), bflo(t.w), bfhi(t.w)};
                    const f32x4 r0 = x0 + (gq[mm][bj][0] * ww) * acc[ai][bj][mb + mm][0], r1 = x1 + (gq[mm][bj][1] * ww) * acc[ai][bj][mb + mm][1];
                    u32x4 o; o.x = cvt_pk_bf16(r0[0], r0[1]); o.y = cvt_pk_bf16(r0[2], r0[3]); o.z = cvt_pk_bf16(r1[0], r1[1]); o.w = cvt_pk_bf16(r1[2], r1[3]);
                    *(u32x4*)(orow[mm] + bj * HALF) = o; }
            asm volatile("" ::: "memory");
        }
    }
};

template <class Epi, class Sched, bool GATHER, bool FP8 = false>
__device__ __forceinline__ void gemm_phase(LAS unsigned char* lds, const int K, const Sched& S, const Epi& E, LAS u32x4* goff = nullptr, int ntdiv = 1) {
    int tid_ = threadIdx.x; asm volatile("" : "+v"(tid_));
    const int tid = tid_, wid = __builtin_amdgcn_readfirstlane(tid >> 6), lane = tid & 63, wr = wid >> 2, wc = wid & 3, fr = lane & 15, fq = lane >> 4;
    int nt = K / BK / ntdiv; asm volatile("" : "+s"(nt));
    unsigned voffB[2], ao[2][2], no[2][2];
    const size_t kstep = (size_t)(BK * 2);
    const size_t hstep = (size_t)HALF * K * 2;
#pragma unroll
    for (int i = 0; i < 2; ++i) { int R, C; stage_rc(tid * 16 + i * 8192, R, C); const int Rb = Epi::PERM ? ((R & ~31) + perm32(R & 31)) : R;
        voffB[i] = (unsigned)(Rb * K + C) * 2u;
        ao[0][i] = (unsigned)(R * K + C) * 2u; ao[1][i] = ao[0][i] + (unsigned)hstep; no[0][i] = ao[0][i]; no[1][i] = ao[1][i]; }
    const unsigned ldsw = (unsigned)wid * 1024u;
    const int aoff = lds_byte(wr * 64 + fr, fq * 8), boff = lds_byte(wc * 32 + fr, fq * 8);
#define PG8_CB(i) ([&]() { int t_ = tid; asm volatile("" : "+v"(t_)); int R_, C_; stage_rc(t_ * 16 + (i) * 8192, R_, C_); return (unsigned)C_ * 2u; }())
#define PG8_SA(b, h) (((b) * 2 + (h)) * HTB)
#define PG8_SB(b, h) ((4 + (b) * 2 + (h)) * HTB)
#define PG8_STAGEB(bufoff, gbase) do { _Pragma("unroll") for (int _i = 0; _i < 2; ++_i) \
        __builtin_amdgcn_global_load_lds((const unsigned*)((const char*)(gbase) + voffB[_i]), (LAS unsigned*)(lds + (bufoff) + ldsw + _i * 8192), 16, 0, 0); } while (0)
#define PG8_STAGEA(bufoff, gbase, offs, h) do { _Pragma("unroll") for (int _i = 0; _i < 2; ++_i) \
        __builtin_amdgcn_global_load_lds((const unsigned*)((const char*)(gbase) + (offs)[h][_i]), (LAS unsigned*)(lds + (bufoff) + ldsw + _i * 8192), 16, 0, 0); } while (0)
#define PG8_LD32(p) __builtin_shufflevector(*(const LAS i32x4*)(p), *(const LAS i32x4*)((p) + 1024), 0, 1, 2, 3, 4, 5, 6, 7)
#define PG8_LDA(dst, b, h) do { _Pragma("unroll") for (int m = 0; m < 4; ++m) { if constexpr (FP8) dst##8[m] = PG8_LD32(lds + PG8_SA(b, h) + aoff + m * 2048); \
        else { _Pragma("unroll") for (int k = 0; k < 2; ++k) dst[m][k] = *(const LAS bf16x8*)(lds + PG8_SA(b, h) + aoff + m * 2048 + k * 1024); } } } while (0)
#define PG8_LDB(dst, b, h) do { _Pragma("unroll") for (int n = 0; n < 2; ++n) { if constexpr (FP8) dst##8[n] = PG8_LD32(lds + PG8_SB(b, h) + boff + n * 2048); \
        else { _Pragma("unroll") for (int k = 0; k < 2; ++k) dst[n][k] = *(const LAS bf16x8*)(lds + PG8_SB(b, h) + boff + n * 2048 + k * 1024); } } } while (0)
#define PG8_MMA(ai, bj, At, Bt) do { __builtin_amdgcn_s_setprio(1); _Pragma("unroll") for (int m = 0; m < 4; ++m) _Pragma("unroll") for (int n = 0; n < 2; ++n) { \
        if constexpr (FP8) asm volatile("v_mfma_scale_f32_16x16x128_f8f6f4 %0, %1, %2, %0, %3, %3 op_sel_hi:[0,0,0]" : "+v"(acc[ai][bj][m][n]) : "v"(Bt##8[n]), "v"(At##8[m]), "v"(sc1));     \
        else { _Pragma("unroll") for (int k = 0; k < 2; ++k) acc[ai][bj][m][n] = __builtin_amdgcn_mfma_f32_16x16x32_bf16(Bt[n][k], At[m][k], acc[ai][bj][m][n], 0, 0, 0); } } \
        __builtin_amdgcn_s_setprio(0); } while (0)
#define PG8_WAIT_V(n) asm volatile("s_waitcnt vmcnt(" #n ")" ::: "memory")
#define PG8_WAIT_L(n) asm volatile("s_waitcnt lgkmcnt(" #n ")" ::: "memory")
#define PG8_BAR __builtin_amdgcn_s_barrier()
#define PG8_SCHED __builtin_amdgcn_sched_barrier(0)
    Unit cur, nxt, nn; int ui = 0;
    if (!S.next(0, cur)) return;
    bool has_next = S.next(1, nxt);
    if constexpr (GATHER) {
        unsigned raw[2][2]; S.rows_raw(cur, tid, raw);
#pragma unroll
        for (int h = 0; h < 2; ++h)
#pragma unroll
            for (int i = 0; i < 2; ++i) ao[h][i] = (raw[h][i] & 0xffffffu) * (unsigned)(K * 2) + PG8_CB(i);
        if (has_next) { S.rows_raw(nxt, tid, raw);
#pragma unroll
            for (int h = 0; h < 2; ++h)
#pragma unroll
                for (int i = 0; i < 2; ++i) no[h][i] = (raw[h][i] & 0xffffffu) * (unsigned)(K * 2) + PG8_CB(i); }
        else {
#pragma unroll
            for (int h = 0; h < 2; ++h)
#pragma unroll
                for (int i = 0; i < 2; ++i) no[h][i] = ao[h][i]; }
        goff[tid] = (u32x4){no[0][0], no[0][1], no[1][0], no[1][1]};
    }
    f32x4 acc[2][2][4][2];
#pragma unroll
    for (int a = 0; a < 2; ++a)
#pragma unroll
        for (int b = 0; b < 2; ++b)
#pragma unroll
            for (int m = 0; m < 4; ++m)
#pragma unroll
                for (int n = 0; n < 2; ++n) acc[a][b][m][n] = (f32x4){0.f, 0.f, 0.f, 0.f};
    const int sc1 = 0x7f7f7f7f;
    bf16x8 At[4][2], B0[2][2], B1[2][2];
    i32x8 At8[4], B08[2], B18[2];
    const char* cA = S.a_ptr(cur); const char* cB = S.b_ptr(cur);
    PG8_STAGEB(PG8_SB(0, 0), cB); PG8_STAGEB(PG8_SB(0, 1), cB + hstep); PG8_STAGEA(PG8_SA(0, 0), cA, ao, 0); PG8_STAGEA(PG8_SA(0, 1), cA, ao, 1);
    if (wr == 1) PG8_BAR;
    PG8_WAIT_V(2); PG8_BAR;
    PG8_STAGEB(PG8_SB(1, 0), cB + kstep); PG8_STAGEA(PG8_SA(1, 0), cA + kstep, ao, 0); PG8_STAGEB(PG8_SB(1, 1), cB + hstep + kstep);
    PG8_WAIT_V(6); PG8_BAR;
    for (;;) {
        const char* nA = has_next ? S.a_ptr(nxt) : cA; const char* nB = has_next ? S.b_ptr(nxt) : cB;
#pragma clang loop unroll(disable)
        for (int t = 0; t < nt; t += 2) {
            const bool last = (t == nt - 2);
            const char* a1 = cA + (size_t)(t + 1) * kstep;
            const char* a2 = last ? nA : cA + (size_t)(t + 2) * kstep; const char* b2 = last ? nB : cB + (size_t)(t + 2) * kstep;
            const char* a3 = a2 + kstep; const char* b3 = b2 + kstep;
            asm volatile("" : "+v"(voffB[0]), "+v"(voffB[1]), "+v"(ao[0][0]), "+v"(ao[0][1]), "+v"(ao[1][0]), "+v"(ao[1][1]));
            PG8_LDB(B0, 0, 0); PG8_LDB(B1, 0, 1); PG8_SCHED; PG8_LDA(At, 0, 0); PG8_STAGEA(PG8_SA(1, 1), a1, ao, 1);
            if constexpr (GATHER) { if (last) { const u32x4 q = goff[tid]; ao[0][0] = q[0]; ao[0][1] = q[1]; ao[1][0] = q[2]; ao[1][1] = q[3]; } }
            PG8_WAIT_V(8); PG8_WAIT_L(0); PG8_BAR; PG8_MMA(0, 0, At, B0); PG8_MMA(0, 1, At, B1); PG8_BAR; PG8_SCHED;
            PG8_LDA(At, 0, 1); PG8_STAGEB(PG8_SB(0, 0), b2); PG8_STAGEB(PG8_SB(0, 1), b2 + hstep); PG8_STAGEA(PG8_SA(0, 0), a2, ao, 0);
            PG8_WAIT_V(8); PG8_WAIT_L(0); PG8_BAR; PG8_MMA(1, 0, At, B0); PG8_MMA(1, 1, At, B1); PG8_BAR; PG8_SCHED;
            PG8_LDB(B0, 1, 0); PG8_LDB(B1, 1, 1); PG8_SCHED; PG8_LDA(At, 1, 0); PG8_STAGEA(PG8_SA(0, 1), a2, ao, 1);
            PG8_WAIT_V(8); PG8_WAIT_L(0); PG8_BAR; PG8_MMA(0, 0, At, B0); PG8_MMA(0, 1, At, B1); PG8_BAR; PG8_SCHED;
            PG8_LDA(At, 1, 1); PG8_STAGEB(PG8_SB(1, 0), b3); PG8_STAGEB(PG8_SB(1, 1), b3 + hstep); PG8_STAGEA(PG8_SA(1, 0), a3, ao, 0);
            PG8_WAIT_V(8); PG8_WAIT_L(0); PG8_BAR; PG8_MMA(1, 0, At, B0); PG8_MMA(1, 1, At, B1); PG8_BAR; PG8_SCHED;
        }
        if (wr == 0) PG8_BAR;
        if constexpr (FP8) asm volatile("s_nop 15\n\ts_nop 15\n\ts_nop 7" ::: "memory");
        bool has_nn = false; unsigned raw[2][2];
        if (has_next) has_nn = S.next(ui + 2, nn);
        if constexpr (GATHER) { if (has_nn) S.rows_raw(nn, tid, raw); }
        E(acc, cur, wr, wc, fr, fq);
        if (!has_next) break;
#pragma unroll
        for (int a = 0; a < 2; ++a)
#pragma unroll
            for (int b = 0; b < 2; ++b)
#pragma unroll
                for (int m = 0; m < 4; ++m)
#pragma unroll
                    for (int n = 0; n < 2; ++n) acc[a][b][m][n] = (f32x4){0.f, 0.f, 0.f, 0.f};
        if constexpr (GATHER) {
            if (has_nn) { u32x4 q;
#pragma unroll
                for (int h = 0; h < 2; ++h)
#pragma unroll
                    for (int i = 0; i < 2; ++i) q[h * 2 + i] = (raw[h][i] & 0xffffffu) * (unsigned)(K * 2) + PG8_CB(i);
                goff[tid] = q; }
        }
        cur = nxt; cA = nA; cB = nB; nxt = nn; has_next = has_nn; ++ui;
        if (wr == 1) PG8_BAR;
    }
    PG8_WAIT_V(0);
    PG8_BAR;
#undef PG8_SA
#undef PG8_CB
#undef PG8_SB
#undef PG8_STAGEA
#undef PG8_STAGEB
#undef PG8_LDA
#undef PG8_LDB
#undef PG8_MMA
#undef PG8_LD32
#undef PG8_WAIT_V
#undef PG8_WAIT_L
#undef PG8_BAR
#undef PG8_SCHED
}
}

struct Args { const float* in[27]; float* out; unsigned char* ws; };
typedef const float* cfp_t;
typedef __attribute__((address_space(4))) const cfp_t* kargp_t;
struct Frame {
    LAS unsigned char* lds;
    int tid, lane, wave, G, bid;
    kargp_t ka;
};
#define PHASE_ENTER(F) do { kargp_t _p = (F).ka; asm volatile("" : "+s"(_p)); (F).ka = _p; \
    int _t = threadIdx.x; asm volatile("" : "+v"(_t)); (F).tid = _t; (F).lane = _t & 63; (F).wave = __builtin_amdgcn_readfirstlane(_t >> 6); \
    int _g = gridDim.x; asm volatile("" : "+s"(_g)); (F).G = _g; int _b = blockIdx.x; asm volatile("" : "+s"(_b)); (F).bid = _b; } while (0)
#define KIN(k) ((F).ka[k])
#define KOUT ((float*)(F).ka[27])
#define KWS ((unsigned char*)(F).ka[28])
#define KMOD ((float*)(KWS + WS_MOD))
#define KH ((bf16*)(KWS + WS_H))
#define KPROJ ((bf16*)(KWS + WS_BIG))
#define KMIXED ((bf16*)(KWS + WS_MIXED))
#define KACT ((bf16*)(KWS + WS_BIG))
#define KXB ((bf16*)(KWS + WS_XB))

struct P0Item { const float* W; unsigned char* WT; int K, N, dst_row0, kb, nb, f8; };
__device__ __forceinline__ void p0_load(const P0Item& d, int lane, f32x4 (&t)[8]) {
    const int k0 = 64 * d.kb, n0 = 32 * d.nb;
#pragma unroll
    for (int i = 0; i < 8; ++i) t[i] = __builtin_nontemporal_load((const f32x4*)(d.W + (size_t)(k0 + 8 * i + (lane >> 3)) * d.N + n0 + 4 * (lane & 7)));
}
__device__ __forceinline__ void p0_store(const P0Item& d, LAS float* scr, int lane, const f32x4 (&t)[8]) {
    const int k0 = 64 * d.kb;
#pragma unroll
    for (int i = 0; i < 8; ++i) { LAS float* q = scr + (8 * i + (lane >> 3)) * 33 + 4 * (lane & 7); q[0] = t[i][0]; q[1] = t[i][1]; q[2] = t[i][2]; q[3] = t[i][3]; }
    LDS_WAIT(); asm volatile("" ::: "memory");
    if (d.f8) {
        const int n = lane >> 1, kh = (lane & 1) * 32; const LAS float* sp = scr + kh * 33 + n;
#pragma unroll
        for (int q = 0; q < 2; ++q) { u32x4 o;
#pragma unroll
            for (int e = 0; e < 4; ++e) { const int kk = q * 16 + e * 4; o[e] = pk4_fp8(sp[(kk + 0) * 33] * SC_W, sp[(kk + 1) * 33] * SC_W, sp[(kk + 2) * 33] * SC_W, sp[(kk + 3) * 33] * SC_W); }
            *(u32x4*)(d.WT + (size_t)(d.dst_row0 + n) * d.K + k0 + kh + q * 16) = o; }
    } else { const int c = lane & 7;
#pragma unroll
        for (int j = 0; j < 4; ++j) { const int n = (lane >> 3) + 8 * j; const LAS float* sq = scr + (8 * c) * 33 + n;
            u32x4 o; o.x = pk2(sq[0 * 33], sq[1 * 33]); o.y = pk2(sq[2 * 33], sq[3 * 33]); o.z = pk2(sq[4 * 33], sq[5 * 33]); o.w = pk2(sq[6 * 33], sq[7 * 33]);
            *(u32x4*)((bf16*)d.WT + (size_t)(d.dst_row0 + n) * d.K + k0 + 8 * c) = o; }
    }
    LDS_WAIT(); asm volatile("" ::: "memory");
}
__device__ __forceinline__ int gu_row(int n) { return (n >> 7) * 256 + (n & 127); }

__device__ __forceinline__ void p0_prologue(Frame& F) {
    if (F.bid < 192) {
        LAS float* cond = (LAS float*)F.lds;
        LAS float* red = (LAS float*)(F.lds + 32768);
        const float* cin = KIN(1);
        for (int i = F.tid; i < BATCH * D; i += NTHREADS) cond[i] = silu_f(cin[i]);
        __syncthreads();
        for (int item = F.bid; item < 192; item += F.G) {
            const int l = item / 96, colbase = (item % 96) * 64, col = colbase + F.lane;
            const float* W = KIN(2) + (size_t)l * D * NMOD;
            float a[8];
#pragma unroll
            for (int b = 0; b < 8; ++b) a[b] = 0.f;
            for (int k0 = F.wave * 128; k0 < F.wave * 128 + 128; k0 += 16) { float w[16];
#pragma unroll
                for (int i = 0; i < 16; ++i) w[i] = W[(size_t)(k0 + i) * NMOD + col];
#pragma unroll
                for (int i = 0; i < 16; ++i)
#pragma unroll
                    for (int b = 0; b < 8; ++b) a[b] = fmaf(cond[b * D + k0 + i], w[i], a[b]); }
#pragma unroll
            for (int b = 0; b < 8; ++b) red[(F.wave * 8 + b) * 64 + F.lane] = a[b];
            __syncthreads();
            { const int b = F.tid >> 6, cl = F.tid & 63; float s = 0.f;
#pragma unroll
              for (int w = 0; w < 8; ++w) s += red[(w * 8 + b) * 64 + cl];
              KMOD[((size_t)l * BATCH + b) * NMOD + colbase + cl] = s + KIN(3)[(size_t)l * NMOD + colbase + cl]; }
            __syncthreads();
        }
    }
    LAS float* scr = (LAS float*)(F.lds + F.wave * 16384);
    const int gw = F.bid * NWAVES + F.wave, NGW = F.G * NWAVES;
    constexpr int I_IN = 16 * 56, I_OUT = 16 * 32, I_FG = 16 * 88, I_FD = 44 * 32, I_MG = 16 * 112, I_MD = 56 * 32;
    constexpr int NITEMS = 2 * I_IN + 2 * I_OUT + 2 * I_FG + I_FD + 16 * I_MG + 8 * I_MD;
#define P0_DECODE(it_, d, ok) do { int r = (it_); ok = r < NITEMS; if (ok) { \
        if (r < 2 * I_IN) { const int l = r / I_IN; r -= l * I_IN; d = P0Item{KIN(6) + (size_t)l * D * D_IN, KWS + WS_WIN + (size_t)l * D_IN * D * 2, D, D_IN, 32 * (r % 56), r / 56, r % 56, 0}; } \
        else if ((r -= 2 * I_IN) < 2 * I_OUT) { const int l = r / I_OUT; r -= l * I_OUT; d = P0Item{KIN(17) + (size_t)l * D * D, KWS + WS_WOUT + (size_t)l * D * D * 2, D, D, 32 * (r % 32), r / 32, r % 32, 0}; } \
        else if ((r -= 2 * I_OUT) < 2 * I_FG) { const int up = r / I_FG; r -= up * I_FG; d = P0Item{up ? KIN(19) : KIN(18), KWS + WS_WGU, D, FF, gu_row(32 * (r % 88)) + 128 * up, r / 88, r % 88, 0}; } \
        else if ((r -= 2 * I_FG) < I_FD) { d = P0Item{KIN(20), KWS + WS_WD, FF, D, 32 * (r % 32), r / 32, r % 32, 1}; } \
        else if ((r -= I_FD) < 16 * I_MG) { const int q = r / I_MG; r -= q * I_MG; const int up = q >> 3, e = q & 7; \
            d = P0Item{(up ? KIN(24) : KIN(23)) + (size_t)e * D * FFE, KWS + WS_MWGU + (size_t)e * 2 * FFE * D, D, FFE, gu_row(32 * (r % 112)) + 128 * up, r / 112, r % 112, 1}; } \
        else { r -= 16 * I_MG; const int e = r / I_MD; r -= e * I_MD; d = P0Item{KIN(25) + (size_t)e * FFE * D, KWS + WS_MWD + (size_t)e * D * FFE, FFE, D, 32 * (r % 32), r / 32, r % 32, 1}; } } } while (0)
    { P0Item cur, nxt; f32x4 tc[8], tn[8]; bool hc, hn;
      P0_DECODE(gw, cur, hc); if (hc) p0_load(cur, F.lane, tc);
      for (int it = gw; hc; it += NGW) {
          P0_DECODE(it + NGW, nxt, hn); if (hn) p0_load(nxt, F.lane, tn);
          p0_store(cur, scr, F.lane, tc);
          cur = nxt; hc = hn;
#pragma unroll
          for (int i = 0; i < 8; ++i) tc[i] = tn[i]; } }
#undef P0_DECODE
    if (F.bid == 0) for (int i = F.tid; i < D; i += NTHREADS) ((float*)(KWS + WS_DUMP))[i] = 0.f;
    { bf16* pw = (bf16*)(KWS + WS_POOLW);
      for (int i = F.bid * NTHREADS + F.tid; i < 2 * 4 * 64 * 64; i += F.G * NTHREADS) { const int c = i & 63, d = (i >> 6) & 63, lg = i >> 12;
          pw[i] = (bf16)f2bf(KIN(7)[((size_t)lg * 64 + c) * 64 + d] * KIN(8)[lg * 64 + d]); } }
    { const float* sw = KIN(15); bf16* so = (bf16*)(KWS + WS_SGUW);
      for (int i = (F.bid * NTHREADS + F.tid) * 4; i < 2 * NH * 128 * 128; i += F.G * NTHREADS * 4) { const f32x4 v = *(const f32x4*)(sw + i); u32x2 o; o.x = pk2(v[0], v[1]); o.y = pk2(v[2], v[3]); *(u32x2*)(so + i) = o; } }
}

template <int MODE, bool SRCB>
__device__ __forceinline__ void norm_phase(Frame& F, const void* xsrc, const float* g, const float* shiftp, const float* scalep, bf16* hdst, float* fdst) {
    LAS int* lhist = (LAS int*)(F.lds + LC_HIST);
    for (int tb = F.bid; tb < M / 256; tb += F.G) {
        const int row0 = tb * 256 + F.wave * 32, b = row0 >> 13;
        f32x4 gm[4], sh[4];
#pragma unroll
        for (int j = 0; j < 4; ++j) { const int col = 4 * F.lane + 256 * j; const f32x4 gg = *(const f32x4*)(g + col);
            if (MODE == 2) { gm[j] = gg; sh[j] = (f32x4){0.f, 0.f, 0.f, 0.f}; }
            else { const f32x4 sc = *(const f32x4*)(scalep + (size_t)b * NMOD + col); gm[j] = gg * (1.0f + sc); sh[j] = *(const f32x4*)(shiftp + (size_t)b * NMOD + col); } }
        float rbias[8];
        LAS float* rwl = (LAS float*)F.lds;
        if (MODE == 1) {
            for (int i = F.tid; i < D * NE; i += NTHREADS) rwl[(i & 7) * D + (i >> 3)] = KIN(21)[i];
#pragma unroll
            for (int e = 0; e < 8; ++e) rbias[e] = KIN(22)[e];
            if (F.tid < 16) lhist[F.tid] = 0;
            __syncthreads();
        }
        constexpr int RB = SRCB ? 8 : 4;
        for (int rq = 0; rq < 32; rq += RB) {
            u32x2 rawb[SRCB ? RB : 1][4]; f32x4 vv[SRCB ? 1 : RB][4];
#pragma unroll
            for (int rr = 0; rr < RB; ++rr) { const int row = row0 + rq + rr;
                if (SRCB) { const u32x2* xr = (const u32x2*)((const bf16*)xsrc + (size_t)row * D) + F.lane;
#pragma unroll
                    for (int j = 0; j < 4; ++j) rawb[SRCB ? rr : 0][j] = xr[64 * j]; }
                else { const f32x4* xr = (const f32x4*)((const float*)xsrc + (size_t)row * D) + F.lane;
#pragma unroll
                    for (int j = 0; j < 4; ++j) vv[SRCB ? 0 : rr][j] = xr[64 * j]; } }
#pragma unroll
            for (int rr = 0; rr < RB; ++rr) {
            const int row = row0 + rq + rr;
            if (SRCB) {
#pragma unroll
                for (int j = 0; j < 4; ++j) { const u32x2 t = rawb[SRCB ? rr : 0][j]; vv[0][j] = (f32x4){bflo(t.x), bfhi(t.x), bflo(t.y), bfhi(t.y)}; } }
            f32x4 v[4]; float ss = 0.f;
#pragma unroll
            for (int j = 0; j < 4; ++j) v[j] = vv[SRCB ? 0 : rr][j];
#pragma unroll
            for (int j = 0; j < 4; ++j) { ss += (v[j][0] * v[j][0] + v[j][1] * v[j][1]) + (v[j][2] * v[j][2] + v[j][3] * v[j][3]); }
            const float rstd = 1.0f / sqrtf(wave_sum(ss) * (1.0f / D) + EPS);
#pragma unroll
            for (int j = 0; j < 4; ++j) v[j] = (v[j] * rstd) * gm[j] + sh[j];
            if (MODE == 2) { f32x4* o = (f32x4*)(fdst + (size_t)row * D) + F.lane;
#pragma unroll
                for (int j = 0; j < 4; ++j) o[64 * j] = v[j]; }
            else if (MODE == 1) { unsigned* o = (unsigned*)((unsigned char*)hdst + (size_t)row * D) + F.lane;
#pragma unroll
                for (int j = 0; j < 4; ++j) o[64 * j] = pk4_fp8(v[j][0] * SC_H, v[j][1] * SC_H, v[j][2] * SC_H, v[j][3] * SC_H); }
            else { u32x2* o = (u32x2*)(hdst + (size_t)row * D) + F.lane;
#pragma unroll
                for (int j = 0; j < 4; ++j) { u32x2 w; w.x = pk2(v[j][0], v[j][1]); w.y = pk2(v[j][2], v[j][3]); o[64 * j] = w; } }
            if (MODE == 1) {
                float lg[8];
#pragma unroll
                for (int e = 0; e < 8; ++e) lg[e] = 0.f;
#pragma unroll
                for (int e = 0; e < 8; ++e)
#pragma unroll
                    for (int j = 0; j < 4; ++j) { const f32x4 wv = *(const LAS f32x4*)(rwl + e * D + 4 * F.lane + 256 * j);
                        lg[e] = fmaf(v[j][0], wv[0], lg[e]); lg[e] = fmaf(v[j][1], wv[1], lg[e]); lg[e] = fmaf(v[j][2], wv[2], lg[e]); lg[e] = fmaf(v[j][3], wv[3], lg[e]); }
#pragma unroll
                for (int e = 0; e < 8; ++e) lg[e] = wave_sum(lg[e]) + rbias[e];
                int i1 = 0; float v1 = lg[0];
#pragma unroll
                for (int e = 1; e < 8; ++e) if (lg[e] > v1) { v1 = lg[e]; i1 = e; }
                int i2 = -1; float v2 = -3.0e38f;
#pragma unroll
                for (int e = 0; e < 8; ++e) if (e != i1 && lg[e] > v2) { v2 = lg[e]; i2 = e; }
                const float ex = __expf(v2 - v1), w1 = 1.0f / (1.0f + ex), w2 = ex * w1;
                if (F.lane == 0) { u32x4 rec; rec.x = (unsigned)i1; rec.y = (unsigned)i2; rec.z = __float_as_uint(w1); rec.w = __float_as_uint(w2);
                    *(u32x4*)(KWS + WS_REC + (size_t)row * 16) = rec; __hip_atomic_fetch_add(&lhist[i1], 1, __ATOMIC_RELAXED, __HIP_MEMORY_SCOPE_WORKGROUP); __hip_atomic_fetch_add(&lhist[8 + i2], 1, __ATOMIC_RELAXED, __HIP_MEMORY_SCOPE_WORKGROUP); }
            }
        }
        }
        if (MODE == 1) { __syncthreads(); if (F.tid < 16) ((int*)(KWS + WS_HIST))[tb * 16 + F.tid] = lhist[F.tid]; __syncthreads(); }
    }
}

__device__ __forceinline__ void route_phase(Frame& F) {
    LAS int* ltot = (LAS int*)(F.lds + LC_TOT); LAS int* lpre = (LAS int*)(F.lds + LC_PRE); LAS int* ltb = (LAS int*)(F.lds + LC_TBASE); LAS int* lwc = (LAS int*)(F.lds + LC_WCNT);
    const int* hist = (const int*)(KWS + WS_HIST);
    int* list = (int*)(KWS + WS_LIST); float* wgt = (float*)(KWS + WS_WGT);
    for (int tb = F.bid; tb < M / 256; tb += F.G) {
        if (F.tid < 16) { ltot[F.tid] = 0; lpre[F.tid] = 0; }
        __syncthreads();
        { const int pe = F.tid & 15, part = F.tid >> 4; int sa = 0, sp = 0;
#pragma unroll
          for (int k = 0; k < 8; ++k) { const int t = part * 8 + k; const int v = hist[t * 16 + pe]; sa += v; sp += (t < tb) ? v : 0; }
          __hip_atomic_fetch_add(&ltot[pe], sa, __ATOMIC_RELAXED, __HIP_MEMORY_SCOPE_WORKGROUP); __hip_atomic_fetch_add(&lpre[pe], sp, __ATOMIC_RELAXED, __HIP_MEMORY_SCOPE_WORKGROUP); }
        __syncthreads();
        if (F.tid < 2) { int base = 0; for (int e = 0; e < 8; ++e) { ltb[F.tid * 8 + e] = base; base += (ltot[F.tid * 8 + e] + 255) >> 8; } }
        __syncthreads();
        unsigned e01[2] = {0u, 0u}; float w01[2] = {0.f, 0.f}; int rk[2] = {0, 0};
        if (F.tid < 256) {
            const u32x4 rec = *(const u32x4*)(KWS + WS_REC + (size_t)(tb * 256 + F.tid) * 16);
            e01[0] = rec.x; e01[1] = rec.y; w01[0] = __uint_as_float(rec.z); w01[1] = __uint_as_float(rec.w);
#pragma unroll
            for (int p = 0; p < 2; ++p)
#pragma unroll
                for (int ee = 0; ee < 8; ++ee) { const unsigned long long mk = __ballot(e01[p] == (unsigned)ee);
                    if (e01[p] == (unsigned)ee) rk[p] = __builtin_popcountll(mk & ((1ull << F.lane) - 1ull));
                    if (F.lane == 0) lwc[(p * 4 + F.wave) * 8 + ee] = __builtin_popcountll(mk); }
        }
        __syncthreads();
        if (F.tid < 256) {
#pragma unroll
            for (int p = 0; p < 2; ++p) { const int e = (int)e01[p]; int off = 0;
                for (int w = 0; w < F.wave; ++w) off += lwc[(p * 4 + w) * 8 + e];
                const int pos = ltb[p * 8 + e] * 256 + lpre[p * 8 + e] + off + rk[p];
                list[p * LISTN + pos] = tb * 256 + F.tid; wgt[p * LISTN + pos] = w01[p]; }
        }
        if (tb < 16) { const int p = tb >> 3, e = tb & 7; const int lo = ltb[tb] * 256 + ltot[tb], hi = (ltb[tb] + ((ltot[tb] + 255) >> 8)) * 256;
            for (int i = lo + F.tid; i < hi; i += NTHREADS) { list[p * LISTN + i] = (int)0x80000000u; wgt[p * LISTN + i] = 0.f; } (void)e; }
        if (tb == 0 && F.tid < 16) ((int*)(KWS + WS_TOT))[F.tid] = ltot[F.tid];
        __syncthreads();
    }
}
__device__ __forceinline__ void build_group_table(Frame& F, int p, int nN) {
    LAS int* tab = (LAS int*)(F.lds + LC_GT);
    __syncthreads();
    if (F.tid == 0) { const int* tot = (const int*)(KWS + WS_TOT) + p * 8; int ng = 0, ustart = 0, tile = 0;
        for (int e = 0; e < 8; ++e) { int tl = (tot[e] + 255) >> 8;
            while (tl > 0) { const int gsz = tl < 8 ? tl : 8; tab[64 + ng] = ustart; tab[128 + ng] = tile; tab[192 + ng] = gsz; tab[256 + ng] = e; ustart += gsz * nN; tile += gsz; tl -= gsz; ++ng; } }
        tab[0] = ng; tab[1] = ustart; }
    __syncthreads();
}

__device__ __forceinline__ void mixer_unit(Frame& F, const int l, const int unit, const int parts = 0xff) {
    const bf16* P = KPROJ; bf16* MO = KMIXED;
    const int t0 = unit * 128, s0 = t0 & (SEQ - 1), rb = t0 - s0;
    const int lane = F.lane, wave = F.wave, tid = F.tid;
    if (parts & 9) {
        typedef float f32x2 __attribute__((ext_vector_type(2)));
        constexpr int GS = 392;
        LAS bf16* gbuf = (LAS bf16*)F.lds;
        const __amdgpu_buffer_rsrc_t rsw = __builtin_amdgcn_make_buffer_rsrc((void*)(KIN(9) + (size_t)l * CKW * CONVW), (short)0, CKW * CONVW * 4, 0x00020000);
        const __amdgpu_buffer_rsrc_t rsb = __builtin_amdgcn_make_buffer_rsrc((void*)(KIN(10) + (size_t)l * CONVW), (short)0, CONVW * 4, 0x00020000);
        float g6[6], b6[6];
#pragma unroll
        for (int k = 0; k < 3; ++k)
#pragma unroll
            for (int e = 0; e < 2; ++e) { g6[2 * k + e] = KIN(11)[l * CONVW + 128 * k + 2 * lane + e]; b6[2 * k + e] = KIN(12)[l * CONVW + 128 * k + 2 * lane + e]; }
        for (int hf = 0; hf < 2; ++hf) {
            const int sbase = s0 + 64 * hf - 15;
            if (parts & 1) for (int j0 = 0; j0 < 9; j0 += 3) {
                u32x4 va[3], vg[3];
#pragma unroll
                for (int jj = 0; jj < 3; ++jj) { const int i = tid + (j0 + jj) * NTHREADS, rr = i / 48, cp = i - rr * 48, sq = sbase + rr;
                    va[jj] = (u32x4){0u, 0u, 0u, 0u}; vg[jj] = va[jj];
                    if (i < 94 * 48 && sq >= 0 && sq < SEQ) { const bf16* pr = P + (size_t)(rb + sq) * D_IN + 256 + 8 * cp; va[jj] = *(const u32x4*)pr; vg[jj] = *(const u32x4*)(pr + CONVW); } }
#pragma unroll
                for (int jj = 0; jj < 3; ++jj) { const int i = tid + (j0 + jj) * NTHREADS, rr = i / 48, cp = i - rr * 48;
                    if (i < 94 * 48) { u32x4 o;
#pragma unroll
                        for (int d = 0; d < 4; ++d) o[d] = pk2(bflo(va[jj][d]) * fast_sigmoid(bflo(vg[jj][d])), bfhi(va[jj][d]) * fast_sigmoid(bfhi(vg[jj][d])));
                        *(LAS u32x4*)(gbuf + rr * GS + 8 * cp) = o; } }
            }
            __syncthreads();
            if (parts & 8) {
            f32x2 o[3][8];
#pragma unroll
            for (int pg = 0; pg < 3; ++pg) {
                asm volatile("" ::: "memory");
                f32x2 w[31];
#pragma unroll
                for (int j = 0; j < 31; ++j) w[j] = __builtin_bit_cast(f32x2, __builtin_amdgcn_raw_buffer_load_b64(rsw, (unsigned)lane * 8u, (j * CONVW + 128 * pg) * 4, 0));
                const f32x2 bias = __builtin_bit_cast(f32x2, __builtin_amdgcn_raw_buffer_load_b64(rsb, (unsigned)lane * 8u, 128 * pg * 4, 0));
#pragma unroll
                for (int i = 0; i < 8; ++i) o[pg][i] = bias;
                const LAS unsigned* gp = (const LAS unsigned*)gbuf + (8 * wave) * (GS / 2) + 64 * pg + lane;
#pragma unroll
                for (int r = 0; r < 38; ++r) { const unsigned u = gp[r * (GS / 2)]; const f32x2 gl = {bflo(u), bfhi(u)};
#pragma unroll
                    for (int i = 0; i < 8; ++i) if (r - i >= 0 && r - i < 31) o[pg][i] = w[r - i] * gl + o[pg][i]; }
            }
#pragma unroll
            for (int i = 0; i < 8; ++i) { float sm = 0.f, q = 0.f;
#pragma unroll
                for (int pg = 0; pg < 3; ++pg) { sm += o[pg][i][0] + o[pg][i][1]; q += o[pg][i][0] * o[pg][i][0] + o[pg][i][1] * o[pg][i][1]; }
                sm = wave_sum(sm); q = wave_sum(q);
                const float mean = sm * (1.0f / CONVW), var = fmaxf(q * (1.0f / CONVW) - mean * mean, 0.f), rstd = 1.0f / sqrtf(var + EPS);
                unsigned* orow = (unsigned*)(MO + (size_t)(t0 + 64 * hf + 8 * wave + i) * D + 256);
#pragma unroll
                for (int pg = 0; pg < 3; ++pg) { const float o0 = silu_f((o[pg][i][0] - mean) * rstd * g6[2 * pg] + b6[2 * pg]), o1 = silu_f((o[pg][i][1] - mean) * rstd * g6[2 * pg + 1] + b6[2 * pg + 1]);
                    orow[64 * pg + lane] = pk2(o0, o1); } }
            }
            __syncthreads();
        }
    }
    if (parts & 18) {
        constexpr int VS = 136;
        LAS bf16* vnT = (LAS bf16*)F.lds;
        float g6[6], b6[6];
#pragma unroll
        for (int k = 0; k < 3; ++k)
#pragma unroll
            for (int e = 0; e < 2; ++e) { g6[2 * k + e] = KIN(13)[l * CONVW + 128 * k + 2 * lane + e]; b6[2 * k + e] = KIN(14)[l * CONVW + 128 * k + 2 * lane + e]; }
        if (parts & 2) for (int rh = 0; rh < 2; ++rh) {
            unsigned raw[8][3];
#pragma unroll
            for (int r = 0; r < 8; ++r) { const unsigned* pv = (const unsigned*)(P + (size_t)(t0 + wave * 16 + rh * 8 + r) * D_IN + 1408);
#pragma unroll
                for (int k = 0; k < 3; ++k) raw[r][k] = pv[64 * k + lane]; }
#pragma unroll
            for (int r = 0; r < 8; ++r) { const int tk = wave * 16 + rh * 8 + r;
                float v[6]; float s = 0.f, q = 0.f;
#pragma unroll
                for (int k = 0; k < 3; ++k) { v[2 * k] = bflo(raw[r][k]); v[2 * k + 1] = bfhi(raw[r][k]); }
#pragma unroll
                for (int k = 0; k < 6; ++k) { s += v[k]; q += v[k] * v[k]; }
                s = wave_sum(s); q = wave_sum(q);
                const float mean = s * (1.0f / CONVW), var = fmaxf(q * (1.0f / CONVW) - mean * mean, 0.f), rstd = 1.0f / sqrtf(var + EPS);
#pragma unroll
                for (int k = 0; k < 3; ++k)
#pragma unroll
                    for (int e = 0; e < 2; ++e) vnT[(128 * k + 2 * lane + e) * VS + tk] = (bf16)f2bf((v[2 * k + e] - mean) * rstd * g6[2 * k + e] + b6[2 * k + e]);
            }
        }
        __syncthreads();
        const bf16* sw = (const bf16*)(KWS + WS_SGUW);
        const float* sb = KIN(16) + (size_t)l * NH * 128;
        if (parts & 16) {
            bf16x8 wf[2][8]; u32x2 uu[2][2][4];
#define SGU_LOAD(slot, tile) do { const int hh_ = (tile) >> 2, pb_ = (tile) & 3; \
                const bf16* Wh_ = sw + ((size_t)((l * NH + hh_) * 128 + pb_ * 32 + (lane & 31))) * 128 + 8 * (lane >> 5); \
                _Pragma("unroll") for (int ks = 0; ks < 8; ++ks) wf[slot][ks] = *(const bf16x8*)(Wh_ + ks * 16); \
                const bf16* up_ = P + (size_t)(t0 + pb_ * 32 + (lane & 31)) * D_IN + 1024 + hh_ * 64 + 4 * (lane >> 5); \
                _Pragma("unroll") for (int dh = 0; dh < 2; ++dh) _Pragma("unroll") for (int a = 0; a < 4; ++a) uu[slot][dh][a] = *(const u32x2*)(up_ + dh * 32 + 8 * a); } while (0)
            SGU_LOAD(0, wave);
#pragma unroll
            for (int ti = 0; ti < 3; ++ti) { const int tile = wave + 8 * ti, hh = tile >> 2, pb = tile & 3, cs = ti & 1;
                if (ti < 2) { if (ti == 0) SGU_LOAD(1, wave + 8); else SGU_LOAD(0, wave + 16); }
                f32x16 acc0, acc1;
#pragma unroll
                for (int i = 0; i < 16; ++i) { acc0[i] = 0.f; acc1[i] = 0.f; }
                const LAS bf16* Vb = vnT + (hh * 64 + (lane & 31)) * VS + 8 * (lane >> 5);
#pragma unroll
                for (int ks = 0; ks < 8; ++ks) { const bf16x8 v0 = *(const LAS bf16x8*)(Vb + ks * 16), v1 = *(const LAS bf16x8*)(Vb + 32 * VS + ks * 16);
                    acc0 = __builtin_amdgcn_mfma_f32_32x32x16_bf16(v0, wf[cs][ks], acc0, 0, 0, 0); acc1 = __builtin_amdgcn_mfma_f32_32x32x16_bf16(v1, wf[cs][ks], acc1, 0, 0, 0); }
                const int p = pb * 32 + (lane & 31); const size_t row = (size_t)(t0 + p); const float bias = sb[hh * 128 + p];
                bf16* op = MO + row * D + 640 + hh * 64 + 4 * (lane >> 5);
#pragma unroll
                for (int a = 0; a < 4; ++a) {
                    { const unsigned u0 = uu[cs][0][a].x, u1 = uu[cs][0][a].y; u32x2 o; o.x = pk2(bflo(u0) * (acc0[4 * a + 0] + bias), bfhi(u0) * (acc0[4 * a + 1] + bias)); o.y = pk2(bflo(u1) * (acc0[4 * a + 2] + bias), bfhi(u1) * (acc0[4 * a + 3] + bias)); *(u32x2*)(op + 8 * a) = o; }
                    { const unsigned u0 = uu[cs][1][a].x, u1 = uu[cs][1][a].y; u32x2 o; o.x = pk2(bflo(u0) * (acc1[4 * a + 0] + bias), bfhi(u0) * (acc1[4 * a + 1] + bias)); o.y = pk2(bflo(u1) * (acc1[4 * a + 2] + bias), bfhi(u1) * (acc1[4 * a + 3] + bias)); *(u32x2*)(op + 32 + 8 * a) = o; }
                }
            }
#undef SGU_LOAD
        }
        __syncthreads();
    }
    if (parts & 36) {
        constexpr int AS = 264;
        constexpr int DS = 136;
        LAS bf16* abuf = (LAS bf16*)F.lds;
        LAS bf16* dbuf = (LAS bf16*)(F.lds + 144 * AS * 2);
        { u32x4 st[9];
#pragma unroll
          for (int j = 0; j < 9; ++j) { const int i = tid + j * NTHREADS, rr = i >> 5, cp = i & 31; const int sq = s0 - 8 + rr; st[j] = (u32x4){0u, 0u, 0u, 0u};
              if (sq >= 0 && sq < SEQ) st[j] = *(const u32x4*)(P + (size_t)(rb + sq) * D_IN + 8 * cp); }
#pragma unroll
          for (int j = 0; j < 9; ++j) { const int i = tid + j * NTHREADS, rr = i >> 5, cp = i & 31; *(LAS u32x4*)(abuf + rr * AS + 8 * cp) = st[j]; } }
        __syncthreads();
        const bf16* pwt = (const bf16*)(KWS + WS_POOLW) + (size_t)l * 4 * 64 * 64;
        for (int gp = 0; gp < 2; ++gp) {
            if (parts & 4) { const int cc = tid & 127, run = tid >> 7, g = 2 * gp + (cc >> 6), half = 1 << g, ch = g * 64 + (cc & 63);
              const int tk0 = run * 32; float sum = 0.f;
              for (int j = -half; j < half; ++j) sum += bf2f(abuf[(tk0 + j + 8) * AS + ch]);
              for (int k = 0; k < 32; ++k) { const int tk = tk0 + k, sq = s0 + tk; int lo = sq - half; lo = lo < 0 ? 0 : lo; int hi = sq + half; hi = hi > SEQ ? SEQ : hi;
                  const float a = bf2f(abuf[(tk + 8) * AS + ch]);
                  dbuf[tk * DS + cc] = (bf16)f2bf(sum / (float)(hi - lo) - a);
                  sum += bf2f(abuf[(tk + half + 8) * AS + ch]) - bf2f(abuf[(tk - half + 8) * AS + ch]); } }
            __syncthreads();
            if (parts & 32) { const int fr = lane & 15, fq = lane >> 4;
#pragma unroll
              for (int gg = 0; gg < 2; ++gg) { const int g = 2 * gp + gg;
                  bf16x8 af[2];
#pragma unroll
                  for (int ks = 0; ks < 2; ++ks) af[ks] = *(const LAS bf16x8*)(dbuf + (wave * 16 + fr) * DS + gg * 64 + ks * 32 + 8 * fq);
                  bf16* op = MO + (size_t)(t0 + wave * 16 + fr) * D + g * 64 + 4 * fq;
#pragma unroll
                  for (int nt = 0; nt < 4; ++nt) { f32x4 acc = {0.f, 0.f, 0.f, 0.f};
#pragma unroll
                      for (int ks = 0; ks < 2; ++ks) { const bf16x8 wfr = *(const bf16x8*)(pwt + ((size_t)(g * 64 + nt * 16 + fr)) * 64 + ks * 32 + 8 * fq);
                          acc = __builtin_amdgcn_mfma_f32_16x16x32_bf16(wfr, af[ks], acc, 0, 0, 0); }
                      u32x2 o; o.x = pk2(acc[0], acc[1]); o.y = pk2(acc[2], acc[3]); *(u32x2*)(op + nt * 16) = o; } } }
            __syncthreads();
        }
    }
}

__global__ void __launch_bounds__(NTHREADS, 2) fwd_kernel(Args args) {
    extern __shared__ __attribute__((aligned(16))) unsigned char lds_raw[];
    Frame F;
    F.lds = (LAS unsigned char*)lds_raw;
    F.tid = threadIdx.x; F.lane = F.tid & 63; F.wave = __builtin_amdgcn_readfirstlane(F.tid >> 6); F.G = gridDim.x; F.bid = blockIdx.x;
    F.ka = (kargp_t)__builtin_amdgcn_kernarg_segment_ptr(); (void)args;
    for (int u = F.tid; u < (LDS_BYTES - LC_OFF) / 4; u += NTHREADS) ((LAS unsigned*)(F.lds + LC_OFF))[u] = 0u;
    __syncthreads();
    XcdBarrier bar = xcd_barrier_post((unsigned*)(KWS + WS_CTL) + CW_BAR, (volatile LAS unsigned*)(F.lds + LC_MISC) + 8);
#define GRID_BAR() xcd_barrier(bar)
#ifndef PROBE_DUP
#define PROBE_DUP 0
#endif
#ifndef PROBE_MXPARTS
#define PROBE_MXPARTS 7
#endif
#define PROBE_REP(bit) for (int rep_ = 0; rep_ < ((PROBE_DUP & (bit)) ? 2 : 1); ++rep_)
#define MODL(l) (KMOD + (size_t)(l) * BATCH * NMOD)

    PROBE_REP(2 | 1024) { PHASE_ENTER(F); p0_prologue(F); GRID_BAR(); }

#define LAYER_MIX(l) \
    PROBE_REP(2) { PHASE_ENTER(F); if ((l) == 0) norm_phase<0, false>(F, KIN(0), KIN(4) + (l) * D, MODL(l) + 0 * D, MODL(l) + 1 * D, KH, nullptr); \
        else norm_phase<0, true>(F, KXB, KIN(4) + (l) * D, MODL(l) + 0 * D, MODL(l) + 1 * D, KH, nullptr); GRID_BAR(); } \
    PROBE_REP(8) { PHASE_ENTER(F); pg8::DenseOrder S; S.init(KH, (const bf16*)(KWS + WS_WIN) + (size_t)(l) * D_IN * D, M, D_IN, D, F.G, F.bid); \
        pg8::EpiBf16 E{KPROJ, D_IN, (PROBE_DUP & 256) ? rep_ : 0}; pg8::gemm_phase<pg8::EpiBf16, pg8::DenseOrder, false>(F.lds, D, S, E, nullptr, ((PROBE_DUP & 512) && rep_) ? 2 : 1); GRID_BAR(); } \
    PROBE_REP(1) { PHASE_ENTER(F); for (int u = F.bid; u < M / 128; u += F.G) mixer_unit(F, (l), u, ((PROBE_DUP & 1) && rep_ == 0) ? PROBE_MXPARTS : 0xff); GRID_BAR(); } \
    for (int rep_ = 0; rep_ < (((PROBE_DUP & 32) && (l) == 0) ? 2 : 1); ++rep_) { PHASE_ENTER(F); \
        pg8::DenseOrder S; S.init(KMIXED, (const bf16*)(KWS + WS_WOUT) + (size_t)(l) * D * D, M, D, D, F.G, F.bid); \
        if ((l) == 0) { pg8::EpiResidual<true> E{KIN(0), KXB, MODL(l) + 2 * D, 1.0f}; pg8::gemm_phase<pg8::EpiResidual<true>, pg8::DenseOrder, false>(F.lds, D, S, E); } \
        else { pg8::EpiResidual<false> E{KXB, KXB, MODL(l) + 2 * D, 1.0f}; pg8::gemm_phase<pg8::EpiResidual<false>, pg8::DenseOrder, false>(F.lds, D, S, E); } GRID_BAR(); }
#define KACT8(p) ((unsigned char*)(KWS + WS_BIG) + (size_t)(p) * LISTN * FFE)
#define MOE_GU(p, N5, ADV, BAR) \
    PROBE_REP(4 | 2048) { PHASE_ENTER(F); build_group_table(F, (p), 2 * FFE / 256); \
        pg8::MoeOrder S; S.tab = (const LAS int*)(F.lds + LC_GT); S.A = KH; S.Bt = (const bf16*)(KWS + WS_MWGU); S.bstride = (size_t)2 * FFE * D; S.list = (const int*)(KWS + WS_LIST) + (p) * LISTN; \
        S.K = D / 2; S.nN = 2 * FFE / 256; S.G = F.G; S.c = F.bid; S.gather = true; S.n5 = N5; S.adv = ADV; \
        pg8::EpiSwigluF8 E{KACT8(p), FFE, (PROBE_DUP & 2048) ? rep_ : 0, 1.0f / (SC_H * SC_W)}; pg8::gemm_phase<pg8::EpiSwigluF8, pg8::MoeOrder, true, true>(F.lds, D / 2, S, E, (LAS u32x4*)(F.lds + LC_GOFF)); if (BAR) GRID_BAR(); }
#define MOE_DOWN(p, BAR) \
    { PHASE_ENTER(F); build_group_table(F, (p), D / 256); \
        pg8::MoeOrder S; S.tab = (const LAS int*)(F.lds + LC_GT); S.A = (const bf16*)KACT8(p); S.Bt = (const bf16*)(KWS + WS_MWD); S.bstride = (size_t)D * FFE; S.list = nullptr; \
        S.K = FFE / 2; S.nN = D / 256; S.G = F.G; S.c = F.bid; S.gather = false; S.n5 = 0; S.adv = 0; \
        pg8::EpiMoeDown E{KXB, (const int*)(KWS + WS_LIST) + (p) * LISTN, (const float*)(KWS + WS_WGT) + (p) * LISTN, MODL(1) + 5 * D, 1.0f / (SC_A * SC_W), (bf16*)(KWS + WS_DUMP)}; \
        pg8::gemm_phase<pg8::EpiMoeDown, pg8::MoeOrder, false, true>(F.lds, FFE / 2, S, E); if (BAR) GRID_BAR(); \
        if (PROBE_DUP & 128) { pg8::EpiMoeDown E0 = E; E0.ascale = 0.f; pg8::gemm_phase<pg8::EpiMoeDown, pg8::MoeOrder, false, true>(F.lds, FFE / 2, S, E0); GRID_BAR(); } }

    LAYER_MIX(0)
    PROBE_REP(2) { PHASE_ENTER(F); norm_phase<0, true>(F, KXB, KIN(5), MODL(0) + 3 * D, MODL(0) + 4 * D, KH, nullptr); GRID_BAR(); }
    PROBE_REP(16) { PHASE_ENTER(F); pg8::DenseOrder S; S.init(KH, (const bf16*)(KWS + WS_WGU), M, 2 * FF, D, F.G, F.bid);
        pg8::EpiSwigluF8 E{(unsigned char*)KACT, FF, 0, 1.0f}; pg8::gemm_phase<pg8::EpiSwigluF8, pg8::DenseOrder, false>(F.lds, D, S, E); GRID_BAR(); }
    { PHASE_ENTER(F); pg8::DenseOrder S; S.init(KACT, (const bf16*)(KWS + WS_WD), M, D, FF / 2, F.G, F.bid);
        pg8::EpiResidual<false> E{KXB, KXB, MODL(0) + 5 * D, 1.0f / (SC_A * SC_W)}; pg8::gemm_phase<pg8::EpiResidual<false>, pg8::DenseOrder, false, true>(F.lds, FF / 2, S, E); GRID_BAR(); }
    if (PROBE_DUP & 64) { PHASE_ENTER(F); pg8::DenseOrder S; S.init(KACT, (const bf16*)(KWS + WS_WD), M, D, FF / 2, F.G, F.bid);
        pg8::EpiResidual<false> E{KXB, KXB, MODL(0) + 5 * D, 0.0f}; pg8::gemm_phase<pg8::EpiResidual<false>, pg8::DenseOrder, false, true>(F.lds, FF / 2, S, E); GRID_BAR(); }
    LAYER_MIX(1)
    PROBE_REP(2) { PHASE_ENTER(F); norm_phase<1, true>(F, KXB, KIN(5) + D, MODL(1) + 3 * D, MODL(1) + 4 * D, KH, nullptr); GRID_BAR();
        PHASE_ENTER(F); route_phase(F); GRID_BAR(); }
    MOE_GU(0, 0, 0, true)
    { int n5; { const int* tot = (const int*)(KWS + WS_TOT); int tl = 0; for (int e = 0; e < 8; ++e) tl += (tot[e] + 255) >> 8; n5 = (tl * (D / 256)) % F.G; n5 = (n5 + 7) & ~7; if (n5 >= F.G) n5 = 0; }
      MOE_DOWN(0, false)
      MOE_GU(1, n5, (n5 ? 3 : 0), true) }
    MOE_DOWN(1, true)
    if (PROBE_DUP & 4096) { for (int i = 0; i < 20; ++i) GRID_BAR(); }
    { PHASE_ENTER(F); norm_phase<2, true>(F, KXB, KIN(26), nullptr, nullptr, nullptr, KOUT); }
}

extern "C" void kernel_launch(void* const* d_in, const int* in_sizes, int n_in, void* d_out, int out_size, void* d_ws, size_t ws_size, hipStream_t stream) {
    static int grid = 0;
    if (grid == 0) {
        if (n_in != 27 || in_sizes[0] != M * D || out_size != M * D || ws_size < WS_END) { fprintf(stderr, "kernel_launch: unexpected shapes (n_in %d, in0 %d, out %d, ws %zu < %zu); nothing launched\n", n_in, n_in > 0 ? in_sizes[0] : -1, out_size, ws_size, (size_t)WS_END); grid = -1; return; }
        int dev = 0, cus = 0, per_cu = 0;
        if (hipGetDevice(&dev) != hipSuccess || hipDeviceGetAttribute(&cus, hipDeviceAttributeMultiprocessorCount, dev) != hipSuccess) { grid = -1; return; }
        if (hipFuncSetAttribute((const void*)fwd_kernel, hipFuncAttributeMaxDynamicSharedMemorySize, LDS_BYTES) != hipSuccess) { fprintf(stderr, "kernel_launch: hipFuncSetAttribute failed\n"); grid = -1; return; }
        if (hipOccupancyMaxActiveBlocksPerMultiprocessor(&per_cu, (const void*)fwd_kernel, NTHREADS, LDS_BYTES) != hipSuccess || per_cu < 1) { fprintf(stderr, "kernel_launch: occupancy query says %d blocks per CU\n", per_cu); }
        (void)hipGetLastError();
        grid = cus;
    }
    if (grid < 0) return;
    if (hipMemsetAsync((char*)d_ws + WS_CTL, 0, CTL_ZERO_BYTES, stream) != hipSuccess) return;
    Args a{};
    for (int i = 0; i < 27; ++i) a.in[i] = (const float*)d_in[i];
    a.out = (float*)d_out; a.ws = (unsigned char*)d_ws;
    hipLaunchKernelGGL(fwd_kernel, dim3(grid), dim3(NTHREADS), LDS_BYTES, stream, a);
}
```
